# Optimizing an MI355X kernel written in HIP

```python
import math
import jax, jax.numpy as jnp
from jax import lax
import numpy as np

D_MODEL = 1024
BATCH = 4
SEQ = 4096
DEPTH = 2

GRID_W = 64
CTX_LEN = 256

ATTN_HEADS = 8
ATTN_KV_HEADS = 2
HEAD_DIM = 64
ATTN_REP = ATTN_HEADS // ATTN_KV_HEADS
ATTN_WIDTH = ATTN_HEADS * HEAD_DIM
KV_WIDTH = ATTN_KV_HEADS * HEAD_DIM
AXIS_ROT = HEAD_DIM // 2
ROPE_THETA = 10000.0
Q_BLOCK = 128

SSD_HEADS = 8
SSD_HEAD_DIM = 64
SSD_INNER = SSD_HEADS * SSD_HEAD_DIM
SSD_STATE = 64
SSD_GROUPS = 2
SSD_HPG = SSD_HEADS // SSD_GROUPS
SSD_GN = SSD_GROUPS * SSD_STATE
SSD_CONV = 3
SSD_CONV_DIM = SSD_INNER + 2 * SSD_GN
SSD_CHUNK = 128

SC_WIDTH = 512
SC_CONV = 3

N_BRANCH = 3

N_EXPERTS = 16
EXPERT_FF = 2048
CAPACITY_FACTOR = 2

ALPHA = (2 * DEPTH) ** 0.25
BETA = (8 * DEPTH) ** -0.25

N_MOD = 6
EPS = 1e-6

CTX_COLS = (KV_WIDTH, KV_WIDTH, SSD_CONV_DIM, 2 * SSD_HEADS)
LAT_COLS = (ATTN_WIDTH, SSD_INNER, SC_WIDTH, SC_WIDTH, SC_WIDTH, N_BRANCH * D_MODEL)
CTX_STATE_COLS = sum(CTX_COLS)
IN_COLS = CTX_STATE_COLS + sum(LAT_COLS)

kernel_name = "hybrid_dit_attn_ssd_shortconv_ecmoe"


def split_cols(p, sizes):
    return jnp.split(p, np.cumsum(sizes)[:-1].tolist(), axis=-1)


def layer_norm(x, g=None, b=None):
    xf = x.astype(jnp.float32)
    mu = jnp.mean(xf, axis=-1, keepdims=True)
    var = jnp.mean(jnp.square(xf - mu), axis=-1, keepdims=True)
    y = (xf - mu) * lax.rsqrt(var + EPS)
    if g is not None:
        y = y * g.astype(jnp.float32) + b.astype(jnp.float32)
    return y.astype(x.dtype)


def rms_norm(x, g):
    xf = x.astype(jnp.float32)
    y = xf * lax.rsqrt(jnp.mean(jnp.square(xf), axis=-1, keepdims=True) + EPS)
    return (y * g.astype(jnp.float32)).astype(x.dtype)


def modulate(x, shift, scale):
    return layer_norm(x) * (1.0 + scale) + shift


def dwconv_centred(u, w):
    k = w.shape[0]
    return lax.conv_general_dilated(
        u, w[:, None, :].astype(u.dtype), window_strides=(1,),
        padding=[(k // 2, k // 2)], dimension_numbers=('NWC', 'WIO', 'NWC'),
        feature_group_count=u.shape[-1])


def axial_rope(n):
    rows = n // GRID_W
    row = jnp.repeat(jnp.arange(rows), GRID_W).astype(jnp.float32)
    col = jnp.tile(jnp.arange(GRID_W), rows).astype(jnp.float32)
    inv = ROPE_THETA ** (-jnp.arange(0, AXIS_ROT, 2, dtype=jnp.float32) / AXIS_ROT)
    ang = jnp.stack([row[:, None] * inv, col[:, None] * inv], axis=1)
    return jnp.cos(ang), jnp.sin(ang)


def apply_rope(x, cos, sin):
    b, n, h, d = x.shape
    xa = x.reshape(b, n, h, 2, 2, AXIS_ROT // 2).astype(jnp.float32)
    x1, x2 = xa[..., 0, :], xa[..., 1, :]
    c, s = cos[None, :, None], sin[None, :, None]
    out = jnp.stack([x1 * c - x2 * s, x2 * c + x1 * s], axis=-2)
    return out.reshape(b, n, h, d).astype(x.dtype)


def attend(q, k, v):
    b, tq = q.shape[:2]
    qg = q.reshape(b, tq, ATTN_KV_HEADS, ATTN_REP, HEAD_DIM)
    s = jnp.einsum('bqgrd,bkgd->bgrqk', qg, k, preferred_element_type=jnp.float32) * (HEAD_DIM ** -0.5)
    p = jax.nn.softmax(s, axis=-1).astype(v.dtype)
    o = jnp.einsum('bgrqk,bkgd->bqgrd', p, v)
    return o.reshape(b, tq, ATTN_WIDTH)


def blocked_attention(q, k, v):
    b, n = q.shape[:2]
    nb = n // Q_BLOCK
    qb = q.reshape(b, nb, Q_BLOCK, ATTN_HEADS, HEAD_DIM).swapaxes(0, 1)
    ob = lax.map(lambda blk: attend(blk, k, v), qb)
    return ob.swapaxes(0, 1).reshape(b, n, ATTN_WIDTH)


def ssd_scan(xs, dt, a, bm, cm, h0):
    b, t, nh, hp = xs.shape
    L = SSD_CHUNK
    nc = t // L
    to_chunks = lambda u: u.reshape((b, nc, L) + u.shape[2:]).astype(jnp.float32)
    xc, dtc, bc, cc = to_chunks(xs), to_chunks(dt), to_chunks(bm), to_chunks(cm)
    acs = jnp.cumsum(dtc * a, axis=2)
    mask = jnp.tril(jnp.ones((L, L), dtype=bool))
    seg = acs[:, :, :, None, :] - acs[:, :, None, :, :]
    decay = jnp.exp(jnp.where(mask[:, :, None], seg, -jnp.inf))
    scores = jnp.einsum('bclhn,bcshn->bclsh', cc, bc) * decay
    y_diag = jnp.einsum('bclsh,bcsh,bcshp->bclhp', scores, dtc, xc)
    w_state = jnp.exp(acs[:, :, -1:, :] - acs) * dtc
    states = jnp.einsum('bclhn,bclh,bclhp->bchpn', bc, w_state, xc)
    chunk_decay = jnp.exp(acs[:, :, -1, :])

    def step(h, inp):
        st, dec = inp
        return dec[:, :, None, None] * h + st, h

    h_last, h_start = lax.scan(step, h0.astype(jnp.float32),
                               (jnp.moveaxis(states, 1, 0), jnp.moveaxis(chunk_decay, 1, 0)))
    h_start = jnp.moveaxis(h_start, 0, 1)
    y_off = jnp.einsum('bclhn,bchpn,bclh->bclhp', cc, h_start, jnp.exp(acs))
    return (y_diag + y_off).reshape(b, t, nh, hp), h_last


def ssd_bidirectional(xbc_raw, dt_raw, conv_w, conv_b, a_log, dt_bias, d_skip, h0_f, h0_b):
    b, t, _ = xbc_raw.shape
    xbc = jax.nn.silu(dwconv_centred(xbc_raw, conv_w) + conv_b)
    xs, bm, cm = split_cols(xbc, (SSD_INNER, SSD_GN, SSD_GN))
    xs = xs.reshape(b, t, SSD_HEADS, SSD_HEAD_DIM)
    bm = jnp.repeat(bm.reshape(b, t, SSD_GROUPS, SSD_STATE), SSD_HPG, axis=2)
    cm = jnp.repeat(cm.reshape(b, t, SSD_GROUPS, SSD_STATE), SSD_HPG, axis=2)
    dt = jax.nn.softplus(dt_raw.reshape(b, t, 2, SSD_HEADS).astype(jnp.float32)
                         + dt_bias.astype(jnp.float32))
    a = -jnp.exp(a_log.astype(jnp.float32))
    y_f, s_f = ssd_scan(xs, dt[:, :, 0], a[0], bm, cm, h0_f)
    flip = lambda u: jnp.flip(u, axis=1)
    y_b, s_b = ssd_scan(flip(xs), flip(dt[:, :, 1]), a[1], flip(bm), flip(cm), h0_b)
    y = y_f + flip(y_b) + d_skip.astype(jnp.float32)[:, None] * xs.astype(jnp.float32)
    return y.reshape(b, t, SSD_INNER).astype(xbc_raw.dtype), s_f, s_b


def merge_branches(ya, ys, yc, gate_cols, w_br_attn, w_br_ssd, w_br_conv, w_o):
    b, t = ya.shape[:2]
    g = jax.nn.sigmoid(gate_cols).reshape(b, t, N_BRANCH, D_MODEL)
    m = (g[:, :, 0] * (ya @ w_br_attn) + g[:, :, 1] * (ys @ w_br_ssd)
         + g[:, :, 2] * (yc @ w_br_conv))
    return m @ w_o


def token_mixer(h_ctx, h_lat, cos, sin, w_in, q_norm, k_norm, ssd_conv_w, ssd_conv_b,
                ssd_a_log, ssd_dt_bias, ssd_d, ssd_norm, sc_conv_w,
                w_br_attn, w_br_ssd, w_br_conv, w_o, need_ctx):
    b, n = h_lat.shape[:2]
    nctx = h_ctx.shape[1]
    if need_ctx:
        pc = split_cols(h_ctx @ w_in, CTX_COLS + LAT_COLS)
    else:
        pc = split_cols(h_ctx @ w_in[:, :CTX_STATE_COLS], CTX_COLS)
    k_c = rms_norm(pc[0].reshape(b, nctx, ATTN_KV_HEADS, HEAD_DIM), k_norm)
    v_c = pc[1].reshape(b, nctx, ATTN_KV_HEADS, HEAD_DIM)
    zeros_state = jnp.zeros((b, SSD_HEADS, SSD_HEAD_DIM, SSD_STATE), jnp.float32)
    ys_c, s_f, s_b = ssd_bidirectional(pc[2], pc[3], ssd_conv_w, ssd_conv_b, ssd_a_log,
                                       ssd_dt_bias, ssd_d, zeros_state, zeros_state)

    k_l, v_l, xbc_l, dt_l, q_l, z_l, scb_l, scc_l, scx_l, gate_l = split_cols(h_lat @ w_in, CTX_COLS + LAT_COLS)
    q_l = apply_rope(rms_norm(q_l.reshape(b, n, ATTN_HEADS, HEAD_DIM), q_norm), cos, sin)
    k_l = apply_rope(rms_norm(k_l.reshape(b, n, ATTN_KV_HEADS, HEAD_DIM), k_norm), cos, sin)
    keys = jnp.concatenate([k_c, k_l], axis=1)
    vals = jnp.concatenate([v_c, v_l.reshape(b, n, ATTN_KV_HEADS, HEAD_DIM)], axis=1)
    ya_l = blocked_attention(q_l, keys, vals)
    ys_l, _, _ = ssd_bidirectional(xbc_l, dt_l, ssd_conv_w, ssd_conv_b, ssd_a_log,
                                   ssd_dt_bias, ssd_d, s_f, s_b)
    ys_l = rms_norm(ys_l * jax.nn.silu(z_l), ssd_norm)
    yc_l = scb_l * dwconv_centred(scc_l * scx_l, sc_conv_w)
    out_l = merge_branches(ya_l, ys_l, yc_l, gate_l, w_br_attn, w_br_ssd, w_br_conv, w_o)

    out_c = None
    if need_ctx:
        q_c, z_c, scb_c, scc_c, scx_c, gate_c = pc[4:]
        q_c = rms_norm(q_c.reshape(b, nctx, ATTN_HEADS, HEAD_DIM), q_norm)
        ya_c = attend(q_c, k_c, v_c)
        ys_cg = rms_norm(ys_c * jax.nn.silu(z_c), ssd_norm)
        yc_c = scb_c * dwconv_centred(scc_c * scx_c, sc_conv_w)
        out_c = merge_branches(ya_c, ys_cg, yc_c, gate_c, w_br_attn, w_br_ssd, w_br_conv, w_o)
    return out_l, out_c


def ec_moe(h, w_router, w_gate, w_up, w_down):
    b, t, _ = h.shape
    cap = CAPACITY_FACTOR * t // N_EXPERTS
    aff = jax.nn.softmax((h @ w_router).astype(jnp.float32), axis=-1)
    top_aff, idx = lax.top_k(aff.swapaxes(1, 2), cap)
    bidx = jnp.arange(b)[:, None, None]
    xs = h[bidx, idx]
    hid = jax.nn.silu(jnp.einsum('becd,edf->becf', xs, w_gate)) * jnp.einsum('becd,edf->becf', xs, w_up)
    out = jnp.einsum('becf,efd->becd', hid, w_down) * top_aff[..., None].astype(h.dtype)
    return jnp.zeros_like(h).at[bidx, idx].add(out)


def setup_inputs(seed: int = 0) -> dict:
    key = jax.random.key(seed)
    ks = jax.random.split(key, 28)
    f32 = jnp.float32
    nrm = lambda k, shape, scale: scale * jax.random.normal(k, shape, f32)
    L, D = DEPTH, D_MODEL
    dt0 = jnp.exp(jax.random.uniform(ks[12], (L, 2, SSD_HEADS), f32,
                                     minval=math.log(1e-3), maxval=math.log(1e-1)))
    return {
        "x": nrm(ks[0], (BATCH, SEQ, D), 1.0),
        "c": nrm(ks[1], (BATCH, D), 1.0),
        "ctx": nrm(ks[2], (BATCH, CTX_LEN, D), 1.0),
        "c_ctx": nrm(ks[3], (D,), 1.0),
        "w_mod": nrm(ks[4], (L, D, N_MOD * D), 0.5 * D ** -0.5),
        "b_mod": nrm(ks[5], (L, N_MOD * D), 0.01),
        "w_in": nrm(ks[6], (L, D, IN_COLS), D ** -0.5),
        "q_norm": 1.0 + nrm(ks[7], (L, HEAD_DIM), 0.05),
        "k_norm": 1.0 + nrm(ks[8], (L, HEAD_DIM), 0.05),
        "ssd_conv_w": nrm(ks[9], (L, SSD_CONV, SSD_CONV_DIM), SSD_CONV ** -0.5),
        "ssd_conv_b": nrm(ks[10], (L, SSD_CONV_DIM), 0.01),
        "ssd_a_log": jnp.log(jax.random.uniform(ks[11], (L, 2, SSD_HEADS), f32, minval=1.0, maxval=16.0)),
        "ssd_dt_bias": dt0 + jnp.log(-jnp.expm1(-dt0)),
        "ssd_d": 1.0 + nrm(ks[13], (L, SSD_HEADS), 0.1),
        "ssd_norm": 1.0 + nrm(ks[14], (L, SSD_INNER), 0.05),
        "sc_conv_w": nrm(ks[15], (L, SC_CONV, SC_WIDTH), SC_CONV ** -0.5),
        "w_br_attn": nrm(ks[16], (L, ATTN_WIDTH, D), ATTN_WIDTH ** -0.5),
        "w_br_ssd": nrm(ks[17], (L, SSD_INNER, D), SSD_INNER ** -0.5),
        "w_br_conv": nrm(ks[18], (L, SC_WIDTH, D), SC_WIDTH ** -0.5),
        "w_o": nrm(ks[19], (L, D, D), BETA * D ** -0.5),
        "ln1_g": 1.0 + nrm(ks[20], (L, D), 0.05),
        "ln1_b": nrm(ks[21], (L, D), 0.01),
        "w_router": nrm(ks[22], (L, D, N_EXPERTS), D ** -0.5),
        "w_exp_gate": nrm(ks[23], (L, N_EXPERTS, D, EXPERT_FF), D ** -0.5),
        "w_exp_up": nrm(ks[24], (L, N_EXPERTS, D, EXPERT_FF), D ** -0.5),
        "w_exp_down": nrm(ks[25], (L, N_EXPERTS, EXPERT_FF, D), BETA * EXPERT_FF ** -0.5),
        "ln2_g": 1.0 + nrm(ks[26], (L, D), 0.05),
        "ln2_b": nrm(ks[27], (L, D), 0.01),
    }


def reference(x, c, ctx, c_ctx, w_mod, b_mod, w_in, q_norm, k_norm, ssd_conv_w, ssd_conv_b,
              ssd_a_log, ssd_dt_bias, ssd_d, ssd_norm, sc_conv_w, w_br_attn, w_br_ssd,
              w_br_conv, w_o, ln1_g, ln1_b, w_router, w_exp_gate, w_exp_up, w_exp_down,
              ln2_g, ln2_b):
    n = x.shape[1]
    cos, sin = axial_rope(n)
    x_ctx = ctx
    silu_c = jax.nn.silu(c)
    silu_cc = jax.nn.silu(c_ctx)[None]
    for i in range(DEPTH):
        need_ctx = i < DEPTH - 1
        mod_l = [m[:, None, :] for m in jnp.split(silu_c @ w_mod[i] + b_mod[i], N_MOD, axis=-1)]
        mod_c = [m[:, None, :] for m in jnp.split(silu_cc @ w_mod[i] + b_mod[i], N_MOD, axis=-1)]

        h_l = modulate(x, mod_l[0], mod_l[1])
        h_c = modulate(x_ctx, mod_c[0], mod_c[1])
        out_l, out_c = token_mixer(h_c, h_l, cos, sin, w_in[i], q_norm[i], k_norm[i],
                                   ssd_conv_w[i], ssd_conv_b[i], ssd_a_log[i], ssd_dt_bias[i],
                                   ssd_d[i], ssd_norm[i], sc_conv_w[i], w_br_attn[i],
                                   w_br_ssd[i], w_br_conv[i], w_o[i], need_ctx)
        x = layer_norm(ALPHA * x + mod_l[2] * out_l, ln1_g[i], ln1_b[i])

        moe_l = ec_moe(modulate(x, mod_l[3], mod_l[4]), w_router[i], w_exp_gate[i],
                       w_exp_up[i], w_exp_down[i])
        x = layer_norm(ALPHA * x + mod_l[5] * moe_l, ln2_g[i], ln2_b[i])

        if need_ctx:
            x_ctx = layer_norm(ALPHA * x_ctx + mod_c[2] * out_c, ln1_g[i], ln1_b[i])
            moe_c = ec_moe(modulate(x_ctx, mod_c[3], mod_c[4]), w_router[i], w_exp_gate[i],
                           w_exp_up[i], w_exp_down[i])
            x_ctx = layer_norm(ALPHA * x_ctx + mod_c[5] * moe_c, ln2_g[i], ln2_b[i])
    return x
```

```cpp
#include <hip/hip_runtime.h>
#include <hip/hip_bf16.h>
#include <hip/hip_cooperative_groups.h>
#include <cstdio>
#include <cstdint>
namespace cg = cooperative_groups;

#define DI __device__ __forceinline__
#define LAS __attribute__((address_space(3)))
typedef unsigned short bf16_t;
typedef short bf16x8 __attribute__((ext_vector_type(8)));
typedef float f32x4 __attribute__((ext_vector_type(4)));
typedef float f32x2 __attribute__((ext_vector_type(2)));
typedef float f32x16 __attribute__((ext_vector_type(16)));
typedef unsigned u32x4 __attribute__((ext_vector_type(4)));
typedef unsigned u32x2 __attribute__((ext_vector_type(2)));

constexpr int DMODEL = 1024, NBATCH = 4, SEQL = 4096, CTXL = 256, TPB = SEQL + CTXL  , MR = NBATCH * TPB  ;
constexpr int NLAYER = 2, IN_COLS = 6672, NP = 6656;
constexpr int PK = 0, PV = 128, PXBC = 256, PQ = 1024, PZ = 1536, PSCB = 2048, PSCC = 2560, PSCX = 3072, PG = 3584;
constexpr int NEXP = 16, FF = 2048, ESTR = 2304  , NCH = 34  ;
constexpr float EPSF = 1e-6f;
constexpr float ALPHA_F = 1.4142135623730951f;
constexpr float QSCALE = 0.125f * 1.4426950408889634f;

constexpr size_t al256(size_t x) { return (x + 255) & ~(size_t)255; }
constexpr size_t WS_WIN = 0;
constexpr size_t WS_WBR = WS_WIN + al256((size_t)NLAYER * NP * 1024 * 2);
constexpr size_t WS_WO = WS_WBR + al256((size_t)NLAYER * 3 * 1024 * 512 * 2);
constexpr size_t WS_WGU = WS_WO + al256((size_t)NLAYER * 1024 * 1024 * 2);
constexpr size_t WS_WD = WS_WGU + al256((size_t)NLAYER * NEXP * 4096 * 1024 * 2);
constexpr size_t WS_XA = WS_WD + al256((size_t)NLAYER * NEXP * 1024 * 2048 * 2);
constexpr size_t WS_X1 = WS_XA + al256((size_t)MR * 1024 * 4);
constexpr size_t WS_H = WS_X1 + al256((size_t)MR * 1024 * 4);
constexpr size_t WS_PROJ = WS_H + al256((size_t)MR * 1024 * 2);
constexpr size_t WS_XS = WS_PROJ;
constexpr size_t WS_HID = WS_PROJ + al256((size_t)NEXP * ESTR * 1024 * 2);
constexpr size_t WS_Q = WS_PROJ + al256((size_t)MR * NP * 2);
constexpr size_t WS_K = WS_Q + al256((size_t)MR * 512 * 2);
constexpr size_t WS_V = WS_K + al256((size_t)MR * 128 * 2);
constexpr size_t WS_XBC = WS_V + al256((size_t)MR * 128 * 2);
constexpr size_t WS_YC = WS_XBC + al256((size_t)MR * 768 * 2);
constexpr size_t WS_YA = WS_YC + al256((size_t)MR * 512 * 2);
constexpr size_t WS_YS = WS_YA + al256((size_t)MR * 512 * 2);
constexpr size_t WS_YRAW = WS_YS + al256((size_t)MR * 512 * 2);
constexpr size_t WS_M = WS_YRAW + al256((size_t)MR * 512 * 2);
constexpr size_t WS_ST = WS_M + al256((size_t)MR * 1024 * 2);
constexpr size_t WS_DT = WS_ST + al256((size_t)2 * NBATCH * NCH * 8 * 4096 * 4);
constexpr size_t WS_ACS = WS_DT + al256((size_t)MR * 16 * 4);
constexpr size_t WS_AFF = WS_ACS + al256((size_t)MR * 16 * 4);
constexpr size_t WS_SLOT = WS_AFF + al256((size_t)MR * 16 * 4);
constexpr size_t WS_AFFSEL = WS_SLOT + al256((size_t)MR * 16 * 4);
constexpr size_t WS_MODV = WS_AFFSEL + al256((size_t)NEXP * ESTR * 4);
constexpr size_t WS_ROPE = WS_MODV + al256((size_t)NLAYER * 5 * 6144 * 4);
constexpr size_t WS_END = WS_ROPE + al256((size_t)64 * 16 * 2 * 4);
static_assert(WS_HID + (size_t)NEXP * ESTR * 2048 * 2 <= WS_Q, "MoE overlays fit inside PROJ");
static_assert(WS_END <= (size_t)1073741824, "workspace fits 1 GiB");

constexpr int LDS_BYTES = 147456;
constexpr int RING_BYTES = 131072;

struct Params {
    const float *x, *c, *ctx, *c_ctx, *w_mod, *b_mod, *w_in, *q_norm, *k_norm, *ssd_conv_w, *ssd_conv_b, *ssd_a_log, *ssd_dt_bias, *ssd_d, *ssd_norm, *sc_conv_w,
        *w_br_attn, *w_br_ssd, *w_br_conv, *w_o, *ln1_g, *ln1_b, *w_router, *w_exp_gate, *w_exp_up, *w_exp_down, *ln2_g, *ln2_b;
    float* out; unsigned char* ws; int ph_lo, ph_hi;
};

DI float wave_sum(float v) {
#pragma unroll
    for (int o = 1; o < 64; o <<= 1) v += __shfl_xor(v, o);
    return v;
}
DI int wave_sum_i(int v) {
#pragma unroll
    for (int o = 1; o < 64; o <<= 1) v += __shfl_xor(v, o);
    return v;
}
typedef __bf16 bf16x2_t __attribute__((ext_vector_type(2)));
DI unsigned pk2(float lo, float hi) { f32x2 v = {lo, hi}; bf16x2_t b = __builtin_convertvector(v, bf16x2_t); return __builtin_bit_cast(unsigned, b); }
DI float bflo(unsigned w) { return __uint_as_float(w << 16); }
DI float bfhi(unsigned w) { return __uint_as_float(w & 0xffff0000u); }
DI void unpack8(const u32x4 v, float (&f)[8]) { f[0] = bflo(v.x); f[1] = bfhi(v.x); f[2] = bflo(v.y); f[3] = bfhi(v.y); f[4] = bflo(v.z); f[5] = bfhi(v.z); f[6] = bflo(v.w); f[7] = bfhi(v.w); }
DI u32x4 pack8(const float (&f)[8]) { u32x4 o; o.x = pk2(f[0], f[1]); o.y = pk2(f[2], f[3]); o.z = pk2(f[4], f[5]); o.w = pk2(f[6], f[7]); return o; }
DI float sigmoidf_(float x) { return 1.f / (1.f + __expf(-x)); }
DI float siluf_(float x) { return x / (1.f + __expf(-x)); }
DI int crow(int r, int hi) { return (r & 3) + 8 * (r >> 2) + 4 * hi; }
DI void row_bp(int r, int& b, int& p) { b = r / TPB; p = r - b * TPB; }
DI const float* xsrc_row(const Params& P, int layer, int r) {
    if (layer == 0) { int b, p; row_bp(r, b, p); return p < CTXL ? P.ctx + ((size_t)b * CTXL + p) * DMODEL : P.x + ((size_t)b * SEQL + (p - CTXL)) * DMODEL; }
    return (const float*)(P.ws + WS_XA) + (size_t)r * DMODEL;
}

namespace pg8 {
#define PG8_LAS __attribute__((address_space(3)))
constexpr int BM = 256, BK = 64, HALF = 128, HTB = HALF * BK * 2, STAGE_BYTES = 8 * HTB;
DI int lds_byte(int r, int c) { const int st = (r >> 4) * 2 + (c >> 5), rr = r & 15, cc = c & 31, ob = rr * 64 + cc * 2; return st * 1024 + (ob ^ (((ob >> 9) & 1) << 5)); }
DI void stage_rc(int b, int& R, int& C) { const int st = b / 1024, sb = b % 1024, swz = sb ^ (((sb >> 9) & 1) << 5); R = (st >> 1) * 16 + swz / 64; C = (st & 1) * 32 + (swz % 64) / 2; }
DI int perm32(int rho) { const int n = rho >> 4, i = rho & 15; return 8 * (i >> 2) + 4 * n + (i & 3); }
struct Unit { const char* a; const char* b; int orow, ocol, aux, keep; };
DI unsigned cvt_pk_bf16(float lo, float hi) { return pk2(lo, hi); }
template <class Epi, class Sched, bool ALIGN_EPI = false, bool SP2 = false>
__device__ __forceinline__ void gemm_phase(PG8_LAS unsigned char* lds, const int K_, const Sched& S, const Epi& E) {
    int tid = threadIdx.x; asm volatile("" : "+v"(tid)); const int wid = __builtin_amdgcn_readfirstlane(tid >> 6), lane = tid & 63, wr = wid >> 2, wc = wid & 3, fr = lane & 15, fq = lane >> 4;
    const int K = K_, nt = K / BK;
    unsigned voffA[2], voffB[2];
#pragma unroll
    for (int i = 0; i < 2; ++i) { int R, C; stage_rc(tid * 16 + i * 8192, R, C); const int Rb = Epi::PERM ? ((R & ~31) + perm32(R & 31)) : R;
        voffA[i] = (unsigned)(R * K + C) * 2u; voffB[i] = (unsigned)(Rb * K + C) * 2u; }
    const size_t kstep = (size_t)(BK * 2);
    const size_t hstep = (size_t)HALF * K * 2;
    const unsigned ldsw = (unsigned)wid * 1024u;
    const int aoff = lds_byte(wr * 64 + fr, fq * 8), boff = lds_byte(wc * 32 + fr, fq * 8);
#define PG8_SA(b, h) (((b) * 2 + (h)) * HTB)
#define PG8_SB(b, h) ((4 + (b) * 2 + (h)) * HTB)
#define PG8_STAGE(bufoff, gbase, voff) do { _Pragma("unroll") for (int _i = 0; _i < 2; ++_i) \
        __builtin_amdgcn_global_load_lds((const unsigned*)((const char*)(gbase) + (voff)[_i]), (PG8_LAS unsigned*)(lds + (bufoff) + ldsw + _i * 8192), 16, 0, 0); } while (0)
#define PG8_LDA(dst, b, h) do { _Pragma("unroll") for (int m = 0; m < 4; ++m) _Pragma("unroll") for (int k = 0; k < 2; ++k) dst[m][k] = *(const PG8_LAS bf16x8*)(lds + PG8_SA(b, h) + aoff + m * 2048 + k * 1024); } while (0)
#define PG8_LDB(dst, b, h) do { _Pragma("unroll") for (int n = 0; n < 2; ++n) _Pragma("unroll") for (int k = 0; k < 2; ++k) dst[n][k] = *(const PG8_LAS bf16x8*)(lds + PG8_SB(b, h) + boff + n * 2048 + k * 1024); } while (0)
#define PG8_MMA(ai, bj, At, Bt) do { __builtin_amdgcn_s_setprio(1); _Pragma("unroll") for (int m = 0; m < 4; ++m) _Pragma("unroll") for (int n = 0; n < 2; ++n) _Pragma("unroll") for (int k = 0; k < 2; ++k) \
        acc[ai][bj][m][n] = __builtin_amdgcn_mfma_f32_16x16x32_bf16(Bt[n][k], At[m][k], acc[ai][bj][m][n], 0, 0, 0); __builtin_amdgcn_s_setprio(0); } while (0)
#define PG8_WAIT_V(n) asm volatile("s_waitcnt vmcnt(" #n ")" ::: "memory")
#define PG8_WAIT_L(n) asm volatile("s_waitcnt lgkmcnt(" #n ")" ::: "memory")
#define PG8_BAR __builtin_amdgcn_s_barrier()
#define PG8_SCHED __builtin_amdgcn_sched_barrier(0)
    Unit cur, nxt; int ui = 0;
    if (!S.next(0, cur)) return;
    f32x4 acc[2][2][4][2];
#pragma unroll
    for (int a = 0; a < 2; ++a)
#pragma unroll
        for (int b = 0; b < 2; ++b)
#pragma unroll
            for (int m = 0; m < 4; ++m)
#pragma unroll
                for (int n = 0; n < 2; ++n) acc[a][b][m][n] = (f32x4){0.f, 0.f, 0.f, 0.f};
    bf16x8 At[4][2], B0[2][2], B1[2][2];
    const char* cA = cur.a; const char* cB = cur.b;
    S.a_ready(cur);
    if constexpr (SP2) {
        PG8_STAGE(PG8_SB(0, 0), cB, voffB); PG8_STAGE(PG8_SB(0, 1), cB + hstep, voffB); PG8_STAGE(PG8_SA(0, 0), cA, voffA); PG8_STAGE(PG8_SA(0, 1), cA + hstep, voffA);
        if (wr == 1) PG8_BAR;
        PG8_WAIT_V(2); PG8_BAR;
        PG8_STAGE(PG8_SB(1, 0), cB + kstep, voffB); PG8_STAGE(PG8_SA(1, 0), cA + kstep, voffA); PG8_STAGE(PG8_SB(1, 1), cB + hstep + kstep, voffB);
        PG8_WAIT_V(6); PG8_BAR;
    } else {
        PG8_STAGE(PG8_SB(0, 0), cB, voffB); PG8_STAGE(PG8_SA(0, 0), cA, voffA); PG8_STAGE(PG8_SB(0, 1), cB + hstep, voffB); PG8_STAGE(PG8_SA(0, 1), cA + hstep, voffA);
        if (wr == 1) PG8_BAR;
        PG8_WAIT_V(4); PG8_BAR;
        PG8_STAGE(PG8_SB(1, 0), cB + kstep, voffB); PG8_STAGE(PG8_SA(1, 0), cA + kstep, voffA); PG8_STAGE(PG8_SB(1, 1), cB + hstep + kstep, voffB);
        PG8_WAIT_V(6); PG8_BAR;
    }
    for (;;) {
        const bool has_next = S.next(ui + 1, nxt);
        const char* nA = has_next ? nxt.a : cA; const char* nB = has_next ? nxt.b : cB;
        for (int t = 0; t < nt; t += 2) {
            const bool last = (t == nt - 2);
            const char* a1 = cA + (size_t)(t + 1) * kstep;
            const char* a2 = last ? nA : cA + (size_t)(t + 2) * kstep; const char* b2 = last ? nB : cB + (size_t)(t + 2) * kstep;
            const char* a3 = a2 + kstep; const char* b3 = b2 + kstep;
            if (last && has_next) S.a_ready(nxt);
            if constexpr (SP2) {
            PG8_LDB(B0, 0, 0); PG8_LDB(B1, 0, 1); PG8_SCHED; PG8_LDA(At, 0, 0); PG8_STAGE(PG8_SA(1, 1), a1 + hstep, voffA);
            PG8_WAIT_V(8); PG8_WAIT_L(0); PG8_BAR; PG8_MMA(0, 0, At, B0); PG8_MMA(0, 1, At, B1); PG8_BAR; PG8_SCHED;
            PG8_LDA(At, 0, 1); PG8_STAGE(PG8_SB(0, 0), b2, voffB); PG8_STAGE(PG8_SB(0, 1), b2 + hstep, voffB); PG8_STAGE(PG8_SA(0, 0), a2, voffA);
            PG8_WAIT_V(8); PG8_WAIT_L(0); PG8_BAR; PG8_MMA(1, 0, At, B0); PG8_MMA(1, 1, At, B1); PG8_BAR; PG8_SCHED;
            PG8_LDB(B0, 1, 0); PG8_LDB(B1, 1, 1); PG8_SCHED; PG8_LDA(At, 1, 0); PG8_STAGE(PG8_SA(0, 1), a2 + hstep, voffA);
            PG8_WAIT_V(8); PG8_WAIT_L(0); PG8_BAR; PG8_MMA(0, 0, At, B0); PG8_MMA(0, 1, At, B1); PG8_BAR; PG8_SCHED;
            PG8_LDA(At, 1, 1); PG8_STAGE(PG8_SB(1, 0), b3, voffB); PG8_STAGE(PG8_SB(1, 1), b3 + hstep, voffB); PG8_STAGE(PG8_SA(1, 0), a3, voffA);
            PG8_WAIT_V(8); PG8_WAIT_L(0); PG8_BAR; PG8_MMA(1, 0, At, B0); PG8_MMA(1, 1, At, B1); PG8_BAR; PG8_SCHED;
            } else {
            PG8_LDB(B0, 0, 0); PG8_SCHED; PG8_LDA(At, 0, 0); PG8_STAGE(PG8_SA(1, 1), a1 + hstep, voffA);
            PG8_WAIT_L(8); PG8_BAR; PG8_WAIT_L(0); PG8_MMA(0, 0, At, B0); PG8_BAR; PG8_SCHED;
            PG8_LDB(B1, 0, 1); PG8_STAGE(PG8_SB(0, 0), b2, voffB);
            PG8_BAR; PG8_WAIT_L(0); PG8_MMA(0, 1, At, B1); PG8_BAR;
            PG8_LDA(At, 0, 1); PG8_STAGE(PG8_SA(0, 0), a2, voffA);
            PG8_BAR; PG8_WAIT_L(0); PG8_MMA(1, 0, At, B0); PG8_BAR; PG8_SCHED;
            PG8_STAGE(PG8_SB(0, 1), b2 + hstep, voffB);
            PG8_WAIT_V(6); PG8_BAR; PG8_MMA(1, 1, At, B1); PG8_BAR;
            PG8_LDB(B0, 1, 0); PG8_SCHED; PG8_LDA(At, 1, 0); PG8_STAGE(PG8_SA(0, 1), a2 + hstep, voffA);
            PG8_WAIT_L(8); PG8_BAR; PG8_WAIT_L(0); PG8_MMA(0, 0, At, B0); PG8_BAR; PG8_SCHED;
            PG8_LDB(B1, 1, 1); PG8_STAGE(PG8_SB(1, 0), b3, voffB);
            PG8_BAR; PG8_WAIT_L(0); PG8_MMA(0, 1, At, B1); PG8_BAR;
            PG8_LDA(At, 1, 1); PG8_STAGE(PG8_SA(1, 0), a3, voffA);
            PG8_BAR; PG8_WAIT_L(0); PG8_MMA(1, 0, At, B0); PG8_BAR; PG8_SCHED;
            PG8_STAGE(PG8_SB(1, 1), b3 + hstep, voffB);
            PG8_WAIT_V(6); PG8_BAR; PG8_MMA(1, 1, At, B1); PG8_BAR;
            }
        }
        if constexpr (ALIGN_EPI) { if (wr == 0) PG8_BAR; }
        if constexpr (!Epi::AFTER_DRAIN) { E(acc, cur, wr, wc, fr, fq); S.done(cur); }
        if (!has_next) break;
        if (!cur.keep) {
#pragma unroll
        for (int a = 0; a < 2; ++a)
#pragma unroll
            for (int b = 0; b < 2; ++b)
#pragma unroll
                for (int m = 0; m < 4; ++m)
#pragma unroll
                    for (int n = 0; n < 2; ++n) acc[a][b][m][n] = (f32x4){0.f, 0.f, 0.f, 0.f};
        }
        cur = nxt; cA = nA; cB = nB; ++ui;
        if constexpr (ALIGN_EPI) { if (wr == 1) PG8_BAR; }
    }
    PG8_WAIT_V(0);
    if constexpr (!ALIGN_EPI) { if (wr == 0) PG8_BAR; }
    PG8_BAR;
    if constexpr (Epi::AFTER_DRAIN) { E.fused(acc, cur, wr, wc, fr, fq, lds, wid, lane); S.done(cur); }
#undef PG8_SA
#undef PG8_SB
#undef PG8_STAGE
#undef PG8_LDA
#undef PG8_LDB
#undef PG8_MMA
#undef PG8_WAIT_V
#undef PG8_WAIT_L
#undef PG8_BAR
#undef PG8_SCHED
}


typedef f32x4 AccT[2][2][4][2];
struct EpiStoreBf16 {
    static constexpr bool PERM = true, AFTER_DRAIN = false;
    bf16_t* O; int ldc;
    DI void operator()(AccT& acc, const Unit& u, int wr, int wc, int fr, int fq) const {
        const int row0 = u.orow + wr * 64 + fr, col0 = u.ocol + wc * 32 + 8 * fq;
#pragma unroll
        for (int ai = 0; ai < 2; ++ai)
#pragma unroll
            for (int m = 0; m < 4; ++m) { bf16_t* rowp = O + (size_t)(row0 + ai * HALF + m * 16) * ldc + col0;
#pragma unroll
                for (int bj = 0; bj < 2; ++bj) { const f32x4 v0 = acc[ai][bj][m][0], v1 = acc[ai][bj][m][1];
                    u32x4 w; w.x = pk2(v0[0], v0[1]); w.y = pk2(v0[2], v0[3]); w.z = pk2(v1[0], v1[1]); w.w = pk2(v1[2], v1[3]);
                    *(u32x4*)(rowp + bj * HALF) = w; } }
    }
};
struct EpiMerge {
    static constexpr bool PERM = true, AFTER_DRAIN = false;
    const bf16_t* PROJ; bf16_t* Mo;
    DI void operator()(AccT& acc, const Unit& u, int wr, int wc, int fr, int fq) const {
        const int row0 = u.orow + wr * 64 + fr, col0 = u.ocol + wc * 32 + 8 * fq; const int j = u.aux;
#pragma unroll
        for (int ai = 0; ai < 2; ++ai)
#pragma unroll
            for (int m = 0; m < 4; ++m) { const size_t row = (size_t)(row0 + ai * HALF + m * 16);
#pragma unroll
                for (int bj = 0; bj < 2; ++bj) {
                    const bf16_t* gp = PROJ + row * NP + PG + j * 1024 + col0 + bj * HALF;
                    float ga[8], f[8]; unpack8(*(const u32x4*)gp, ga);
                    if (j < 2) { float gb[8]; unpack8(*(const u32x4*)(gp + 1024), gb);
#pragma unroll
                        for (int e = 0; e < 8; ++e) f[e] = (1.f + __expf(-gb[e])) / (1.f + __expf(-ga[e])); }
                    else {
#pragma unroll
                        for (int e = 0; e < 8; ++e) f[e] = 1.f / (1.f + __expf(-ga[e])); }
                    f32x4 v0 = acc[ai][bj][m][0], v1 = acc[ai][bj][m][1];
                    v0[0] *= f[0]; v0[1] *= f[1]; v0[2] *= f[2]; v0[3] *= f[3]; v1[0] *= f[4]; v1[1] *= f[5]; v1[2] *= f[6]; v1[3] *= f[7];
                    acc[ai][bj][m][0] = v0; acc[ai][bj][m][1] = v1;
                    if (j == 2) { u32x4 w; w.x = pk2(v0[0], v0[1]); w.y = pk2(v0[2], v0[3]); w.z = pk2(v1[0], v1[1]); w.w = pk2(v1[2], v1[3]);
                        *(u32x4*)(Mo + row * 1024 + col0 + bj * HALF) = w; } } }
    }
};
struct EpiWo {
    static constexpr bool PERM = false, AFTER_DRAIN = false;
    const float* x_in; const float* ctx_in; const float* XA; int layer; const float* modv  ; float* X1;
    DI void operator()(AccT& acc, const Unit& u, int wr, int wc, int fr, int fq) const {
        const int b = u.orow / TPB, p = u.orow - b * TPB;
        const float* xb; int mrow;
        if (p < CTXL) mrow = 4; else mrow = b;
        if (layer == 0) xb = (p < CTXL) ? ctx_in + (size_t)b * CTXL * DMODEL : x_in + ((size_t)b * SEQL + (p - CTXL)) * DMODEL;
        else xb = XA + (size_t)u.orow * DMODEL;
        const int rl0 = wr * 64 + fr, col0 = u.ocol + wc * 32 + 4 * fq;
        const float* m2 = modv + (size_t)mrow * 6144 + 2 * 1024;
        f32x4 mv[2][2];
#pragma unroll
        for (int bj = 0; bj < 2; ++bj)
#pragma unroll
            for (int n = 0; n < 2; ++n) mv[bj][n] = *(const f32x4*)(m2 + col0 + bj * HALF + n * 16);
#pragma unroll
        for (int ai = 0; ai < 2; ++ai)
#pragma unroll
            for (int m = 0; m < 4; ++m) { const int rl = rl0 + ai * HALF + m * 16; const float* xr = xb + (size_t)rl * DMODEL + col0; float* orow = X1 + (size_t)(u.orow + rl) * DMODEL + col0;
#pragma unroll
                for (int bj = 0; bj < 2; ++bj)
#pragma unroll
                    for (int n = 0; n < 2; ++n) { const f32x4 xv = *(const f32x4*)(xr + bj * HALF + n * 16);
                        *(f32x4*)(orow + bj * HALF + n * 16) = xv * ALPHA_F + mv[bj][n] * acc[ai][bj][m][n]; } }
    }
};
struct EpiGU {
    static constexpr bool PERM = true, AFTER_DRAIN = false;
    bf16_t* HID;
    DI void operator()(AccT& acc, const Unit& u, int wr, int wc, int fr, int fq) const {
        const int row0 = u.orow + wr * 64 + fr, col0 = u.ocol + wc * 32 + 8 * fq;
#pragma unroll
        for (int ai = 0; ai < 2; ++ai)
#pragma unroll
            for (int m = 0; m < 4; ++m) { bf16_t* rowp = HID + (size_t)(row0 + ai * HALF + m * 16) * FF + col0;
                const f32x4 g0 = acc[ai][0][m][0], g1 = acc[ai][0][m][1], u0 = acc[ai][1][m][0], u1 = acc[ai][1][m][1];
                u32x4 w; w.x = pk2(siluf_(g0[0]) * u0[0], siluf_(g0[1]) * u0[1]); w.y = pk2(siluf_(g0[2]) * u0[2], siluf_(g0[3]) * u0[3]);
                w.z = pk2(siluf_(g1[0]) * u1[0], siluf_(g1[1]) * u1[1]); w.w = pk2(siluf_(g1[2]) * u1[2], siluf_(g1[3]) * u1[3]);
                *(u32x4*)rowp = w; }
    }
};
struct EpiDown {
    static constexpr bool PERM = true, AFTER_DRAIN = false;
    bf16_t* Y; const float* affsel;
    DI void operator()(AccT& acc, const Unit& u, int wr, int wc, int fr, int fq) const {
        const int row0 = u.orow + wr * 64 + fr, col0 = u.ocol + wc * 32 + 8 * fq;
#pragma unroll
        for (int ai = 0; ai < 2; ++ai)
#pragma unroll
            for (int m = 0; m < 4; ++m) { const int row = row0 + ai * HALF + m * 16; const float s = affsel[row]; bf16_t* rowp = Y + (size_t)row * 1024 + col0;
#pragma unroll
                for (int bj = 0; bj < 2; ++bj) { const f32x4 v0 = acc[ai][bj][m][0] * s, v1 = acc[ai][bj][m][1] * s;
                    u32x4 w; w.x = pk2(v0[0], v0[1]); w.y = pk2(v0[2], v0[3]); w.z = pk2(v1[0], v1[1]); w.w = pk2(v1[2], v1[3]);
                    *(u32x4*)(rowp + bj * HALF) = w; } }
    }
};

struct NoHooks { DI void a_ready(const Unit&) const {} DI void done(const Unit&) const {} };
struct SchedInProj : NoHooks {
    const char* A; const char* Bt; int G, c;
    DI bool next(int i, Unit& u) const {
        constexpr int nM = MR / 256, nN = NP / 256, nwg = nM * nN, NXCD = 8, WGM = 8;
        const long L = (long)i * G + c; if (L >= nwg) return false;
        int wgid = (int)L; { const int q = nwg / NXCD, r = nwg % NXCD, xcd = wgid % NXCD, off = wgid / NXCD; wgid = (xcd < r ? xcd * (q + 1) : r * (q + 1) + (xcd - r) * q) + off; }
        const int nig = WGM * nN, gid = wgid / nig, fm = gid * WGM, gsz = (nM - fm) < WGM ? (nM - fm) : WGM;
        const int pm = fm + ((wgid % nig) % gsz), pn = (wgid % nig) / gsz;
        u.a = A + (size_t)pm * 256 * 1024 * 2; u.b = Bt + (size_t)pn * 256 * 1024 * 2; u.orow = pm * 256; u.ocol = pn * 256; u.aux = 0; u.keep = 0; return true;
    }
};
template <int NBR> struct SchedTok : NoHooks {
    const char* A0; const char* A1; const char* A2; const char* Bt; int KA  ; int ntile; bool skip_ctx; int G, c;
    DI bool next(int i, Unit& u) const {
        const int k = i / NBR, j = i - k * NBR; const int t = k * G + c; if (t >= ntile) return false;
        const int lt = t >> 2, pn = t & 3; const int pm = skip_ctx ? (lt / 16) * 17 + 1 + (lt % 16) : lt;
        const char* Ab = (j == 0) ? A0 : (j == 1 ? A1 : A2);
        u.a = Ab + (size_t)pm * 256 * KA * 2; u.b = Bt + ((size_t)j * 1024 + pn * 256) * KA * 2; u.orow = pm * 256; u.ocol = pn * 256; u.aux = j; u.keep = (j < NBR - 1); return true;
    }
};
struct SchedExp : NoHooks {
    const char* A; const char* Bt; int KA; int NMT, NPN, OCW  ; int G, c;
    DI bool next(int i, Unit& u) const {
        const int id = i * G + c; if (id >= NEXP * NMT * NPN) return false;
        const int mt = id % NMT, pn = (id / NMT) % NPN, e = id / (NMT * NPN);
        u.a = A + ((size_t)e * ESTR + mt * 256) * KA * 2; u.b = Bt + ((size_t)e * NPN + pn) * 256 * KA * 2; u.orow = e * ESTR + mt * 256; u.ocol = pn * OCW; u.aux = e; u.keep = 0; return true;
    }
};
}

namespace attn_body {
using bf16=__hip_bfloat16;
using bf16x8=__attribute__((ext_vector_type(8)))short;
using s16x4=__attribute__((ext_vector_type(4)))short;
using f32x16=__attribute__((ext_vector_type(16)))float;
using u32x4=__attribute__((ext_vector_type(4)))unsigned;
constexpr int D=64,NW=8,QBLK=32,QB=QBLK*NW,KVBLK=64,QP=512,KP=128;
__device__ __forceinline__ int crow(int r,int hi){return (r&3)+8*(r>>2)+4*hi;}
#define SBAR() __builtin_amdgcn_sched_barrier(0)
__device__ __forceinline__ void cmask(f32x16&p0,f32x16&p1,int jb,int qrel,int hi){
  const float NEG=-INFINITY; int kb=64*jb+4*hi;
  #pragma unroll
  for(int r=0;r<16;++r){int kv=kb+(r&3)+8*(r>>2); if(kv>qrel)p0[r]=NEG; if(kv+32>qrel)p1[r]=NEG;}
}

constexpr int NSLOT=3, SLOTB=8192;
constexpr int LDS_K=0, LDS_V=NSLOT*SLOTB, LDS_WS=2*NSLOT*SLOTB, LDS_OST=LDS_WS+NW*64*4, LDS_BYTES=LDS_OST+NW*4096;
constexpr float C2=0.125f*1.4426950408889634f;
__device__ __forceinline__ void glds16(const void*gsrc,unsigned lds_dst){unsigned keep;
  asm volatile("s_mov_b32 %0, m0\n\ts_mov_b32 m0, %2\n\ts_nop 0\n\tglobal_load_lds_dwordx4 %1, off\n\ts_mov_b32 m0, %0":"=&s"(keep):"v"(gsrc),"s"(lds_dst):"memory");}
__device__ __forceinline__ float max3f(float a,float b,float c){float r;asm("v_max3_f32 %0, %1, %2, %3":"=v"(r):"v"(a),"v"(b),"v"(c));return r;}
__device__ __forceinline__ float max2f(float a,float b){float r;asm("v_max_f32_e32 %0, %1, %2":"=v"(r):"v"(a),"v"(b));return r;}
__device__ __forceinline__ float fadd_s(float a,float b){float r;asm("v_add_f32_e32 %0, %1, %2":"=v"(r):"v"(a),"v"(b));return r;}
__device__ __forceinline__ float fsub_s(float a,float b){float r;asm("v_sub_f32_e32 %0, %1, %2":"=v"(r):"v"(a),"v"(b));return r;}
typedef float f32x2_t __attribute__((ext_vector_type(2))); typedef __bf16 bf16x2_t __attribute__((ext_vector_type(2)));
__device__ __forceinline__ unsigned cvtpk_s(float lo,float hi){f32x2_t v={lo,hi};bf16x2_t b=__builtin_convertvector(v,bf16x2_t);return __builtin_bit_cast(unsigned,b);}
#define WAIT_BAR(N) asm volatile("s_waitcnt vmcnt(" #N ") lgkmcnt(0)\n\ts_barrier":::"memory")

__device__ __forceinline__ void qkt(f32x16&p0,f32x16&p1,const char*Kslot,const bf16x8*qr,const f32x16&negm,int r32,int hi){
  const char*kb=Kslot+hi*1024+r32*16;
  #pragma unroll
  for(int d0=0;d0<4;++d0){
    const bf16x8 b0=*reinterpret_cast<const bf16x8*>(kb+d0*2048);
    const bf16x8 b1=*reinterpret_cast<const bf16x8*>(kb+d0*2048+512);
    if(d0==0){p0=__builtin_amdgcn_mfma_f32_32x32x16_bf16(b0,qr[0],negm,0,0,0);p1=__builtin_amdgcn_mfma_f32_32x32x16_bf16(b1,qr[0],negm,0,0,0);}
    else{p0=__builtin_amdgcn_mfma_f32_32x32x16_bf16(b0,qr[d0],p0,0,0,0);p1=__builtin_amdgcn_mfma_f32_32x32x16_bf16(b1,qr[d0],p1,0,0,0);}}
}
typedef __attribute__((address_space(3))) const char* lds_cptr;
typedef short v4i16_t __attribute__((ext_vector_type(4)));
__device__ __forceinline__ void kload8(bf16x8*kf,lds_cptr kp){
  kf[0]=*(const __attribute__((address_space(3))) bf16x8*)(kp);      kf[1]=*(const __attribute__((address_space(3))) bf16x8*)(kp+512);
  kf[2]=*(const __attribute__((address_space(3))) bf16x8*)(kp+2048); kf[3]=*(const __attribute__((address_space(3))) bf16x8*)(kp+2560);
  kf[4]=*(const __attribute__((address_space(3))) bf16x8*)(kp+4096); kf[5]=*(const __attribute__((address_space(3))) bf16x8*)(kp+4608);
  kf[6]=*(const __attribute__((address_space(3))) bf16x8*)(kp+6144); kf[7]=*(const __attribute__((address_space(3))) bf16x8*)(kp+6656);
}
__device__ __forceinline__ void kload2(bf16x8*kf,lds_cptr kp,int j){ kf[2*j]=*(const __attribute__((address_space(3))) bf16x8*)(kp+j*2048); kf[2*j+1]=*(const __attribute__((address_space(3))) bf16x8*)(kp+j*2048+512); }
__device__ __forceinline__ s16x4 vtr(lds_cptr p){ return __builtin_bit_cast(s16x4,__builtin_amdgcn_ds_read_tr16_b64_v4i16((__attribute__((address_space(3))) v4i16_t*)p)); }
__device__ __forceinline__ float rowmax(const f32x16&p0,const f32x16&p1){
  float a=max3f(p0[0],p0[1],p1[0]),b=max3f(p0[2],p0[3],p1[1]);a=max3f(a,p1[2],p1[3]);
  #pragma unroll
  for(int r=4;r<16;r+=4){a=max3f(a,p0[r],p0[r+1]);b=max3f(b,p0[r+2],p0[r+3]);a=max3f(a,p1[r],p1[r+1]);b=max3f(b,p1[r+2],p1[r+3]);}
  const float m=max2f(a,b);
  auto rr=__builtin_amdgcn_permlane32_swap(__float_as_uint(m),__float_as_uint(m),false,false);
  return max2f(__uint_as_float(rr[0]),__uint_as_float(rr[1]));
}
__device__ __forceinline__ void pv(f32x16*o,int vb,bf16x8 pa0,bf16x8 pa1,bf16x8 pa2,bf16x8 pa3){
  #pragma unroll
  for(int d0=0;d0<2;++d0){s16x4 lo[4],hi[4];
    #pragma unroll
    for(int ks=0;ks<4;++ks){
      asm volatile("ds_read_b64_tr_b16 %0,%1 offset:%c2":"=&v"(lo[ks]):"v"(vb),"i"(d0*4096+ks*1024):"memory");
      asm volatile("ds_read_b64_tr_b16 %0,%1 offset:%c2":"=&v"(hi[ks]):"v"(vb),"i"(d0*4096+ks*1024+512):"memory");}
    asm volatile("s_waitcnt lgkmcnt(0)":::"memory");SBAR();
    #define PK(k) (bf16x8){lo[k][0],lo[k][1],lo[k][2],lo[k][3],hi[k][0],hi[k][1],hi[k][2],hi[k][3]}
    o[d0]=__builtin_amdgcn_mfma_f32_32x32x16_bf16(pa0,PK(0),o[d0],0,0,0);
    o[d0]=__builtin_amdgcn_mfma_f32_32x32x16_bf16(pa1,PK(1),o[d0],0,0,0);
    o[d0]=__builtin_amdgcn_mfma_f32_32x32x16_bf16(pa2,PK(2),o[d0],0,0,0);
    o[d0]=__builtin_amdgcn_mfma_f32_32x32x16_bf16(pa3,PK(3),o[d0],0,0,0);
    #undef PK
  }
}

#ifndef ATTN_STORE16
#define ATTN_STORE16(p,v) (*(u32x4*)(p)=(v))
#endif
template<int THRL> __device__ __forceinline__ void attn_unit(long qrow0,long krow0,int NT_,int h,int g,const bf16*Q,const bf16*__restrict__ K,const bf16*__restrict__ V,bf16*O,char*shm){
  int tid=threadIdx.x; asm volatile("":"+v"(tid)); const int lane=tid&63,r32=lane&31,hi=lane>>5; const int wid=__builtin_amdgcn_readfirstlane(tid>>6);
  const bf16*Qw=Q+(qrow0+wid*QBLK)*QP+h*D;
  const bf16*Kh=K+krow0*KP+g*D,*Vh=V+krow0*KP+g*D;
  const unsigned lds0=(unsigned)(uintptr_t)shm;
  float*wsf=(float*)(shm+LDS_WS)+wid*64;
  const bf16*ksrc=Kh+(long)lane*KP+wid*8;
  const bf16*vsrc=Vh+(long)(16*(wid&3)+(lane>>2))*KP+(wid>>2)*32+(lane&3)*8;
  const unsigned kdst=lds0+LDS_K+wid*1024, vdst=lds0+LDS_V+wid*1024;
  #define DMA_K(t,slot) glds16(ksrc+(long)(t)*KVBLK*KP,(unsigned)__builtin_amdgcn_readfirstlane(kdst+(slot)))
  #define DMA_V(t,slot) glds16(vsrc+(long)(t)*KVBLK*KP,(unsigned)__builtin_amdgcn_readfirstlane(vdst+(slot)))
  const int vb0=(int)(lds0+LDS_V)+((lane>>4)&1)*32+(lane&3)*8+(4*hi+((lane&15)>>2))*64;
  const char*Kbase=shm+LDS_K; bf16x8 kf[8];
  const lds_cptr shm3=(lds_cptr)shm; const lds_cptr kp0=shm3+LDS_K+hi*1024+r32*16; const lds_cptr vp0=shm3+LDS_V+((lane>>4)&1)*32+(lane&3)*8+(4*hi+((lane&15)>>2))*64;
  const int NT=NT_;
  DMA_K(0,0);DMA_V(0,0);DMA_K(1,SLOTB);
  bf16x8 qr[4];
  #pragma unroll
  for(int d0=0;d0<4;++d0)qr[d0]=*reinterpret_cast<const bf16x8*>(&Qw[(long)r32*QP+d0*16+hi*8]);
  float mhat=0.f,l_reg=0.f;f32x16 o[2];o[0]=f32x16{};o[1]=f32x16{};f32x16 negm=f32x16{};asm volatile("":"+v"(negm));
  const int qrel=wid*QBLK+r32;
  #define CMASK(P0,P1,t) do{}while(0)
  bool resc=false;
  #define START(P0,P1) do{ const float rm=rowmax(P0,P1); resc=false; \
    { const float dl=rm; mhat=fadd_s(mhat,dl); \
      _Pragma("unroll") for(int r=0;r<16;++r){P0[r]=fsub_s(P0[r],dl);P1[r]=fsub_s(P1[r],dl);} \
      _Pragma("unroll") for(int r=0;r<16;++r)negm[r]=-mhat; asm volatile("":"+v"(negm)); } \
    _Pragma("unroll") for(int r=0;r<16;++r)P0[r]=__builtin_amdgcn_exp2f(P0[r]); }while(0)
  #define RESC() do{ if(resc){ asm volatile("s_waitcnt lgkmcnt(0)":::"memory"); \
      _Pragma("unroll") for(int d_=0;d_<2;++d_) _Pragma("unroll") for(int r=0;r<16;++r)o[d_][r]*=wsf[crow(r,hi)]; } }while(0)
  f32x16 pA0,pA1,pB0,pB1;
  int sl_prev=0,sl_cur=0,sl_next=SLOTB;
  #define ROT() do{sl_prev=sl_cur;sl_cur=sl_next;sl_next=(sl_next==(NSLOT-1)*SLOTB)?0:sl_next+SLOTB;}while(0)
  DMA_K(2,2*SLOTB);
  WAIT_BAR(3);
  qkt(pA0,pA1,Kbase,qr,negm,r32,hi);asm volatile("s_nop 15\n\ts_nop 7":"+v"(pA0),"+v"(pA1));CMASK(pA0,pA1,0);
  START(pA0,pA1);
  _Pragma("unroll") for(int r=0;r<16;++r)pA1[r]=__builtin_amdgcn_exp2f(pA1[r]);
  WAIT_BAR(0);
  DMA_K(3,0);DMA_V(1,SLOTB);
  ROT();
  kload8(kf,kp0+sl_cur);
  WAIT_BAR(2);
  s16x4 vlo[8],vhi[8]; u32x4 pw0,pw1,pw2,pw3;
  #define PKW(P,B) cvtpk_s(P[B],P[B+1])
  #define PAF(k) __builtin_bit_cast(bf16x8,pw##k)
  #define VFR(i) (bf16x8){vlo[i][0],vlo[i][1],vlo[i][2],vlo[i][3],vhi[i][0],vhi[i][1],vhi[i][2],vhi[i][3]}
  #define PIN(x) asm volatile("":"+v"(x))
  #define MX3(a,b,c) __builtin_fmaxf(__builtin_fmaxf((a),(b)),(c))
  #define GAPA(MF,A0,A1,A2,A3,W0,W1,PW) do{ MF; sacc+=A0; sacc+=A1; sacc+=A2; sacc+=A3; PIN(sacc); W0; W1; PIN(PW); SBAR(); }while(0)
  #define EX(v) __builtin_amdgcn_exp2f(v)
  #define GAPB(MF,X,B) do{ MF; X[B]=EX(X[B]); X[B+1]=EX(X[B+1]); X[B+2]=EX(X[B+2]); X[B+3]=EX(X[B+3]); PIN(X); SBAR(); }while(0)
  #define VRD(i) do{ vlo[i]=vtr(vp_+(((i)>>2)*4096+((i)&3)*1024)); vhi[i]=vtr(vp_+(((i)>>2)*4096+((i)&3)*1024+512)); }while(0)
  #define KRD(G,j) do{ if(G){ kload2(kf,kp0+sl_next,j); SBAR(); } }while(0)
  #define STEP(C0,C1,P0,P1,t,GK,GV,GL) do{ SBAR(); \
    const lds_cptr vp_=vp0+sl_prev; \
    VRD(0); SBAR(); float sacc=(P0[0]+P0[1]); \
    GAPA(C0=__builtin_amdgcn_mfma_f32_32x32x16_bf16(kf[0],qr[0],negm,0,0,0), P0[2],P0[3],P0[4],P0[5],     pw0[0]=PKW(P0,0), pw0[1]=PKW(P0,2), pw0); \
    VRD(4); SBAR(); GAPA(C1=__builtin_amdgcn_mfma_f32_32x32x16_bf16(kf[1],qr[0],negm,0,0,0), P0[6],P0[7],P0[8],P0[9],     pw0[2]=PKW(P0,4), pw0[3]=PKW(P0,6), pw0); \
    VRD(1); SBAR(); GAPA(C0=__builtin_amdgcn_mfma_f32_32x32x16_bf16(kf[2],qr[1],C0,0,0,0),   P0[10],P0[11],P0[12],P0[13], pw1[0]=PKW(P0,8), pw1[1]=PKW(P0,10), pw1); \
    VRD(5); SBAR(); GAPA(C1=__builtin_amdgcn_mfma_f32_32x32x16_bf16(kf[3],qr[1],C1,0,0,0),   P0[14],P0[15],P1[0],P1[1],   pw1[2]=PKW(P0,12),pw1[3]=PKW(P0,14), pw1); \
    VRD(2); SBAR(); GAPA(C0=__builtin_amdgcn_mfma_f32_32x32x16_bf16(kf[4],qr[2],C0,0,0,0),   P1[2],P1[3],P1[4],P1[5],     pw2[0]=PKW(P1,0), pw2[1]=PKW(P1,2), pw2); \
    VRD(6); SBAR(); GAPA(C1=__builtin_amdgcn_mfma_f32_32x32x16_bf16(kf[5],qr[2],C1,0,0,0),   P1[6],P1[7],P1[8],P1[9],     pw2[2]=PKW(P1,4), pw2[3]=PKW(P1,6), pw2); \
    VRD(3); SBAR(); GAPA(C0=__builtin_amdgcn_mfma_f32_32x32x16_bf16(kf[6],qr[3],C0,0,0,0),   P1[10],P1[11],P1[12],P1[13], pw3[0]=PKW(P1,8), pw3[1]=PKW(P1,10), pw3); \
    VRD(7); SBAR(); GAPA(C1=__builtin_amdgcn_mfma_f32_32x32x16_bf16(kf[7],qr[3],C1,0,0,0),   P1[14],P1[15],0.f,0.f,       pw3[2]=PKW(P1,12),pw3[3]=PKW(P1,14), pw3); \
    l_reg+=sacc; \
    if(GK){DMA_K((t)+3,sl_cur);} if(GV){DMA_V((t)+1,sl_next);} \
    CMASK(C0,C1,t); \
    { float a=MX3(C0[0],C0[1],C1[0]),b=MX3(C0[2],C0[3],C1[1]); a=MX3(a,C1[2],C1[3]); \
      _Pragma("unroll") for(int r=4;r<16;r+=4){a=MX3(a,C0[r],C0[r+1]);b=MX3(b,C0[r+2],C0[r+3]);a=MX3(a,C1[r],C1[r+1]);b=MX3(b,C1[r+2],C1[r+3]);} \
      float rm=__builtin_fmaxf(a,b); { auto rr=__builtin_amdgcn_permlane32_swap(__float_as_uint(rm),__float_as_uint(rm),false,false); rm=__builtin_fmaxf(__uint_as_float(rr[0]),__uint_as_float(rr[1])); } \
      resc=false; \
      if(__builtin_expect(__any(rm>(float)THRL),0)){ const float dl=__builtin_fmaxf(rm,0.f); mhat+=dl; \
        _Pragma("unroll") for(int r=0;r<16;++r){C0[r]-=dl;C1[r]-=dl;} \
        _Pragma("unroll") for(int r=0;r<16;++r)negm[r]=-mhat; asm volatile("":"+v"(negm)); \
        const float f=__builtin_amdgcn_exp2f(-dl); l_reg*=f; if(hi==0)wsf[r32]=f; resc=true; } } \
    SBAR(); \
    GAPB(o[0]=__builtin_amdgcn_mfma_f32_32x32x16_bf16(PAF(0),VFR(0),o[0],0,0,0), C0,0); \
    GAPB(o[1]=__builtin_amdgcn_mfma_f32_32x32x16_bf16(PAF(0),VFR(4),o[1],0,0,0), C0,4); \
    KRD(GL,0); GAPB(o[0]=__builtin_amdgcn_mfma_f32_32x32x16_bf16(PAF(1),VFR(1),o[0],0,0,0), C0,8); \
    KRD(GL,1); GAPB(o[1]=__builtin_amdgcn_mfma_f32_32x32x16_bf16(PAF(1),VFR(5),o[1],0,0,0), C0,12); \
    KRD(GL,2); GAPB(o[0]=__builtin_amdgcn_mfma_f32_32x32x16_bf16(PAF(2),VFR(2),o[0],0,0,0), C1,0); \
    KRD(GL,3); GAPB(o[1]=__builtin_amdgcn_mfma_f32_32x32x16_bf16(PAF(2),VFR(6),o[1],0,0,0), C1,4); \
    GAPB(o[0]=__builtin_amdgcn_mfma_f32_32x32x16_bf16(PAF(3),VFR(3),o[0],0,0,0), C1,8); \
    GAPB(o[1]=__builtin_amdgcn_mfma_f32_32x32x16_bf16(PAF(3),VFR(7),o[1],0,0,0), C1,12); \
    }while(0)
  int t=1;
  #undef CMASK
  #define CMASK(P0,P1,t) do{}while(0)
  for(;t+5<NT;t+=2){
    STEP(pB0,pB1,pA0,pA1,t,true,true,true);     WAIT_BAR(2); RESC(); ROT();
    STEP(pA0,pA1,pB0,pB1,t+1,true,true,true);   WAIT_BAR(2); RESC(); ROT();
  }
  #undef CMASK
  #define CMASK(P0,P1,t) do{}while(0)
  #define ENDW(tt) do{ if((tt)+3<NT){WAIT_BAR(2);} else if((tt)+2<NT){WAIT_BAR(1);} else {WAIT_BAR(0);} }while(0)
  for(;t+1<NT;t+=2){
    STEP(pB0,pB1,pA0,pA1,t,(t+3<NT),(t+1<NT),(t+1<NT));       ENDW(t);   RESC(); ROT();
    STEP(pA0,pA1,pB0,pB1,t+1,(t+4<NT),(t+2<NT),(t+2<NT));     ENDW(t+1); RESC(); ROT();
  }
  STEP(pB0,pB1,pA0,pA1,NT-1,false,false,false); RESC();
  { float sacc=pB0[0]+pB0[1]; _Pragma("unroll") for(int r=2;r<16;++r)sacc+=pB0[r]; _Pragma("unroll") for(int r=0;r<16;++r)sacc+=pB1[r]; l_reg+=sacc;
    pw0=(u32x4){PKW(pB0,0),PKW(pB0,2),PKW(pB0,4),PKW(pB0,6)};pw1=(u32x4){PKW(pB0,8),PKW(pB0,10),PKW(pB0,12),PKW(pB0,14)};pw2=(u32x4){PKW(pB1,0),PKW(pB1,2),PKW(pB1,4),PKW(pB1,6)};pw3=(u32x4){PKW(pB1,8),PKW(pB1,10),PKW(pB1,12),PKW(pB1,14)};
    SBAR(); pv(o,vb0+sl_cur,PAF(0),PAF(1),PAF(2),PAF(3)); }
  #undef PKW
  #undef PAF
  #undef VFR
  #undef PIN
  #undef MX3
  #undef GAPA
  #undef GAPB
  #undef EX
  #undef VRD
  #undef KRD
  #undef STEP
  #undef ENDW
  {auto rr=__builtin_amdgcn_permlane32_swap(__float_as_uint(l_reg),__float_as_uint(l_reg),false,false);l_reg=__uint_as_float(rr[0])+__uint_as_float(rr[1]);}
  if(hi==0)wsf[32+r32]=l_reg;asm volatile("s_waitcnt lgkmcnt(0)":::"memory");
  float rli[16];
  #pragma unroll
  for(int r=0;r<16;++r)rli[r]=__builtin_amdgcn_rcpf(wsf[32+crow(r,hi)]);
  bf16*Ow=O+(qrow0+wid*QBLK)*QP+h*D;
  { bf16*stg=(bf16*)(shm+LDS_OST)+wid*2048;
    #pragma unroll
    for(int r=0;r<16;++r){const int orow=crow(r,hi);
      #pragma unroll
      for(int d0=0;d0<2;++d0)stg[orow*64+d0*32+r32]=__float2bfloat16(o[d0][r]*rli[r]);}
    asm volatile("s_waitcnt lgkmcnt(0)":::"memory");
    #pragma unroll
    for(int i=0;i<4;++i){const int row=i*8+(lane>>3),ch=lane&7; const u32x4 v=*(const u32x4*)(stg+row*64+ch*8); ATTN_STORE16(Ow+(long)row*QP+ch*8,v);} }
  asm volatile("s_waitcnt lgkmcnt(0)\n\ts_barrier":::"memory");
  #undef DMA_K
  #undef DMA_V
  #undef CMASK
  #undef START
  #undef RESC
  #undef ROT
}

#undef SBAR
#undef WAIT_BAR
}

#define LDSW() asm volatile("s_waitcnt lgkmcnt(0)" ::: "memory")
#define MFMA32(a, b, c) __builtin_amdgcn_mfma_f32_32x32x16_bf16((a), (b), (c), 0, 0, 0)
struct Tctx { int tid, lane, wave, G, blk, gw, NGW; };
DI Tctx opaque_ctx(const Tctx& T0) { Tctx t = T0; asm volatile("" : "+v"(t.tid)); asm volatile("" : "+s"(t.blk));
    t.lane = t.tid & 63; t.wave = __builtin_amdgcn_readfirstlane(t.tid >> 6); t.gw = t.blk * 8 + t.wave; return t; }

DI void transpose_item64(const float* src, int ld, bf16_t* dst, int ldd, LAS float* scr, int lane) {
    f32x4 v[16];
#pragma unroll
    for (int j = 0; j < 16; ++j) v[j] = *(const f32x4*)(src + (size_t)(4 * j + (lane >> 4)) * ld + 4 * (lane & 15));
#pragma unroll
    for (int j = 0; j < 16; ++j) { LAS float* s = scr + (4 * j + (lane >> 4)) * 65 + 4 * (lane & 15); s[0] = v[j].x; s[1] = v[j].y; s[2] = v[j].z; s[3] = v[j].w; }
    LDSW();
    const int c = lane & 7;
#pragma unroll
    for (int j = 0; j < 8; ++j) { const int n = (lane >> 3) + 8 * j; const LAS float* s = scr + (8 * c) * 65 + n;
        u32x4 o; o.x = pk2(s[0], s[65]); o.y = pk2(s[130], s[195]); o.z = pk2(s[260], s[325]); o.w = pk2(s[390], s[455]);
        *(u32x4*)(dst + (size_t)n * ldd + 8 * c) = o; }
    LDSW();
}
DI void p0_convert(const Params& P, const Tctx& T0, unsigned char* lds) { const Tctx T = opaque_ctx(T0);
    LAS float* scr = (LAS float*)lds + T.wave * (64 * 65);
    bf16_t* WIN = (bf16_t*)(P.ws + WS_WIN); bf16_t* WBR = (bf16_t*)(P.ws + WS_WBR); bf16_t* WO = (bf16_t*)(P.ws + WS_WO); bf16_t* WGU = (bf16_t*)(P.ws + WS_WGU); bf16_t* WD = (bf16_t*)(P.ws + WS_WD);
    constexpr int I_IN = 16 * 104, I_BR = 8 * 16, I_O = 16 * 16, I_G = 16 * 32, I_D = 32 * 16;
    constexpr int PER_LAYER = I_IN + 3 * I_BR + I_O + NEXP * (2 * I_G + I_D);
    for (int it0 = T.gw; it0 < NLAYER * PER_LAYER; it0 += T.NGW) {
        const int l = it0 / PER_LAYER; int it = it0 - l * PER_LAYER;
        if (it < I_IN) { const int kb = it / 104, nb = it % 104; const int scol = nb * 64 + (nb >= 16 ? 16 : 0);
            transpose_item64(P.w_in + ((size_t)l * 1024 + kb * 64) * IN_COLS + scol, IN_COLS, WIN + ((size_t)l * NP + nb * 64) * 1024 + kb * 64, 1024, scr, T.lane); continue; }
        it -= I_IN;
        if (it < 3 * I_BR) { const int j = it / I_BR; it -= j * I_BR; const int kb = it / 16, nb = it % 16; const float* w = (j == 0) ? P.w_br_attn : (j == 1 ? P.w_br_ssd : P.w_br_conv);
            transpose_item64(w + ((size_t)l * 512 + kb * 64) * 1024 + nb * 64, 1024, WBR + (((size_t)l * 3 + j) * 1024 + nb * 64) * 512 + kb * 64, 512, scr, T.lane); continue; }
        it -= 3 * I_BR;
        if (it < I_O) { const int kb = it / 16, nb = it % 16;
            transpose_item64(P.w_o + ((size_t)l * 1024 + kb * 64) * 1024 + nb * 64, 1024, WO + ((size_t)l * 1024 + nb * 64) * 1024 + kb * 64, 1024, scr, T.lane); continue; }
        it -= I_O;
        const int e = it / (2 * I_G + I_D); it -= e * (2 * I_G + I_D);
        if (it < 2 * I_G) { const int up = it / I_G; it -= up * I_G; const int kb = it / 32, nb = it % 32; const float* w = up ? P.w_exp_up : P.w_exp_gate;
            const int f0 = nb * 64, pn = f0 >> 7, within = f0 & 127; const size_t drow = ((size_t)(l * NEXP + e) * 16 + pn) * 256 + up * 128 + within;
            transpose_item64(w + (((size_t)l * NEXP + e) * 1024 + kb * 64) * 2048 + nb * 64, 2048, WGU + drow * 1024 + kb * 64, 1024, scr, T.lane); continue; }
        it -= 2 * I_G;
        { const int kb = it / 16, nb = it % 16;
            transpose_item64(P.w_exp_down + (((size_t)l * NEXP + e) * 2048 + kb * 64) * 1024 + nb * 64, 1024, WD + (((size_t)l * NEXP + e) * 1024 + nb * 64) * 2048 + kb * 64, 2048, scr, T.lane); }
    }
}
DI void p0_modv(const Params& P, const Tctx& T0, unsigned char* lds_, int item) { const Tctx T = opaque_ctx(T0);
    LAS float* lds = (LAS float*)lds_;
    const int layer = item / 96, jb = item % 96;
    for (int i = T.tid; i < 5120; i += 512) { const int row = i >> 10, k = i & 1023; const float cv = row < 4 ? P.c[row * 1024 + k] : P.c_ctx[k]; lds[i] = siluf_(cv); }
    __syncthreads();
    const int col = T.tid & 63, ks = T.tid >> 6;
    const float* w = P.w_mod + ((size_t)layer * 1024 + ks * 128) * 6144 + jb * 64 + col;
    float a0 = 0.f, a1 = 0.f, a2 = 0.f, a3 = 0.f, a4 = 0.f;
#pragma unroll 8
    for (int k = 0; k < 128; ++k) { const float wv = w[(size_t)k * 6144]; const int kk = ks * 128 + k;
        a0 += lds[kk] * wv; a1 += lds[1024 + kk] * wv; a2 += lds[2048 + kk] * wv; a3 += lds[3072 + kk] * wv; a4 += lds[4096 + kk] * wv; }
    LAS float* red = lds + 5120;
    red[(ks * 5 + 0) * 64 + col] = a0; red[(ks * 5 + 1) * 64 + col] = a1; red[(ks * 5 + 2) * 64 + col] = a2; red[(ks * 5 + 3) * 64 + col] = a3; red[(ks * 5 + 4) * 64 + col] = a4;
    __syncthreads();
    if (T.tid < 320) { const int row = T.tid >> 6, cc = T.tid & 63; float s = 0.f;
#pragma unroll
        for (int q = 0; q < 8; ++q) s += red[(q * 5 + row) * 64 + cc];
        ((float*)(P.ws + WS_MODV))[((size_t)layer * 5 + row) * 6144 + jb * 64 + cc] = s + P.b_mod[(size_t)layer * 6144 + jb * 64 + cc]; }
    __syncthreads();
}
DI void p0_rope(const Params& P, const Tctx& T0) { const Tctx T = opaque_ctx(T0);
    float* tab = (float*)(P.ws + WS_ROPE);
    for (int i = T.tid; i < 1024; i += 512) { const int pos = i >> 4, j = i & 15;
        const float inv = exp2f(-(float)j * (13.287712379549449f / 16.f));
        const float ang = (float)pos * inv; float rev = ang * 0.15915494309189535f; rev -= floorf(rev);
        tab[2 * i] = __builtin_amdgcn_cosf(rev); tab[2 * i + 1] = __builtin_amdgcn_sinf(rev); }
}

DI void ln_norm(f32x4 (&v)[4]) {
    float s = 0.f;
#pragma unroll
    for (int j = 0; j < 4; ++j) s += (v[j].x + v[j].y) + (v[j].z + v[j].w);
    const float mean = wave_sum(s) * (1.f / DMODEL); float s2 = 0.f;
#pragma unroll
    for (int j = 0; j < 4; ++j) { v[j] = v[j] - mean; s2 += (v[j].x * v[j].x + v[j].y * v[j].y) + (v[j].z * v[j].z + v[j].w * v[j].w); }
    const float rstd = rsqrtf(wave_sum(s2) * (1.f / DMODEL) + EPSF);
#pragma unroll
    for (int j = 0; j < 4; ++j) v[j] = v[j] * rstd;
}
DI void load_row(const float* p, int lane, f32x4 (&v)[4]) {
#pragma unroll
    for (int j = 0; j < 4; ++j) v[j] = *((const f32x4*)p + lane + 64 * j);
}
DI void store_row(float* p, int lane, const f32x4 (&v)[4]) {
#pragma unroll
    for (int j = 0; j < 4; ++j) *((f32x4*)p + lane + 64 * j) = v[j];
}
DI void store_row_bf16(bf16_t* p, int lane, const f32x4 (&v)[4]) {
#pragma unroll
    for (int j = 0; j < 4; ++j) { u32x2 o; o.x = pk2(v[j].x, v[j].y); o.y = pk2(v[j].z, v[j].w); *((u32x2*)p + lane + 64 * j) = o; }
}
DI void stage_w16(LAS float* Wl, const float* src, int ld, int tid) {
    for (int idx = tid; idx < 16384; idx += 512) { const int k = idx >> 4, jj = idx & 15; const int j = k >> 8, l = (k & 255) >> 2, e = k & 3;
        Wl[((j * 4 + e) * 64 + l) * 16 + jj] = src[(size_t)k * ld + jj]; }
}
DI void row_dot16(const f32x4 (&h)[4], const LAS float* Wl, int lane, float (&s)[16]) {
#pragma unroll
    for (int q = 0; q < 16; ++q) s[q] = 0.f;
#pragma unroll
    for (int j = 0; j < 4; ++j)
#pragma unroll
        for (int e = 0; e < 4; ++e) { const float x = h[j][e]; const LAS f32x4* wp = (const LAS f32x4*)(Wl + ((j * 4 + e) * 64 + lane) * 16);
#pragma unroll
            for (int q = 0; q < 4; ++q) { const f32x4 w = wp[q]; s[4 * q] += x * w.x; s[4 * q + 1] += x * w.y; s[4 * q + 2] += x * w.z; s[4 * q + 3] += x * w.w; }
            if (e & 1) asm volatile("" ::: "memory"); }
}

DI void p1_modulate(const Params& P, const Tctx& T0, unsigned char* lds, int layer) { const Tctx T = opaque_ctx(T0);
    LAS float* Wl = (LAS float*)lds;
    stage_w16(Wl, P.w_in + (size_t)layer * 1024 * IN_COLS + 1024, IN_COLS, T.tid);
    __syncthreads();
    const float* modv = (const float*)(P.ws + WS_MODV) + (size_t)layer * 5 * 6144;
    bf16_t* H = (bf16_t*)(P.ws + WS_H); float* DT = (float*)(P.ws + WS_DT);
    for (int r = T.gw; r < MR; r += T.NGW) {
        int b, p; row_bp(r, b, p); const int mrow = p < CTXL ? 4 : b;
        f32x4 v[4]; load_row(xsrc_row(P, layer, r), T.lane, v); ln_norm(v);
        const float* mv = modv + (size_t)mrow * 6144;
#pragma unroll
        for (int j = 0; j < 4; ++j) { const f32x4 sh = *((const f32x4*)mv + T.lane + 64 * j), sc = *((const f32x4*)(mv + 1024) + T.lane + 64 * j); v[j] = v[j] * (sc + 1.f) + sh; }
        store_row_bf16(H + (size_t)r * DMODEL, T.lane, v);
        float s[16]; row_dot16(v, Wl, T.lane, s); float mine = 0.f;
#pragma unroll
        for (int q = 0; q < 16; ++q) { const float t = wave_sum(s[q]); if (T.lane == q) mine = t; }
        if (T.lane < 16) { const float xx = mine + P.ssd_dt_bias[layer * 16 + T.lane]; DT[(size_t)r * 16 + T.lane] = xx > 20.f ? xx : __logf(1.f + __expf(xx)); }
    }
    __syncthreads();
}

DI void norm_rope8(float (&y)[8], const float* nw, int lq, bool do_rope, const float* tab_row, const float* tab_col, float outscale) {
    float ss = 0.f;
#pragma unroll
    for (int e = 0; e < 8; ++e) ss += y[e] * y[e];
    ss += __shfl_xor(ss, 1); ss += __shfl_xor(ss, 2); ss += __shfl_xor(ss, 4);
    const float rstd = rsqrtf(ss * (1.f / 64.f) + EPSF);
#pragma unroll
    for (int e = 0; e < 8; ++e) y[e] = y[e] * rstd * nw[8 * lq + e];
    if (do_rope) { const int axis = lq >> 2, half = (lq >> 1) & 1, j0 = 8 * (lq & 1); const float* tab = (axis ? tab_col : tab_row) + 2 * j0;
#pragma unroll
        for (int e = 0; e < 8; ++e) { const float pr = __shfl_xor(y[e], 2); const float cs = tab[2 * e], sn = tab[2 * e + 1]; y[e] = half ? y[e] * cs + pr * sn : y[e] * cs - pr * sn; } }
#pragma unroll
    for (int e = 0; e < 8; ++e) y[e] *= outscale;
}
DI void p3_post(const Params& P, const Tctx& T0, int layer) { const Tctx T = opaque_ctx(T0);
    const bf16_t* PROJ = (const bf16_t*)(P.ws + WS_PROJ); const float* rope = (const float*)(P.ws + WS_ROPE);
    bf16_t* Qf = (bf16_t*)(P.ws + WS_Q); bf16_t* Kf = (bf16_t*)(P.ws + WS_K); bf16_t* Vf = (bf16_t*)(P.ws + WS_V); bf16_t* XBC = (bf16_t*)(P.ws + WS_XBC); bf16_t* YC = (bf16_t*)(P.ws + WS_YC);
    const int lane = T.lane, lq = lane & 7;
    for (int r = T.gw; r < MR; r += T.NGW) {
        int b, p; row_bp(r, b, p); const bool isctx = p < CTXL; const int pos = isctx ? 0 : p - CTXL;
        const float* trow = rope + (size_t)(pos >> 6) * 32; const float* tcol = rope + (size_t)(pos & 63) * 32;
        const bf16_t* pr = PROJ + (size_t)r * NP;
        { float y[8]; unpack8(*(const u32x4*)(pr + PQ + 8 * lane), y); norm_rope8(y, P.q_norm + layer * 64, lq, !isctx, trow, tcol, QSCALE); *(u32x4*)(Qf + (size_t)r * 512 + 8 * lane) = pack8(y); }
        { const int l16 = lane & 15; float y[8]; unpack8(*(const u32x4*)(pr + PK + 8 * l16), y); norm_rope8(y, P.k_norm + layer * 64, lq, !isctx, trow, tcol, 1.f);
          if (lane < 16) *(u32x4*)(Kf + (size_t)r * 128 + 8 * lane) = pack8(y);
          else if (lane < 32) *(u32x4*)(Vf + (size_t)r * 128 + 8 * (lane - 16)) = *(const u32x4*)(pr + PV + 8 * (lane - 16)); }
        const bool hasprev = !(p == 0 || p == CTXL), hasnext = !(p == CTXL - 1 || p == TPB - 1);
#pragma unroll
        for (int pass = 0; pass < 2; ++pass) { const int ch0 = 8 * lane + 512 * pass;
            if (ch0 < 768) { float cu[8], pv[8], nx[8]; unpack8(*(const u32x4*)(pr + PXBC + ch0), cu);
                if (hasprev) unpack8(*(const u32x4*)(pr - NP + PXBC + ch0), pv); else {
#pragma unroll
                    for (int e = 0; e < 8; ++e) pv[e] = 0.f; }
                if (hasnext) unpack8(*(const u32x4*)(pr + NP + PXBC + ch0), nx); else {
#pragma unroll
                    for (int e = 0; e < 8; ++e) nx[e] = 0.f; }
                const float* cw = P.ssd_conv_w + (size_t)layer * 3 * 768 + ch0; const float* cb = P.ssd_conv_b + (size_t)layer * 768 + ch0; float o[8];
#pragma unroll
                for (int e = 0; e < 8; ++e) { const float t = cw[e] * pv[e] + cw[768 + e] * cu[e] + cw[1536 + e] * nx[e] + cb[e]; o[e] = siluf_(t); }
                *(u32x4*)(XBC + (size_t)r * 768 + ch0) = pack8(o); } }
        { const int ch0 = 8 * lane; float bq[8], c0[8], x0[8], c1[8], x1[8], c2[8], x2[8];
            unpack8(*(const u32x4*)(pr + PSCB + ch0), bq); unpack8(*(const u32x4*)(pr + PSCC + ch0), c1); unpack8(*(const u32x4*)(pr + PSCX + ch0), x1);
            if (hasprev) { unpack8(*(const u32x4*)(pr - NP + PSCC + ch0), c0); unpack8(*(const u32x4*)(pr - NP + PSCX + ch0), x0); } else {
#pragma unroll
                for (int e = 0; e < 8; ++e) { c0[e] = 0.f; x0[e] = 0.f; } }
            if (hasnext) { unpack8(*(const u32x4*)(pr + NP + PSCC + ch0), c2); unpack8(*(const u32x4*)(pr + NP + PSCX + ch0), x2); } else {
#pragma unroll
                for (int e = 0; e < 8; ++e) { c2[e] = 0.f; x2[e] = 0.f; } }
            const float* cw = P.sc_conv_w + (size_t)layer * 3 * 512 + ch0; float o[8];
#pragma unroll
            for (int e = 0; e < 8; ++e) o[e] = bq[e] * (cw[e] * (c0[e] * x0[e]) + cw[512 + e] * (c1[e] * x1[e]) + cw[1024 + e] * (c2[e] * x2[e]));
            *(u32x4*)(YC + (size_t)r * 512 + ch0) = pack8(o); }
    }
}

constexpr int XT_LD = 136;
DI void ssd_stage_t(const bf16_t* src, int ld, int nch8  , LAS bf16_t* dstT, int tid, int nload) {
    for (int i = 0; i < nload; ++i) { const int q = tid + 512 * i; const int s = q / nch8, ch0 = (q % nch8) * 8;
        const u32x4 v = *(const u32x4*)(src + (size_t)s * ld + ch0); LAS bf16_t* d = dstT + ch0 * XT_LD + s;
        d[0] = (bf16_t)(v.x & 0xffff); d[XT_LD] = (bf16_t)(v.x >> 16); d[2 * XT_LD] = (bf16_t)(v.y & 0xffff); d[3 * XT_LD] = (bf16_t)(v.y >> 16);
        d[4 * XT_LD] = (bf16_t)(v.z & 0xffff); d[5 * XT_LD] = (bf16_t)(v.z >> 16); d[6 * XT_LD] = (bf16_t)(v.w & 0xffff); d[7 * XT_LD] = (bf16_t)(v.w >> 16); }
}
DI bf16x8 scale8(const u32x4 v, const float (&w)[8]) { float f[8]; unpack8(v, f);
#pragma unroll
    for (int e = 0; e < 8; ++e) f[e] *= w[e];
    return __builtin_bit_cast(bf16x8, pack8(f)); }
DI bf16x8 scale8s(const u32x4 v, float w) { float f[8]; unpack8(v, f);
#pragma unroll
    for (int e = 0; e < 8; ++e) f[e] *= w;
    return __builtin_bit_cast(bf16x8, pack8(f)); }

DI void ssd_a(const Params& P, const Tctx& T0, unsigned char* lds_, int layer) { const Tctx T = opaque_ctx(T0);
    const bf16_t* XBC = (const bf16_t*)(P.ws + WS_XBC); const float* DT = (const float*)(P.ws + WS_DT); float* ACS = (float*)(P.ws + WS_ACS); float* ST = (float*)(P.ws + WS_ST);
    LAS bf16_t* XT = (LAS bf16_t*)lds_; LAS bf16_t* BT = (LAS bf16_t*)(lds_ + 69632); LAS float* lw = (LAS float*)(lds_ + 87040);
    const int lane = T.lane, w = T.wave, r = lane & 31, hb = lane >> 5;
    for (int u = T.blk; u < NBATCH * NCH * 2; u += T.G) {
        const int g = u & 1, c = (u >> 1) % NCH, b = u / (2 * NCH); const int r0 = b * TPB + c * 128;
        const int hh = w & 3, dir = w >> 2, h = 4 * g + hh, dh = dir * 8 + h;
        { const float a = -__expf(P.ssd_a_log[layer * 16 + dh]); const int l0 = 2 * lane;
          const float d0 = DT[(size_t)(r0 + l0) * 16 + dh], d1 = DT[(size_t)(r0 + l0 + 1) * 16 + dh]; const float v0 = d0 * a, v1 = d1 * a; const float s = v0 + v1; float Pf = s;
#pragma unroll
          for (int o = 1; o < 64; o <<= 1) { const float t = __shfl_up(Pf, o); if (lane >= o) Pf += t; }
          const float tot = __shfl(Pf, 63); float a0, a1;
          if (dir == 0) { a0 = Pf - v1; a1 = Pf; } else { const float S = tot - Pf + s; a0 = S; a1 = S - v0; }
          ACS[(size_t)(r0 + l0) * 16 + dh] = a0; ACS[(size_t)(r0 + l0 + 1) * 16 + dh] = a1;
          lw[w * 128 + l0] = __expf(tot - a0) * d0; lw[w * 128 + l0 + 1] = __expf(tot - a1) * d1; }
        ssd_stage_t(XBC + (size_t)r0 * 768 + 256 * g, 768, 32, XT, T.tid, 8);
        ssd_stage_t(XBC + (size_t)r0 * 768 + 512 + 64 * g, 768, 8, BT, T.tid, 2);
        __syncthreads();
        f32x16 acc[2][2];
#pragma unroll
        for (int i = 0; i < 2; ++i)
#pragma unroll
            for (int j = 0; j < 2; ++j)
#pragma unroll
                for (int q = 0; q < 16; ++q) acc[i][j][q] = 0.f;
#pragma unroll 2
        for (int kk = 0; kk < 8; ++kk) { float wv[8]; { const f32x4 w0 = *(const LAS f32x4*)(lw + w * 128 + 16 * kk + 8 * hb), w1 = *(const LAS f32x4*)(lw + w * 128 + 16 * kk + 8 * hb + 4);
                wv[0] = w0.x; wv[1] = w0.y; wv[2] = w0.z; wv[3] = w0.w; wv[4] = w1.x; wv[5] = w1.y; wv[6] = w1.z; wv[7] = w1.w; }
            bf16x8 af[2], bfr[2];
#pragma unroll
            for (int pt = 0; pt < 2; ++pt) af[pt] = scale8(*(const LAS u32x4*)(XT + (64 * hh + 32 * pt + r) * XT_LD + 16 * kk + 8 * hb), wv);
#pragma unroll
            for (int nt = 0; nt < 2; ++nt) bfr[nt] = *(const LAS bf16x8*)(BT + (32 * nt + r) * XT_LD + 16 * kk + 8 * hb);
#pragma unroll
            for (int pt = 0; pt < 2; ++pt)
#pragma unroll
                for (int nt = 0; nt < 2; ++nt) acc[pt][nt] = MFMA32(af[pt], bfr[nt], acc[pt][nt]); }
        float* st = ST + ((((size_t)dir * NBATCH + b) * NCH + c) * 8 + h) * 4096;
#pragma unroll
        for (int pt = 0; pt < 2; ++pt)
#pragma unroll
            for (int nt = 0; nt < 2; ++nt)
#pragma unroll
                for (int i = 0; i < 16; ++i) st[(32 * pt + crow(i, hb)) * 64 + 32 * nt + r] = acc[pt][nt][i];
        __syncthreads();
    }
}
DI void ssd_b(const Params& P, const Tctx& T0) { const Tctx T = opaque_ctx(T0);
    float* ST = (float*)(P.ws + WS_ST); const float* ACS = (const float*)(P.ws + WS_ACS);
    for (int e = T.blk * 512 + T.tid; e < 2 * NBATCH * 8 * 4096; e += T.G * 512) {
        const int pn = e & 4095, h = (e >> 12) & 7, b = (e >> 15) & 3, dir = e >> 17; float hs = 0.f;
#pragma unroll 2
        for (int i = 0; i < NCH; ++i) { const int c = dir == 0 ? i : (i < 2 ? 1 - i : NCH + 1 - i);
            float* sp = ST + ((((size_t)dir * NBATCH + b) * NCH + c) * 8 + h) * 4096 + pn;
            const float dec = __expf(ACS[(size_t)(b * TPB + c * 128 + (dir == 0 ? 127 : 0)) * 16 + dir * 8 + h]);
            const float st = *sp; *sp = hs; hs = dec * hs + st; }
    }
}
DI void ssd_c(const Params& P, const Tctx& T0, unsigned char* lds_, int layer) { const Tctx T = opaque_ctx(T0);
    const bf16_t* XBC = (const bf16_t*)(P.ws + WS_XBC); const float* DT = (const float*)(P.ws + WS_DT); const float* ACS = (const float*)(P.ws + WS_ACS); const float* ST = (const float*)(P.ws + WS_ST);
    bf16_t* YRAW = (bf16_t*)(P.ws + WS_YRAW);
    LAS bf16_t* XT = (LAS bf16_t*)lds_; LAS bf16_t* Wst = (LAS bf16_t*)(lds_ + 69632) + T.wave * (32 * XT_LD); LAS float* lacs = (LAS float*)(lds_ + 139264);
    const int lane = T.lane, w = T.wave, r = lane & 31, hb = lane >> 5;
    for (int u = T.blk; u < NBATCH * NCH * 2; u += T.G) {
        const int g = u & 1, c = (u >> 1) % NCH, b = u / (2 * NCH); const int r0 = b * TPB + c * 128;
        const int hh = w & 3, half = w >> 2, h = 4 * g + hh;
        for (int i = T.tid; i < 1024; i += 512) { const int l = i & 127, dd = (i >> 7) & 1, h4 = i >> 8; lacs[i] = ACS[(size_t)(r0 + l) * 16 + dd * 8 + 4 * g + h4]; }
        ssd_stage_t(XBC + (size_t)r0 * 768 + 256 * g, 768, 32, XT, T.tid, 8);
        __syncthreads();
        float acsf_s[4], acsb_s[4], dtf_s[4], dtb_s[4];
#pragma unroll
        for (int j = 0; j < 4; ++j) { const int s = 32 * j + r; acsf_s[j] = lacs[(hh * 2) * 128 + s]; acsb_s[j] = lacs[(hh * 2 + 1) * 128 + s];
            dtf_s[j] = DT[(size_t)(r0 + s) * 16 + h]; dtb_s[j] = DT[(size_t)(r0 + s) * 16 + 8 + h]; }
        const float Dh = P.ssd_d[layer * 8 + h];
        const bf16_t* Cg = XBC + (size_t)r0 * 768 + 640 + 64 * g; const bf16_t* Bg = XBC + (size_t)r0 * 768 + 512 + 64 * g;
#pragma unroll 1
        for (int lb = 0; lb < 2; ++lb) { const int l0 = 64 * half + 32 * lb;
            f32x16 gt[4];
#pragma unroll
            for (int j = 0; j < 4; ++j)
#pragma unroll
                for (int q = 0; q < 16; ++q) gt[j][q] = 0.f;
#pragma unroll
            for (int kk = 0; kk < 4; ++kk) { const bf16x8 af = *(const bf16x8*)(Cg + (size_t)(l0 + r) * 768 + 16 * kk + 8 * hb);
#pragma unroll
                for (int j = 0; j < 4; ++j) { const bf16x8 bfr = *(const bf16x8*)(Bg + (size_t)(32 * j + r) * 768 + 16 * kk + 8 * hb); gt[j] = MFMA32(af, bfr, gt[j]); } }
#pragma unroll
            for (int i = 0; i < 16; ++i) { const int lr = crow(i, hb), l = l0 + lr; const float af_l = lacs[(hh * 2) * 128 + l], ab_l = lacs[(hh * 2 + 1) * 128 + l];
#pragma unroll
                for (int j = 0; j < 4; ++j) { const int s = 32 * j + r;
                    const float argf = (s <= l) ? af_l - acsf_s[j] : -INFINITY, argb = (s >= l) ? ab_l - acsb_s[j] : -INFINITY;
                    const float wgt = __expf(argf) * dtf_s[j] + __expf(argb) * dtb_s[j];
                    const float val = gt[j][i] * wgt + (s == l ? Dh : 0.f);
                    Wst[lr * XT_LD + s] = (bf16_t)(pk2(val, 0.f) & 0xffff); } }
            LDSW();
            f32x16 y[2];
#pragma unroll
            for (int pt = 0; pt < 2; ++pt)
#pragma unroll
                for (int q = 0; q < 16; ++q) y[pt][q] = 0.f;
#pragma unroll 2
            for (int kk = 0; kk < 8; ++kk) { const bf16x8 af = *(const LAS bf16x8*)(Wst + r * XT_LD + 16 * kk + 8 * hb);
#pragma unroll
                for (int pt = 0; pt < 2; ++pt) { const bf16x8 bfr = *(const LAS bf16x8*)(XT + (64 * hh + 32 * pt + r) * XT_LD + 16 * kk + 8 * hb); y[pt] = MFMA32(af, bfr, y[pt]); } }
#pragma unroll
            for (int dd = 0; dd < 2; ++dd) { const float el = __expf(lacs[(hh * 2 + dd) * 128 + l0 + r]);
                const float* hs = ST + ((((size_t)dd * NBATCH + b) * NCH + c) * 8 + h) * 4096;
#pragma unroll
                for (int kk = 0; kk < 4; ++kk) { const bf16x8 af = scale8s(*(const u32x4*)(Cg + (size_t)(l0 + r) * 768 + 16 * kk + 8 * hb), el);
#pragma unroll
                    for (int pt = 0; pt < 2; ++pt) { const float* hp = hs + (32 * pt + r) * 64 + 16 * kk + 8 * hb; const f32x4 h0 = *(const f32x4*)hp, h1 = *(const f32x4*)(hp + 4);
                        u32x4 pkd; pkd.x = pk2(h0.x, h0.y); pkd.y = pk2(h0.z, h0.w); pkd.z = pk2(h1.x, h1.y); pkd.w = pk2(h1.z, h1.w);
                        y[pt] = MFMA32(af, __builtin_bit_cast(bf16x8, pkd), y[pt]); } } }
#pragma unroll
            for (int pt = 0; pt < 2; ++pt)
#pragma unroll
                for (int i = 0; i < 16; ++i) YRAW[(size_t)(r0 + l0 + crow(i, hb)) * 512 + h * 64 + 32 * pt + r] = (bf16_t)(pk2(y[pt][i], 0.f) & 0xffff);
            LDSW();
        }
        __syncthreads();
    }
}
DI void ys_finalize(const Params& P, const Tctx& T0, int layer) { const Tctx T = opaque_ctx(T0);
    const bf16_t* YRAW = (const bf16_t*)(P.ws + WS_YRAW); const bf16_t* PROJ = (const bf16_t*)(P.ws + WS_PROJ); bf16_t* YS = (bf16_t*)(P.ws + WS_YS);
    for (int r = T.gw; r < MR; r += T.NGW) {
        if (layer == 1 && (r % TPB) < CTXL) continue;
        float y[8], z[8]; unpack8(*(const u32x4*)(YRAW + (size_t)r * 512 + 8 * T.lane), y); unpack8(*(const u32x4*)(PROJ + (size_t)r * NP + PZ + 8 * T.lane), z);
        float ss = 0.f;
#pragma unroll
        for (int e = 0; e < 8; ++e) { y[e] *= siluf_(z[e]); ss += y[e] * y[e]; }
        const float rstd = rsqrtf(wave_sum(ss) * (1.f / 512.f) + EPSF); const float* nw = P.ssd_norm + layer * 512 + 8 * T.lane;
#pragma unroll
        for (int e = 0; e < 8; ++e) y[e] = y[e] * rstd * nw[e];
        *(u32x4*)(YS + (size_t)r * 512 + 8 * T.lane) = pack8(y);
    }
}

DI void p7_ln_router(const Params& P, const Tctx& T0, unsigned char* lds, int layer) { const Tctx T = opaque_ctx(T0);
    LAS float* Wl = (LAS float*)lds;
    stage_w16(Wl, P.w_router + (size_t)layer * 1024 * 16, 16, T.tid);
    __syncthreads();
    const float* modv = (const float*)(P.ws + WS_MODV) + (size_t)layer * 5 * 6144;
    float* X1 = (float*)(P.ws + WS_X1); bf16_t* H = (bf16_t*)(P.ws + WS_H); float* AFF = (float*)(P.ws + WS_AFF);
    const float* g1 = P.ln1_g + layer * 1024; const float* b1 = P.ln1_b + layer * 1024;
    for (int r = T.gw; r < MR; r += T.NGW) {
        int b, p; row_bp(r, b, p); if (layer == 1 && p < CTXL) continue; const int mrow = p < CTXL ? 4 : b;
        f32x4 v[4]; load_row(X1 + (size_t)r * DMODEL, T.lane, v); ln_norm(v);
#pragma unroll
        for (int j = 0; j < 4; ++j) v[j] = v[j] * *((const f32x4*)g1 + T.lane + 64 * j) + *((const f32x4*)b1 + T.lane + 64 * j);
        store_row(X1 + (size_t)r * DMODEL, T.lane, v);
        ln_norm(v); const float* mv = modv + (size_t)mrow * 6144;
#pragma unroll
        for (int j = 0; j < 4; ++j) { const f32x4 sh = *((const f32x4*)(mv + 3072) + T.lane + 64 * j), sc = *((const f32x4*)(mv + 4096) + T.lane + 64 * j); v[j] = v[j] * (sc + 1.f) + sh; }
        store_row_bf16(H + (size_t)r * DMODEL, T.lane, v);
        float s[16]; row_dot16(v, Wl, T.lane, s); float mine = -INFINITY;
#pragma unroll
        for (int q = 0; q < 16; ++q) { const float t = wave_sum(s[q]); if (T.lane == q) mine = t; }
        float mx = mine;
#pragma unroll
        for (int o = 1; o < 16; o <<= 1) mx = fmaxf(mx, __shfl_xor(mx, o));
        const float ex = (T.lane < 16) ? expf(mine - mx) : 0.f; float sm = ex;
#pragma unroll
        for (int o = 1; o < 16; o <<= 1) sm += __shfl_xor(sm, o);
        if (T.lane < 16) AFF[(size_t)r * 16 + T.lane] = ex / sm;
    }
    __syncthreads();
}

DI unsigned block_scan_excl(unsigned v, LAS unsigned* wt, int lane, int wave, unsigned& total) {
    unsigned inc = v;
#pragma unroll
    for (int o = 1; o < 64; o <<= 1) { const unsigned t = __shfl_up(inc, o); if (lane >= o) inc += t; }
    if (lane == 63) wt[wave] = inc;
    __syncthreads();
    unsigned off = 0, tot = 0;
#pragma unroll
    for (int q = 0; q < 8; ++q) { const unsigned t = wt[q]; if (q < wave) off += t; tot += t; }
    __syncthreads();
    total = tot; return off + inc - v;
}
DI void p8_topk(const Params& P, const Tctx& T0, unsigned char* lds_, int layer) { const Tctx T = opaque_ctx(T0);
    const float* AFF = (const float*)(P.ws + WS_AFF); int* SLOT = (int*)(P.ws + WS_SLOT); float* AFFSEL = (float*)(P.ws + WS_AFFSEL);
    const bf16_t* H = (const bf16_t*)(P.ws + WS_H); bf16_t* XS = (bf16_t*)(P.ws + WS_XS);
    LAS unsigned* cnt = (LAS unsigned*)lds_; LAS unsigned* wt = cnt + 16; LAS int* rows = (LAS int*)(cnt + 32);
    const int ntask = layer == 0 ? 128 : 64;
    for (int task = T.blk; task < ntask; task += T.G) {
        const int set = task >> 6, tt = task & 63, b = tt >> 4, e = tt & 15; const int n = set ? CTXL : SEQL, k = set ? 32 : 512;
        const int rowbase = b * TPB + (set ? 0 : CTXL), slotbase = set ? 2048 + b * 32 : b * 512;
        unsigned key[8];
#pragma unroll
        for (int j = 0; j < 8; ++j) { const int idx = T.tid * 8 + j; key[j] = idx < n ? __float_as_uint(AFF[(size_t)(rowbase + idx) * 16 + e]) : 0u; }
        unsigned prefix = 0;
        for (int bit = 29; bit >= 0; --bit) { const unsigned cand = prefix | (1u << bit); int c = 0;
#pragma unroll
            for (int j = 0; j < 8; ++j) c += key[j] >= cand ? 1 : 0;
            c = wave_sum_i(c); if (T.lane == 0) cnt[(bit & 1) * 8 + T.wave] = (unsigned)c;
            __syncthreads();
            unsigned tot = 0;
#pragma unroll
            for (int q = 0; q < 8; ++q) tot += cnt[(bit & 1) * 8 + q];
            if ((int)tot >= k) prefix = cand; }
        unsigned cg_ = 0, ce_ = 0;
#pragma unroll
        for (int j = 0; j < 8; ++j) { cg_ += key[j] > prefix ? 1u : 0u; ce_ += key[j] == prefix ? 1u : 0u; }
        unsigned total; const unsigned ex1 = block_scan_excl((ce_ << 16) | cg_, wt, T.lane, T.wave, total);
        const int need_eq = k - (int)(total & 0xffffu); int eq_rank = (int)(ex1 >> 16);
        unsigned selm = 0, nsel = 0;
#pragma unroll
        for (int j = 0; j < 8; ++j) { bool s = key[j] > prefix; if (key[j] == prefix) { s = eq_rank < need_eq; ++eq_rank; } if (s) { selm |= 1u << j; ++nsel; } }
        unsigned tot2; unsigned pos = block_scan_excl(nsel, wt, T.lane, T.wave, tot2);
#pragma unroll
        for (int j = 0; j < 8; ++j) { const int idx = T.tid * 8 + j; if (idx < n) { const int r = rowbase + idx;
                if (selm & (1u << j)) { const int slot = slotbase + (int)pos; SLOT[(size_t)r * 16 + e] = slot; AFFSEL[e * ESTR + slot] = __uint_as_float(key[j]); rows[pos] = r; ++pos; }
                else SLOT[(size_t)r * 16 + e] = -1; } }
        __syncthreads();
        for (int s = T.wave; s < k; s += 8) { const int r = rows[s]; const u32x4* src = (const u32x4*)(H + (size_t)r * DMODEL); u32x4* dst = (u32x4*)(XS + ((size_t)e * ESTR + slotbase + s) * DMODEL);
            dst[T.lane] = src[T.lane]; dst[T.lane + 64] = src[T.lane + 64]; }
        __syncthreads();
    }
}

DI void p11_combine(const Params& P, const Tctx& T0, int layer) { const Tctx T = opaque_ctx(T0);
    const float* X1 = (const float*)(P.ws + WS_X1); const int* SLOT = (const int*)(P.ws + WS_SLOT); const bf16_t* Y = (const bf16_t*)(P.ws + WS_XS);
    const float* modv = (const float*)(P.ws + WS_MODV) + (size_t)layer * 5 * 6144; float* XA = (float*)(P.ws + WS_XA);
    const float* g2 = P.ln2_g + layer * 1024; const float* b2 = P.ln2_b + layer * 1024;
    for (int r = T.gw; r < MR; r += T.NGW) {
        int b, p; row_bp(r, b, p); if (layer == 1 && p < CTXL) continue; const int mrow = p < CTXL ? 4 : b;
        f32x4 v[4], acc[4]; load_row(X1 + (size_t)r * DMODEL, T.lane, v);
#pragma unroll
        for (int j = 0; j < 4; ++j) acc[j] = (f32x4){0.f, 0.f, 0.f, 0.f};
        const int sl = SLOT[(size_t)r * 16 + (T.lane & 15)];
        for (int e = 0; e < 16; ++e) { const int s = __shfl(sl, e); if (s >= 0) { const bf16_t* yr = Y + ((size_t)e * ESTR + s) * DMODEL;
#pragma unroll
                for (int j = 0; j < 4; ++j) { const u32x2 w = *((const u32x2*)yr + T.lane + 64 * j); acc[j].x += bflo(w.x); acc[j].y += bfhi(w.x); acc[j].z += bflo(w.y); acc[j].w += bfhi(w.y); } } }
        const float* m5 = modv + (size_t)mrow * 6144 + 5 * 1024;
#pragma unroll
        for (int j = 0; j < 4; ++j) v[j] = v[j] * ALPHA_F + *((const f32x4*)m5 + T.lane + 64 * j) * acc[j];
        ln_norm(v);
#pragma unroll
        for (int j = 0; j < 4; ++j) v[j] = v[j] * *((const f32x4*)g2 + T.lane + 64 * j) + *((const f32x4*)b2 + T.lane + 64 * j);
        float* dst = (layer == 0) ? XA + (size_t)r * DMODEL : P.out + ((size_t)b * SEQL + (p - CTXL)) * DMODEL;
        store_row(dst, T.lane, v);
    }
}

__global__ void __launch_bounds__(512, 2) fwd_mega(Params P_unused_) {
    const Params& P = *(const Params*)(const __attribute__((address_space(4))) Params*)__builtin_amdgcn_kernarg_segment_ptr();
    extern __shared__ __attribute__((aligned(16))) unsigned char lds[];
    cg::grid_group grid = cg::this_grid();
    Tctx T; T.tid = threadIdx.x; T.lane = T.tid & 63; T.wave = __builtin_amdgcn_readfirstlane(T.tid >> 6); T.G = gridDim.x; T.blk = blockIdx.x; T.gw = T.blk * 8 + T.wave; T.NGW = T.G * 8;
    PG8_LAS unsigned char* ldsl = (PG8_LAS unsigned char*)lds;
    int ph = 0;
#ifndef ONLY
#define ONLY -1
#endif
#define EN(k) (ONLY < 0 || ONLY == (k))
#define PHASE_BEGIN if (ph >= P.ph_lo && ph < P.ph_hi) {
#define PHASE_END(dosync_) if ((dosync_) && ph + 1 < P.ph_hi) grid.sync(); } ++ph;

    PHASE_BEGIN if constexpr (EN(0)) {
        if (T.blk < 192) p0_modv(P, T, lds, T.blk);
        if (T.blk == T.G - 1) p0_rope(P, T);
        p0_convert(P, T, lds);
    } PHASE_END(true)

    for (int layer = 0; layer < NLAYER; ++layer) {
#define WIN ((const bf16_t*)(P.ws + WS_WIN) + (size_t)layer * NP * 1024)
#define WBR ((const bf16_t*)(P.ws + WS_WBR) + (size_t)layer * 3 * 1024 * 512)
#define WO ((const bf16_t*)(P.ws + WS_WO) + (size_t)layer * 1024 * 1024)
#define WGU ((const bf16_t*)(P.ws + WS_WGU) + (size_t)layer * NEXP * 4096 * 1024)
#define WD ((const bf16_t*)(P.ws + WS_WD) + (size_t)layer * NEXP * 1024 * 2048)
#define modv ((const float*)(P.ws + WS_MODV) + (size_t)layer * 5 * 6144)
        const bool skipc = layer == NLAYER - 1;
        PHASE_BEGIN if constexpr (EN(1)) { p1_modulate(P, T, lds, layer); } PHASE_END(true)
        PHASE_BEGIN if constexpr (EN(2)) {
            pg8::SchedInProj S; S.A = (const char*)(P.ws + WS_H); S.Bt = (const char*)WIN; S.G = T.G; S.c = T.blk;
            pg8::EpiStoreBf16 E{(bf16_t*)(P.ws + WS_PROJ), NP};
            pg8::gemm_phase<pg8::EpiStoreBf16, pg8::SchedInProj, true, true>(ldsl, 1024, S, E);
        } PHASE_END(true)
        PHASE_BEGIN if constexpr (EN(3)) { p3_post(P, T, layer); } PHASE_END(true)
        PHASE_BEGIN if constexpr (EN(4)) { ssd_a(P, T, lds, layer); } PHASE_END(true)
        PHASE_BEGIN if constexpr (EN(5)) { ssd_b(P, T); } PHASE_END(true)
        PHASE_BEGIN if constexpr (EN(6)) { ssd_c(P, T, lds, layer); } PHASE_END(true)
        PHASE_BEGIN if constexpr (EN(7)) {
            ys_finalize(P, T, layer);
            const attn_body::bf16* Qf = (const attn_body::bf16*)(P.ws + WS_Q); const attn_body::bf16* Kf = (const attn_body::bf16*)(P.ws + WS_K); const attn_body::bf16* Vf = (const attn_body::bf16*)(P.ws + WS_V);
            attn_body::bf16* YA = (attn_body::bf16*)(P.ws + WS_YA);
            __syncthreads();
            const int nu = skipc ? 512 : 544;
            for (int u = T.blk; u < nu; u += T.G) {
                long q0, k0; int nt, h;
                if (u < 512) { const int b = u >> 7, qb = u & 15; h = (u >> 4) & 7; q0 = (long)b * TPB + CTXL + qb * 256; k0 = (long)b * TPB; nt = TPB / 64; }
                else { const int v = u - 512, b = v >> 3; h = v & 7; q0 = (long)b * TPB; k0 = q0; nt = CTXL / 64; }
                attn_body::attn_unit<8>(q0, k0, nt, h, h >> 2, Qf, Kf, Vf, YA, (char*)lds); }
        } PHASE_END(true)
        PHASE_BEGIN if constexpr (EN(8)) {
            pg8::SchedTok<3> S; S.A0 = (const char*)(P.ws + WS_YA); S.A1 = (const char*)(P.ws + WS_YS); S.A2 = (const char*)(P.ws + WS_YC); S.Bt = (const char*)WBR; S.KA = 512;
            S.ntile = skipc ? 256 : 272; S.skip_ctx = skipc; S.G = T.G; S.c = T.blk;
            pg8::EpiMerge E{(const bf16_t*)(P.ws + WS_PROJ), (bf16_t*)(P.ws + WS_M)};
            pg8::gemm_phase<pg8::EpiMerge, pg8::SchedTok<3>, true, true>(ldsl, 512, S, E);
        } PHASE_END(true)
        PHASE_BEGIN if constexpr (EN(9)) {
            pg8::SchedTok<1> S; S.A0 = (const char*)(P.ws + WS_M); S.A1 = S.A0; S.A2 = S.A0; S.Bt = (const char*)WO; S.KA = 1024;
            S.ntile = skipc ? 256 : 272; S.skip_ctx = skipc; S.G = T.G; S.c = T.blk;
            pg8::EpiWo E{P.x, P.ctx, (const float*)(P.ws + WS_XA), layer, modv, (float*)(P.ws + WS_X1)};
            pg8::gemm_phase<pg8::EpiWo, pg8::SchedTok<1>, true, true>(ldsl, 1024, S, E);
        } PHASE_END(true)
        PHASE_BEGIN if constexpr (EN(10)) { p7_ln_router(P, T, lds, layer); } PHASE_END(true)
        PHASE_BEGIN if constexpr (EN(11)) { p8_topk(P, T, lds, layer); } PHASE_END(true)
        PHASE_BEGIN if constexpr (EN(12)) {
            pg8::SchedExp S; S.A = (const char*)(P.ws + WS_XS); S.Bt = (const char*)WGU; S.KA = 1024; S.NMT = skipc ? 8 : 9; S.NPN = 16; S.OCW = 128; S.G = T.G; S.c = T.blk;
            pg8::EpiGU E{(bf16_t*)(P.ws + WS_HID)};
            pg8::gemm_phase<pg8::EpiGU, pg8::SchedExp, true, true>(ldsl, 1024, S, E);
        } PHASE_END(true)
        PHASE_BEGIN if constexpr (EN(13)) {
            pg8::SchedExp S; S.A = (const char*)(P.ws + WS_HID); S.Bt = (const char*)WD; S.KA = 2048; S.NMT = skipc ? 8 : 9; S.NPN = 4; S.OCW = 256; S.G = T.G; S.c = T.blk;
            pg8::EpiDown E{(bf16_t*)(P.ws + WS_XS), (const float*)(P.ws + WS_AFFSEL)};
            pg8::gemm_phase<pg8::EpiDown, pg8::SchedExp, true, true>(ldsl, 2048, S, E);
        } PHASE_END(true)
        PHASE_BEGIN if constexpr (EN(14)) { p11_combine(P, T, layer); } PHASE_END(true)
    }
}

constexpr int N_PHASES = 1 + NLAYER * 14;

extern "C" void kernel_launch(void* const* d_in, const int* in_sizes, int n_in, void* d_out, int out_size, void* d_ws, size_t ws_size, hipStream_t stream) {
    static int grid = 0;
    if (grid == 0) {
        if (n_in != 28 || ws_size < WS_END) { fprintf(stderr, "kernel_launch: unexpected n_in %d / ws %zu (need %zu)\n", n_in, ws_size, (size_t)WS_END); grid = -1; return; }
        int dev = 0, cus = 0, per_cu = 0;
        (void)hipGetDevice(&dev); (void)hipDeviceGetAttribute(&cus, hipDeviceAttributeMultiprocessorCount, dev);
        (void)hipFuncSetAttribute((const void*)fwd_mega, hipFuncAttributeMaxDynamicSharedMemorySize, LDS_BYTES);
        (void)hipOccupancyMaxActiveBlocksPerMultiprocessor(&per_cu, (const void*)fwd_mega, 512, LDS_BYTES);
        if (per_cu < 1) { fprintf(stderr, "kernel_launch: occupancy query says %d blocks/CU\n", per_cu); per_cu = 1; }
        grid = cus * per_cu;
    }
    if (grid < 0) return;
    Params p{};
    const float** f = (const float**)&p;
    for (int i = 0; i < 28; ++i) f[i] = (const float*)d_in[i];
    p.out = (float*)d_out; p.ws = (unsigned char*)d_ws;
#ifndef MK_SPLIT
    p.ph_lo = 0; p.ph_hi = N_PHASES;
    void* args[] = {&p};
    hipError_t e = hipLaunchCooperativeKernel((const void*)fwd_mega, dim3(grid), dim3(512), args, LDS_BYTES, stream);
    if (e != hipSuccess) fprintf(stderr, "cooperative launch failed: %s (grid %d)\n", hipGetErrorString(e), grid);
#else
    for (int ph = 0; ph < N_PHASES; ++ph) { p.ph_lo = ph; p.ph_hi = ph + 1; void* args[] = {&p};
        hipError_t e = hipLaunchCooperativeKernel((const void*)fwd_mega, dim3(grid), dim3(512), args, LDS_BYTES, stream);
        if (e != hipSuccess) { fprintf(stderr, "launch %d failed: %s\n", ph, hipGetErrorString(e)); break; } }
#endif
}
```

```cpp
#include <hip/hip_runtime.h>
#include <hip/hip_bf16.h>
#include <hip/hip_cooperative_groups.h>
#include <cstdio>
#include <cstdint>
namespace cg = cooperative_groups;

#define DI __device__ __forceinline__
#define LAS __attribute__((address_space(3)))
typedef unsigned short bf16_t;
typedef short bf16x8 __attribute__((ext_vector_type(8)));
typedef float f32x4 __attribute__((ext_vector_type(4)));
typedef float f32x2 __attribute__((ext_vector_type(2)));
typedef float f32x16 __attribute__((ext_vector_type(16)));
typedef unsigned u32x4 __attribute__((ext_vector_type(4)));
typedef unsigned u32x2 __attribute__((ext_vector_type(2)));

constexpr int DMODEL = 1024, NBATCH = 4, SEQL = 4096, CTXL = 256, TPB = SEQL + CTXL  , MR = NBATCH * TPB  ;
constexpr int NLAYER = 2, IN_COLS = 6672, NP = 6656;
constexpr int PK = 0, PV = 128, PXBC = 256, PQ = 1024, PZ = 1536, PSCB = 2048, PSCC = 2560, PSCX = 3072, PG = 3584;
constexpr int NEXP = 16, FF = 2048, ESTR = 2304  , NCH = 34  ;
constexpr float EPSF = 1e-6f;
constexpr float ALPHA_F = 1.4142135623730951f;
constexpr float QSCALE = 0.125f * 1.4426950408889634f;

constexpr size_t al256(size_t x) { return (x + 255) & ~(size_t)255; }
constexpr size_t WS_WIN = 0;
constexpr size_t WS_WBR = WS_WIN + al256((size_t)NLAYER * NP * 1024 * 2);
constexpr size_t WS_WO = WS_WBR + al256((size_t)NLAYER * 3 * 1024 * 512 * 2);
constexpr size_t WS_WGU = WS_WO + al256((size_t)NLAYER * 1024 * 1024 * 2);
constexpr size_t WS_WD = WS_WGU + al256((size_t)NLAYER * NEXP * 4096 * 1024 * 2);
constexpr size_t WS_XA = WS_WD + al256((size_t)NLAYER * NEXP * 1024 * 2048 * 2);
constexpr size_t WS_X1 = WS_XA + al256((size_t)MR * 1024 * 4);
constexpr size_t WS_H = WS_X1 + al256((size_t)MR * 1024 * 4);
constexpr size_t WS_PROJ = WS_H + al256((size_t)MR * 1024 * 2);
constexpr size_t WS_XS = WS_PROJ;
constexpr size_t WS_HID = WS_PROJ + al256((size_t)NEXP * ESTR * 1024 * 2);
constexpr size_t WS_Q = WS_PROJ + al256((size_t)MR * NP * 2);
constexpr size_t WS_K = WS_Q + al256((size_t)MR * 512 * 2);
constexpr size_t WS_V = WS_K + al256((size_t)MR * 128 * 2);
constexpr size_t WS_XBC = WS_V + al256((size_t)MR * 128 * 2);
constexpr size_t WS_YC = WS_XBC + al256((size_t)MR * 768 * 2);
constexpr size_t WS_YA = WS_YC + al256((size_t)MR * 512 * 2);
constexpr size_t WS_YS = WS_YA + al256((size_t)MR * 512 * 2);
constexpr size_t WS_YRAW = WS_YS + al256((size_t)MR * 512 * 2);
constexpr size_t WS_M = WS_YRAW + al256((size_t)MR * 512 * 2);
constexpr size_t WS_ST = WS_M + al256((size_t)MR * 1024 * 2);
constexpr size_t WS_DT = WS_ST + al256((size_t)2 * NBATCH * NCH * 8 * 4096 * 4);
constexpr size_t WS_ACS = WS_DT + al256((size_t)MR * 16 * 4);
constexpr size_t WS_AFF = WS_ACS + al256((size_t)MR * 16 * 4);
constexpr size_t WS_SLOT = WS_AFF + al256((size_t)MR * 16 * 4);
constexpr size_t WS_AFFSEL = WS_SLOT + al256((size_t)MR * 16 * 4);
constexpr size_t WS_MODV = WS_AFFSEL + al256((size_t)NEXP * ESTR * 4);
constexpr size_t WS_ROPE = WS_MODV + al256((size_t)NLAYER * 5 * 6144 * 4);
constexpr size_t WS_BAR = WS_ROPE + al256((size_t)64 * 16 * 2 * 4);
constexpr size_t WS_END = WS_BAR + 16384;
static_assert(WS_HID + (size_t)NEXP * ESTR * 2048 * 2 <= WS_Q, "MoE overlays fit inside PROJ");
static_assert(WS_END <= (size_t)1073741824, "workspace fits 1 GiB");

constexpr int LDS_BYTES = 147456;
constexpr int RING_BYTES = 131072;

struct Params {
    const float *x, *c, *ctx, *c_ctx, *w_mod, *b_mod, *w_in, *q_norm, *k_norm, *ssd_conv_w, *ssd_conv_b, *ssd_a_log, *ssd_dt_bias, *ssd_d, *ssd_norm, *sc_conv_w,
        *w_br_attn, *w_br_ssd, *w_br_conv, *w_o, *ln1_g, *ln1_b, *w_router, *w_exp_gate, *w_exp_up, *w_exp_down, *ln2_g, *ln2_b;
    float* out; unsigned char* ws; int ph_lo, ph_hi;
};

DI float wave_sum(float v) {
#pragma unroll
    for (int o = 1; o < 64; o <<= 1) v += __shfl_xor(v, o);
    return v;
}
DI int wave_sum_i(int v) {
#pragma unroll
    for (int o = 1; o < 64; o <<= 1) v += __shfl_xor(v, o);
    return v;
}
typedef __bf16 bf16x2_t __attribute__((ext_vector_type(2)));
DI unsigned pk2(float lo, float hi) { f32x2 v = {lo, hi}; bf16x2_t b = __builtin_convertvector(v, bf16x2_t); return __builtin_bit_cast(unsigned, b); }
DI float bflo(unsigned w) { return __uint_as_float(w << 16); }
DI float bfhi(unsigned w) { return __uint_as_float(w & 0xffff0000u); }
DI void unpack8(const u32x4 v, float (&f)[8]) { f[0] = bflo(v.x); f[1] = bfhi(v.x); f[2] = bflo(v.y); f[3] = bfhi(v.y); f[4] = bflo(v.z); f[5] = bfhi(v.z); f[6] = bflo(v.w); f[7] = bfhi(v.w); }
DI u32x4 pack8(const float (&f)[8]) { u32x4 o; o.x = pk2(f[0], f[1]); o.y = pk2(f[2], f[3]); o.z = pk2(f[4], f[5]); o.w = pk2(f[6], f[7]); return o; }
DI float sigmoidf_(float x) { return 1.f / (1.f + __expf(-x)); }
DI float siluf_(float x) { return x / (1.f + __expf(-x)); }
DI int crow(int r, int hi) { return (r & 3) + 8 * (r >> 2) + 4 * hi; }
DI void row_bp(int r, int& b, int& p) { b = r / TPB; p = r - b * TPB; }
DI const float* xsrc_row(const Params& P, int layer, int r) {
    if (layer == 0) { int b, p; row_bp(r, b, p); return p < CTXL ? P.ctx + ((size_t)b * CTXL + p) * DMODEL : P.x + ((size_t)b * SEQL + (p - CTXL)) * DMODEL; }
    return (const float*)(P.ws + WS_XA) + (size_t)r * DMODEL;
}

namespace pg8 {
#define PG8_LAS __attribute__((address_space(3)))
constexpr int BM = 256, BK = 64, HALF = 128, HTB = HALF * BK * 2, STAGE_BYTES = 8 * HTB;
DI int lds_byte(int r, int c) { const int st = (r >> 4) * 2 + (c >> 5), rr = r & 15, cc = c & 31, ob = rr * 64 + cc * 2; return st * 1024 + (ob ^ (((ob >> 9) & 1) << 5)); }
DI void stage_rc(int b, int& R, int& C) { const int st = b / 1024, sb = b % 1024, swz = sb ^ (((sb >> 9) & 1) << 5); R = (st >> 1) * 16 + swz / 64; C = (st & 1) * 32 + (swz % 64) / 2; }
DI int perm32(int rho) { const int n = rho >> 4, i = rho & 15; return 8 * (i >> 2) + 4 * n + (i & 3); }
struct Unit { const char* a; const char* b; int orow, ocol, aux, keep; };
DI unsigned cvt_pk_bf16(float lo, float hi) { return pk2(lo, hi); }
template <class Epi, class Sched, bool ALIGN_EPI = false, bool SP2 = false>
__device__ __forceinline__ void gemm_phase(PG8_LAS unsigned char* lds, const int K_, const Sched& S, const Epi& E) {
    int tid = threadIdx.x; asm volatile("" : "+v"(tid)); const int wid = __builtin_amdgcn_readfirstlane(tid >> 6), lane = tid & 63, wr = wid >> 2, wc = wid & 3, fr = lane & 15, fq = lane >> 4;
    const int K = K_, nt = K / BK;
    unsigned voffA[2], voffB[2];
#pragma unroll
    for (int i = 0; i < 2; ++i) { int R, C; stage_rc(tid * 16 + i * 8192, R, C); const int Rb = Epi::PERM ? ((R & ~31) + perm32(R & 31)) : R;
        voffA[i] = (unsigned)(R * K + C) * 2u; voffB[i] = (unsigned)(Rb * K + C) * 2u; }
    const size_t kstep = (size_t)(BK * 2);
    const size_t hstep = (size_t)HALF * K * 2;
    const unsigned ldsw = (unsigned)wid * 1024u;
    const int aoff = lds_byte(wr * 64 + fr, fq * 8), boff = lds_byte(wc * 32 + fr, fq * 8);
#define PG8_SA(b, h) (((b) * 2 + (h)) * HTB)
#define PG8_SB(b, h) ((4 + (b) * 2 + (h)) * HTB)
#define PG8_STAGE(bufoff, gbase, voff) do { _Pragma("unroll") for (int _i = 0; _i < 2; ++_i) \
        __builtin_amdgcn_global_load_lds((const unsigned*)((const char*)(gbase) + (voff)[_i]), (PG8_LAS unsigned*)(lds + (bufoff) + ldsw + _i * 8192), 16, 0, 0); } while (0)
#define PG8_LDA(dst, b, h) do { _Pragma("unroll") for (int m = 0; m < 4; ++m) _Pragma("unroll") for (int k = 0; k < 2; ++k) dst[m][k] = *(const PG8_LAS bf16x8*)(lds + PG8_SA(b, h) + aoff + m * 2048 + k * 1024); } while (0)
#define PG8_LDB(dst, b, h) do { _Pragma("unroll") for (int n = 0; n < 2; ++n) _Pragma("unroll") for (int k = 0; k < 2; ++k) dst[n][k] = *(const PG8_LAS bf16x8*)(lds + PG8_SB(b, h) + boff + n * 2048 + k * 1024); } while (0)
#define PG8_MMA(ai, bj, At, Bt) do { __builtin_amdgcn_s_setprio(1); _Pragma("unroll") for (int m = 0; m < 4; ++m) _Pragma("unroll") for (int n = 0; n < 2; ++n) _Pragma("unroll") for (int k = 0; k < 2; ++k) \
        acc[ai][bj][m][n] = __builtin_amdgcn_mfma_f32_16x16x32_bf16(Bt[n][k], At[m][k], acc[ai][bj][m][n], 0, 0, 0); __builtin_amdgcn_s_setprio(0); } while (0)
#define PG8_WAIT_V(n) asm volatile("s_waitcnt vmcnt(" #n ")" ::: "memory")
#define PG8_WAIT_L(n) asm volatile("s_waitcnt lgkmcnt(" #n ")" ::: "memory")
#define PG8_BAR __builtin_amdgcn_s_barrier()
#define PG8_SCHED __builtin_amdgcn_sched_barrier(0)
    Unit cur, nxt; int ui = 0;
    if (!S.next(0, cur)) return;
    f32x4 acc[2][2][4][2];
#pragma unroll
    for (int a = 0; a < 2; ++a)
#pragma unroll
        for (int b = 0; b < 2; ++b)
#pragma unroll
            for (int m = 0; m < 4; ++m)
#pragma unroll
                for (int n = 0; n < 2; ++n) acc[a][b][m][n] = (f32x4){0.f, 0.f, 0.f, 0.f};
    bf16x8 At[4][2], B0[2][2], B1[2][2];
    const char* cA = cur.a; const char* cB = cur.b;
    S.a_ready(cur);
    if constexpr (SP2) {
        PG8_STAGE(PG8_SB(0, 0), cB, voffB); PG8_STAGE(PG8_SB(0, 1), cB + hstep, voffB); PG8_STAGE(PG8_SA(0, 0), cA, voffA); PG8_STAGE(PG8_SA(0, 1), cA + hstep, voffA);
        if (wr == 1) PG8_BAR;
        PG8_WAIT_V(2); PG8_BAR;
        PG8_STAGE(PG8_SB(1, 0), cB + kstep, voffB); PG8_STAGE(PG8_SA(1, 0), cA + kstep, voffA); PG8_STAGE(PG8_SB(1, 1), cB + hstep + kstep, voffB);
        PG8_WAIT_V(6); PG8_BAR;
    } else {
        PG8_STAGE(PG8_SB(0, 0), cB, voffB); PG8_STAGE(PG8_SA(0, 0), cA, voffA); PG8_STAGE(PG8_SB(0, 1), cB + hstep, voffB); PG8_STAGE(PG8_SA(0, 1), cA + hstep, voffA);
        if (wr == 1) PG8_BAR;
        PG8_WAIT_V(4); PG8_BAR;
        PG8_STAGE(PG8_SB(1, 0), cB + kstep, voffB); PG8_STAGE(PG8_SA(1, 0), cA + kstep, voffA); PG8_STAGE(PG8_SB(1, 1), cB + hstep + kstep, voffB);
        PG8_WAIT_V(6); PG8_BAR;
    }
    for (;;) {
        const bool has_next = S.next(ui + 1, nxt);
        const char* nA = has_next ? nxt.a : cA; const char* nB = has_next ? nxt.b : cB;
        for (int t = 0; t < nt; t += 2) {
            const bool last = (t == nt - 2);
            const char* a1 = cA + (size_t)(t + 1) * kstep;
            const char* a2 = last ? nA : cA + (size_t)(t + 2) * kstep; const char* b2 = last ? nB : cB + (size_t)(t + 2) * kstep;
            const char* a3 = a2 + kstep; const char* b3 = b2 + kstep;
            if (last && has_next) S.a_ready(nxt);
            if constexpr (SP2) {
            PG8_LDB(B0, 0, 0); PG8_LDB(B1, 0, 1); PG8_SCHED; PG8_LDA(At, 0, 0); PG8_STAGE(PG8_SA(1, 1), a1 + hstep, voffA);
            PG8_WAIT_V(8); PG8_WAIT_L(0); PG8_BAR; PG8_MMA(0, 0, At, B0); PG8_MMA(0, 1, At, B1); PG8_BAR; PG8_SCHED;
            PG8_LDA(At, 0, 1); PG8_STAGE(PG8_SB(0, 0), b2, voffB); PG8_STAGE(PG8_SB(0, 1), b2 + hstep, voffB); PG8_STAGE(PG8_SA(0, 0), a2, voffA);
            PG8_WAIT_V(8); PG8_WAIT_L(0); PG8_BAR; PG8_MMA(1, 0, At, B0); PG8_MMA(1, 1, At, B1); PG8_BAR; PG8_SCHED;
            PG8_LDB(B0, 1, 0); PG8_LDB(B1, 1, 1); PG8_SCHED; PG8_LDA(At, 1, 0); PG8_STAGE(PG8_SA(0, 1), a2 + hstep, voffA);
            PG8_WAIT_V(8); PG8_WAIT_L(0); PG8_BAR; PG8_MMA(0, 0, At, B0); PG8_MMA(0, 1, At, B1); PG8_BAR; PG8_SCHED;
            PG8_LDA(At, 1, 1); PG8_STAGE(PG8_SB(1, 0), b3, voffB); PG8_STAGE(PG8_SB(1, 1), b3 + hstep, voffB); PG8_STAGE(PG8_SA(1, 0), a3, voffA);
            PG8_WAIT_V(8); PG8_WAIT_L(0); PG8_BAR; PG8_MMA(1, 0, At, B0); PG8_MMA(1, 1, At, B1); PG8_BAR; PG8_SCHED;
            } else {
            PG8_LDB(B0, 0, 0); PG8_SCHED; PG8_LDA(At, 0, 0); PG8_STAGE(PG8_SA(1, 1), a1 + hstep, voffA);
            PG8_WAIT_L(8); PG8_BAR; PG8_WAIT_L(0); PG8_MMA(0, 0, At, B0); PG8_BAR; PG8_SCHED;
            PG8_LDB(B1, 0, 1); PG8_STAGE(PG8_SB(0, 0), b2, voffB);
            PG8_BAR; PG8_WAIT_L(0); PG8_MMA(0, 1, At, B1); PG8_BAR;
            PG8_LDA(At, 0, 1); PG8_STAGE(PG8_SA(0, 0), a2, voffA);
            PG8_BAR; PG8_WAIT_L(0); PG8_MMA(1, 0, At, B0); PG8_BAR; PG8_SCHED;
            PG8_STAGE(PG8_SB(0, 1), b2 + hstep, voffB);
            PG8_WAIT_V(6); PG8_BAR; PG8_MMA(1, 1, At, B1); PG8_BAR;
            PG8_LDB(B0, 1, 0); PG8_SCHED; PG8_LDA(At, 1, 0); PG8_STAGE(PG8_SA(0, 1), a2 + hstep, voffA);
            PG8_WAIT_L(8); PG8_BAR; PG8_WAIT_L(0); PG8_MMA(0, 0, At, B0); PG8_BAR; PG8_SCHED;
            PG8_LDB(B1, 1, 1); PG8_STAGE(PG8_SB(1, 0), b3, voffB);
            PG8_BAR; PG8_WAIT_L(0); PG8_MMA(0, 1, At, B1); PG8_BAR;
            PG8_LDA(At, 1, 1); PG8_STAGE(PG8_SA(1, 0), a3, voffA);
            PG8_BAR; PG8_WAIT_L(0); PG8_MMA(1, 0, At, B0); PG8_BAR; PG8_SCHED;
            PG8_STAGE(PG8_SB(1, 1), b3 + hstep, voffB);
            PG8_WAIT_V(6); PG8_BAR; PG8_MMA(1, 1, At, B1); PG8_BAR;
            }
        }
        if constexpr (ALIGN_EPI) { if (wr == 0) PG8_BAR; }
        if constexpr (!Epi::AFTER_DRAIN) { E(acc, cur, wr, wc, fr, fq); S.done(cur); }
        if (!has_next) break;
        if (!cur.keep) {
#pragma unroll
        for (int a = 0; a < 2; ++a)
#pragma unroll
            for (int b = 0; b < 2; ++b)
#pragma unroll
                for (int m = 0; m < 4; ++m)
#pragma unroll
                    for (int n = 0; n < 2; ++n) acc[a][b][m][n] = (f32x4){0.f, 0.f, 0.f, 0.f};
        }
        cur = nxt; cA = nA; cB = nB; ++ui;
        if constexpr (ALIGN_EPI) { if (wr == 1) PG8_BAR; }
    }
    PG8_WAIT_V(0);
    if constexpr (!ALIGN_EPI) { if (wr == 0) PG8_BAR; }
    PG8_BAR;
    if constexpr (Epi::AFTER_DRAIN) { E.fused(acc, cur, wr, wc, fr, fq, lds, wid, lane); S.done(cur); }
#undef PG8_SA
#undef PG8_SB
#undef PG8_STAGE
#undef PG8_LDA
#undef PG8_LDB
#undef PG8_MMA
#undef PG8_WAIT_V
#undef PG8_WAIT_L
#undef PG8_BAR
#undef PG8_SCHED
}


typedef f32x4 AccT[2][2][4][2];
struct EpiStoreBf16 {
    static constexpr bool PERM = true, AFTER_DRAIN = false;
    bf16_t* O; int ldc;
    DI void operator()(AccT& acc, const Unit& u, int wr, int wc, int fr, int fq) const {
        const int row0 = u.orow + wr * 64 + fr, col0 = u.ocol + wc * 32 + 8 * fq;
#pragma unroll
        for (int ai = 0; ai < 2; ++ai)
#pragma unroll
            for (int m = 0; m < 4; ++m) { bf16_t* rowp = O + (size_t)(row0 + ai * HALF + m * 16) * ldc + col0;
#pragma unroll
                for (int bj = 0; bj < 2; ++bj) { const f32x4 v0 = acc[ai][bj][m][0], v1 = acc[ai][bj][m][1];
                    u32x4 w; w.x = pk2(v0[0], v0[1]); w.y = pk2(v0[2], v0[3]); w.z = pk2(v1[0], v1[1]); w.w = pk2(v1[2], v1[3]);
                    *(u32x4*)(rowp + bj * HALF) = w; } }
    }
};
struct EpiMerge {
    static constexpr bool PERM = true, AFTER_DRAIN = false;
    const bf16_t* PROJ; bf16_t* Mo;
    DI void operator()(AccT& acc, const Unit& u, int wr, int wc, int fr, int fq) const {
        const int row0 = u.orow + wr * 64 + fr, col0 = u.ocol + wc * 32 + 8 * fq; const int j = u.aux;
#pragma unroll
        for (int ai = 0; ai < 2; ++ai)
#pragma unroll
            for (int m = 0; m < 4; ++m) { const size_t row = (size_t)(row0 + ai * HALF + m * 16);
#pragma unroll
                for (int bj = 0; bj < 2; ++bj) {
                    const bf16_t* gp = PROJ + row * NP + PG + j * 1024 + col0 + bj * HALF;
                    float ga[8], f[8]; unpack8(*(const u32x4*)gp, ga);
                    if (j < 2) { float gb[8]; unpack8(*(const u32x4*)(gp + 1024), gb);
#pragma unroll
                        for (int e = 0; e < 8; ++e) f[e] = (1.f + __expf(-gb[e])) / (1.f + __expf(-ga[e])); }
                    else {
#pragma unroll
                        for (int e = 0; e < 8; ++e) f[e] = 1.f / (1.f + __expf(-ga[e])); }
                    f32x4 v0 = acc[ai][bj][m][0], v1 = acc[ai][bj][m][1];
                    v0[0] *= f[0]; v0[1] *= f[1]; v0[2] *= f[2]; v0[3] *= f[3]; v1[0] *= f[4]; v1[1] *= f[5]; v1[2] *= f[6]; v1[3] *= f[7];
                    acc[ai][bj][m][0] = v0; acc[ai][bj][m][1] = v1;
                    if (j == 2) { u32x4 w; w.x = pk2(v0[0], v0[1]); w.y = pk2(v0[2], v0[3]); w.z = pk2(v1[0], v1[1]); w.w = pk2(v1[2], v1[3]);
                        *(u32x4*)(Mo + row * 1024 + col0 + bj * HALF) = w; } } }
    }
};
struct EpiWo {
    static constexpr bool PERM = false, AFTER_DRAIN = false;
    const float* x_in; const float* ctx_in; const float* XA; int layer; const float* modv  ; float* X1;
    DI void operator()(AccT& acc, const Unit& u, int wr, int wc, int fr, int fq) const {
        const int b = u.orow / TPB, p = u.orow - b * TPB;
        const float* xb; int mrow;
        if (p < CTXL) mrow = 4; else mrow = b;
        if (layer == 0) xb = (p < CTXL) ? ctx_in + (size_t)b * CTXL * DMODEL : x_in + ((size_t)b * SEQL + (p - CTXL)) * DMODEL;
        else xb = XA + (size_t)u.orow * DMODEL;
        const int rl0 = wr * 64 + fr, col0 = u.ocol + wc * 32 + 4 * fq;
        const float* m2 = modv + (size_t)mrow * 6144 + 2 * 1024;
        f32x4 mv[2][2];
#pragma unroll
        for (int bj = 0; bj < 2; ++bj)
#pragma unroll
            for (int n = 0; n < 2; ++n) mv[bj][n] = *(const f32x4*)(m2 + col0 + bj * HALF + n * 16);
#pragma unroll
        for (int ai = 0; ai < 2; ++ai)
#pragma unroll
            for (int m = 0; m < 4; ++m) { const int rl = rl0 + ai * HALF + m * 16; const float* xr = xb + (size_t)rl * DMODEL + col0; float* orow = X1 + (size_t)(u.orow + rl) * DMODEL + col0;
#pragma unroll
                for (int bj = 0; bj < 2; ++bj)
#pragma unroll
                    for (int n = 0; n < 2; ++n) { const f32x4 xv = *(const f32x4*)(xr + bj * HALF + n * 16);
                        *(f32x4*)(orow + bj * HALF + n * 16) = xv * ALPHA_F + mv[bj][n] * acc[ai][bj][m][n]; } }
    }
};
struct EpiGU {
    static constexpr bool PERM = true, AFTER_DRAIN = false;
    bf16_t* HID;
    DI void operator()(AccT& acc, const Unit& u, int wr, int wc, int fr, int fq) const {
        const int row0 = u.orow + wr * 64 + fr, col0 = u.ocol + wc * 32 + 8 * fq;
#pragma unroll
        for (int ai = 0; ai < 2; ++ai)
#pragma unroll
            for (int m = 0; m < 4; ++m) { bf16_t* rowp = HID + (size_t)(row0 + ai * HALF + m * 16) * FF + col0;
                const f32x4 g0 = acc[ai][0][m][0], g1 = acc[ai][0][m][1], u0 = acc[ai][1][m][0], u1 = acc[ai][1][m][1];
                u32x4 w; w.x = pk2(siluf_(g0[0]) * u0[0], siluf_(g0[1]) * u0[1]); w.y = pk2(siluf_(g0[2]) * u0[2], siluf_(g0[3]) * u0[3]);
                w.z = pk2(siluf_(g1[0]) * u1[0], siluf_(g1[1]) * u1[1]); w.w = pk2(siluf_(g1[2]) * u1[2], siluf_(g1[3]) * u1[3]);
                *(u32x4*)rowp = w; }
    }
};
struct EpiDown {
    static constexpr bool PERM = true, AFTER_DRAIN = false;
    bf16_t* Y; const float* affsel;
    DI void operator()(AccT& acc, const Unit& u, int wr, int wc, int fr, int fq) const {
        const int row0 = u.orow + wr * 64 + fr, col0 = u.ocol + wc * 32 + 8 * fq;
#pragma unroll
        for (int ai = 0; ai < 2; ++ai)
#pragma unroll
            for (int m = 0; m < 4; ++m) { const int row = row0 + ai * HALF + m * 16; const float s = affsel[row]; bf16_t* rowp = Y + (size_t)row * 1024 + col0;
#pragma unroll
                for (int bj = 0; bj < 2; ++bj) { const f32x4 v0 = acc[ai][bj][m][0] * s, v1 = acc[ai][bj][m][1] * s;
                    u32x4 w; w.x = pk2(v0[0], v0[1]); w.y = pk2(v0[2], v0[3]); w.z = pk2(v1[0], v1[1]); w.w = pk2(v1[2], v1[3]);
                    *(u32x4*)(rowp + bj * HALF) = w; } }
    }
};

struct NoHooks { DI void a_ready(const Unit&) const {} DI void done(const Unit&) const {} };
struct SchedInProj : NoHooks {
    const char* A; const char* Bt; int G, c;
    DI bool next(int i, Unit& u) const {
        constexpr int nM = MR / 256, nN = NP / 256, nwg = nM * nN, NXCD = 8, WGM = 8;
        const long L = (long)i * G + c; if (L >= nwg) return false;
        int wgid = (int)L; { const int q = nwg / NXCD, r = nwg % NXCD, xcd = wgid % NXCD, off = wgid / NXCD; wgid = (xcd < r ? xcd * (q + 1) : r * (q + 1) + (xcd - r) * q) + off; }
        const int nig = WGM * nN, gid = wgid / nig, fm = gid * WGM, gsz = (nM - fm) < WGM ? (nM - fm) : WGM;
        const int pm = fm + ((wgid % nig) % gsz), pn = (wgid % nig) / gsz;
        u.a = A + (size_t)pm * 256 * 1024 * 2; u.b = Bt + (size_t)pn * 256 * 1024 * 2; u.orow = pm * 256; u.ocol = pn * 256; u.aux = 0; u.keep = 0; return true;
    }
};
template <int NBR> struct SchedTok : NoHooks {
    const char* A0; const char* A1; const char* A2; const char* Bt; int KA  ; int ntile; bool skip_ctx; int G, c;
    DI bool next(int i, Unit& u) const {
        const int k = i / NBR, j = i - k * NBR; const int t = k * G + c; if (t >= ntile) return false;
        const int lt = t >> 2, pn = t & 3; const int pm = skip_ctx ? (lt / 16) * 17 + 1 + (lt % 16) : lt;
        const char* Ab = (j == 0) ? A0 : (j == 1 ? A1 : A2);
        u.a = Ab + (size_t)pm * 256 * KA * 2; u.b = Bt + ((size_t)j * 1024 + pn * 256) * KA * 2; u.orow = pm * 256; u.ocol = pn * 256; u.aux = j; u.keep = (j < NBR - 1); return true;
    }
};
struct SchedExp : NoHooks {
    const char* A; const char* Bt; int KA; int NMT, NPN, OCW  ; int G, c;
    DI bool next(int i, Unit& u) const {
        const int id = i * G + c; if (id >= NEXP * NMT * NPN) return false;
        const int mt = id % NMT, pn = (id / NMT) % NPN, e = id / (NMT * NPN);
        u.a = A + ((size_t)e * ESTR + mt * 256) * KA * 2; u.b = Bt + ((size_t)e * NPN + pn) * 256 * KA * 2; u.orow = e * ESTR + mt * 256; u.ocol = pn * OCW; u.aux = e; u.keep = 0; return true;
    }
};
}

namespace attn_body {
using bf16=__hip_bfloat16;
using bf16x8=__attribute__((ext_vector_type(8)))short;
using s16x4=__attribute__((ext_vector_type(4)))short;
using f32x16=__attribute__((ext_vector_type(16)))float;
using u32x4=__attribute__((ext_vector_type(4)))unsigned;
constexpr int D=64,NW=8,QBLK=32,QB=QBLK*NW,KVBLK=64,QP=512,KP=128;
__device__ __forceinline__ int crow(int r,int hi){return (r&3)+8*(r>>2)+4*hi;}
#define SBAR() __builtin_amdgcn_sched_barrier(0)
__device__ __forceinline__ void cmask(f32x16&p0,f32x16&p1,int jb,int qrel,int hi){
  const float NEG=-INFINITY; int kb=64*jb+4*hi;
  #pragma unroll
  for(int r=0;r<16;++r){int kv=kb+(r&3)+8*(r>>2); if(kv>qrel)p0[r]=NEG; if(kv+32>qrel)p1[r]=NEG;}
}

constexpr int NSLOT=3, SLOTB=8192;
constexpr int LDS_K=0, LDS_V=NSLOT*SLOTB, LDS_WS=2*NSLOT*SLOTB, LDS_OST=LDS_WS+NW*64*4, LDS_BYTES=LDS_OST+NW*4096;
constexpr float C2=0.125f*1.4426950408889634f;
__device__ __forceinline__ void glds16(const void*gsrc,unsigned lds_dst){unsigned keep;
  asm volatile("s_mov_b32 %0, m0\n\ts_mov_b32 m0, %2\n\ts_nop 0\n\tglobal_load_lds_dwordx4 %1, off\n\ts_mov_b32 m0, %0":"=&s"(keep):"v"(gsrc),"s"(lds_dst):"memory");}
__device__ __forceinline__ float max3f(float a,float b,float c){float r;asm("v_max3_f32 %0, %1, %2, %3":"=v"(r):"v"(a),"v"(b),"v"(c));return r;}
__device__ __forceinline__ float max2f(float a,float b){float r;asm("v_max_f32_e32 %0, %1, %2":"=v"(r):"v"(a),"v"(b));return r;}
__device__ __forceinline__ float fadd_s(float a,float b){float r;asm("v_add_f32_e32 %0, %1, %2":"=v"(r):"v"(a),"v"(b));return r;}
__device__ __forceinline__ float fsub_s(float a,float b){float r;asm("v_sub_f32_e32 %0, %1, %2":"=v"(r):"v"(a),"v"(b));return r;}
typedef float f32x2_t __attribute__((ext_vector_type(2))); typedef __bf16 bf16x2_t __attribute__((ext_vector_type(2)));
__device__ __forceinline__ unsigned cvtpk_s(float lo,float hi){f32x2_t v={lo,hi};bf16x2_t b=__builtin_convertvector(v,bf16x2_t);return __builtin_bit_cast(unsigned,b);}
#define WAIT_BAR(N) asm volatile("s_waitcnt vmcnt(" #N ") lgkmcnt(0)\n\ts_barrier":::"memory")

__device__ __forceinline__ void qkt(f32x16&p0,f32x16&p1,const char*Kslot,const bf16x8*qr,const f32x16&negm,int r32,int hi){
  const char*kb=Kslot+hi*1024+r32*16;
  #pragma unroll
  for(int d0=0;d0<4;++d0){
    const bf16x8 b0=*reinterpret_cast<const bf16x8*>(kb+d0*2048);
    const bf16x8 b1=*reinterpret_cast<const bf16x8*>(kb+d0*2048+512);
    if(d0==0){p0=__builtin_amdgcn_mfma_f32_32x32x16_bf16(b0,qr[0],negm,0,0,0);p1=__builtin_amdgcn_mfma_f32_32x32x16_bf16(b1,qr[0],negm,0,0,0);}
    else{p0=__builtin_amdgcn_mfma_f32_32x32x16_bf16(b0,qr[d0],p0,0,0,0);p1=__builtin_amdgcn_mfma_f32_32x32x16_bf16(b1,qr[d0],p1,0,0,0);}}
}
typedef __attribute__((address_space(3))) const char* lds_cptr;
typedef short v4i16_t __attribute__((ext_vector_type(4)));
__device__ __forceinline__ void kload8(bf16x8*kf,lds_cptr kp){
  kf[0]=*(const __attribute__((address_space(3))) bf16x8*)(kp);      kf[1]=*(const __attribute__((address_space(3))) bf16x8*)(kp+512);
  kf[2]=*(const __attribute__((address_space(3))) bf16x8*)(kp+2048); kf[3]=*(const __attribute__((address_space(3))) bf16x8*)(kp+2560);
  kf[4]=*(const __attribute__((address_space(3))) bf16x8*)(kp+4096); kf[5]=*(const __attribute__((address_space(3))) bf16x8*)(kp+4608);
  kf[6]=*(const __attribute__((address_space(3))) bf16x8*)(kp+6144); kf[7]=*(const __attribute__((address_space(3))) bf16x8*)(kp+6656);
}
__device__ __forceinline__ void kload2(bf16x8*kf,lds_cptr kp,int j){ kf[2*j]=*(const __attribute__((address_space(3))) bf16x8*)(kp+j*2048); kf[2*j+1]=*(const __attribute__((address_space(3))) bf16x8*)(kp+j*2048+512); }
__device__ __forceinline__ s16x4 vtr(lds_cptr p){ return __builtin_bit_cast(s16x4,__builtin_amdgcn_ds_read_tr16_b64_v4i16((__attribute__((address_space(3))) v4i16_t*)p)); }
__device__ __forceinline__ float rowmax(const f32x16&p0,const f32x16&p1){
  float a=max3f(p0[0],p0[1],p1[0]),b=max3f(p0[2],p0[3],p1[1]);a=max3f(a,p1[2],p1[3]);
  #pragma unroll
  for(int r=4;r<16;r+=4){a=max3f(a,p0[r],p0[r+1]);b=max3f(b,p0[r+2],p0[r+3]);a=max3f(a,p1[r],p1[r+1]);b=max3f(b,p1[r+2],p1[r+3]);}
  const float m=max2f(a,b);
  auto rr=__builtin_amdgcn_permlane32_swap(__float_as_uint(m),__float_as_uint(m),false,false);
  return max2f(__uint_as_float(rr[0]),__uint_as_float(rr[1]));
}
__device__ __forceinline__ void pv(f32x16*o,int vb,bf16x8 pa0,bf16x8 pa1,bf16x8 pa2,bf16x8 pa3){
  #pragma unroll
  for(int d0=0;d0<2;++d0){s16x4 lo[4],hi[4];
    #pragma unroll
    for(int ks=0;ks<4;++ks){
      asm volatile("ds_read_b64_tr_b16 %0,%1 offset:%c2":"=&v"(lo[ks]):"v"(vb),"i"(d0*4096+ks*1024):"memory");
      asm volatile("ds_read_b64_tr_b16 %0,%1 offset:%c2":"=&v"(hi[ks]):"v"(vb),"i"(d0*4096+ks*1024+512):"memory");}
    asm volatile("s_waitcnt lgkmcnt(0)":::"memory");SBAR();
    #define PK(k) (bf16x8){lo[k][0],lo[k][1],lo[k][2],lo[k][3],hi[k][0],hi[k][1],hi[k][2],hi[k][3]}
    o[d0]=__builtin_amdgcn_mfma_f32_32x32x16_bf16(pa0,PK(0),o[d0],0,0,0);
    o[d0]=__builtin_amdgcn_mfma_f32_32x32x16_bf16(pa1,PK(1),o[d0],0,0,0);
    o[d0]=__builtin_amdgcn_mfma_f32_32x32x16_bf16(pa2,PK(2),o[d0],0,0,0);
    o[d0]=__builtin_amdgcn_mfma_f32_32x32x16_bf16(pa3,PK(3),o[d0],0,0,0);
    #undef PK
  }
}

#ifndef ATTN_STORE16
#define ATTN_STORE16(p,v) (*(u32x4*)(p)=(v))
#endif
template<int THRL> __device__ __forceinline__ void attn_unit(long qrow0,long krow0,int NT_,int h,int g,const bf16*Q,const bf16*__restrict__ K,const bf16*__restrict__ V,bf16*O,char*shm){
  int tid=threadIdx.x; asm volatile("":"+v"(tid)); const int lane=tid&63,r32=lane&31,hi=lane>>5; const int wid=__builtin_amdgcn_readfirstlane(tid>>6);
  const bf16*Qw=Q+(qrow0+wid*QBLK)*QP+h*D;
  const bf16*Kh=K+krow0*KP+g*D,*Vh=V+krow0*KP+g*D;
  const unsigned lds0=(unsigned)(uintptr_t)shm;
  float*wsf=(float*)(shm+LDS_WS)+wid*64;
  const bf16*ksrc=Kh+(long)lane*KP+wid*8;
  const bf16*vsrc=Vh+(long)(16*(wid&3)+(lane>>2))*KP+(wid>>2)*32+(lane&3)*8;
  const unsigned kdst=lds0+LDS_K+wid*1024, vdst=lds0+LDS_V+wid*1024;
  #define DMA_K(t,slot) glds16(ksrc+(long)(t)*KVBLK*KP,(unsigned)__builtin_amdgcn_readfirstlane(kdst+(slot)))
  #define DMA_V(t,slot) glds16(vsrc+(long)(t)*KVBLK*KP,(unsigned)__builtin_amdgcn_readfirstlane(vdst+(slot)))
  const int vb0=(int)(lds0+LDS_V)+((lane>>4)&1)*32+(lane&3)*8+(4*hi+((lane&15)>>2))*64;
  const char*Kbase=shm+LDS_K; bf16x8 kf[8];
  const lds_cptr shm3=(lds_cptr)shm; const lds_cptr kp0=shm3+LDS_K+hi*1024+r32*16; const lds_cptr vp0=shm3+LDS_V+((lane>>4)&1)*32+(lane&3)*8+(4*hi+((lane&15)>>2))*64;
  const int NT=NT_;
  DMA_K(0,0);DMA_V(0,0);DMA_K(1,SLOTB);
  bf16x8 qr[4];
  #pragma unroll
  for(int d0=0;d0<4;++d0)qr[d0]=*reinterpret_cast<const bf16x8*>(&Qw[(long)r32*QP+d0*16+hi*8]);
  float mhat=0.f,l_reg=0.f;f32x16 o[2];o[0]=f32x16{};o[1]=f32x16{};f32x16 negm=f32x16{};asm volatile("":"+v"(negm));
  const int qrel=wid*QBLK+r32;
  #define CMASK(P0,P1,t) do{}while(0)
  bool resc=false;
  #define START(P0,P1) do{ const float rm=rowmax(P0,P1); resc=false; \
    { const float dl=rm; mhat=fadd_s(mhat,dl); \
      _Pragma("unroll") for(int r=0;r<16;++r){P0[r]=fsub_s(P0[r],dl);P1[r]=fsub_s(P1[r],dl);} \
      _Pragma("unroll") for(int r=0;r<16;++r)negm[r]=-mhat; asm volatile("":"+v"(negm)); } \
    _Pragma("unroll") for(int r=0;r<16;++r)P0[r]=__builtin_amdgcn_exp2f(P0[r]); }while(0)
  #define RESC() do{ if(resc){ asm volatile("s_waitcnt lgkmcnt(0)":::"memory"); \
      _Pragma("unroll") for(int d_=0;d_<2;++d_) _Pragma("unroll") for(int r=0;r<16;++r)o[d_][r]*=wsf[crow(r,hi)]; } }while(0)
  f32x16 pA0,pA1,pB0,pB1;
  int sl_prev=0,sl_cur=0,sl_next=SLOTB;
  #define ROT() do{sl_prev=sl_cur;sl_cur=sl_next;sl_next=(sl_next==(NSLOT-1)*SLOTB)?0:sl_next+SLOTB;}while(0)
  DMA_K(2,2*SLOTB);
  WAIT_BAR(3);
  qkt(pA0,pA1,Kbase,qr,negm,r32,hi);asm volatile("s_nop 15\n\ts_nop 7":"+v"(pA0),"+v"(pA1));CMASK(pA0,pA1,0);
  START(pA0,pA1);
  _Pragma("unroll") for(int r=0;r<16;++r)pA1[r]=__builtin_amdgcn_exp2f(pA1[r]);
  WAIT_BAR(0);
  DMA_K(3,0);DMA_V(1,SLOTB);
  ROT();
  kload8(kf,kp0+sl_cur);
  WAIT_BAR(2);
  s16x4 vlo[8],vhi[8]; u32x4 pw0,pw1,pw2,pw3;
  #define PKW(P,B) cvtpk_s(P[B],P[B+1])
  #define PAF(k) __builtin_bit_cast(bf16x8,pw##k)
  #define VFR(i) (bf16x8){vlo[i][0],vlo[i][1],vlo[i][2],vlo[i][3],vhi[i][0],vhi[i][1],vhi[i][2],vhi[i][3]}
  #define PIN(x) asm volatile("":"+v"(x))
  #define MX3(a,b,c) __builtin_fmaxf(__builtin_fmaxf((a),(b)),(c))
  #define GAPA(MF,A0,A1,A2,A3,W0,W1,PW) do{ MF; sacc+=A0; sacc+=A1; sacc+=A2; sacc+=A3; PIN(sacc); W0; W1; PIN(PW); SBAR(); }while(0)
  #define EX(v) __builtin_amdgcn_exp2f(v)
  #define GAPB(MF,X,B) do{ MF; X[B]=EX(X[B]); X[B+1]=EX(X[B+1]); X[B+2]=EX(X[B+2]); X[B+3]=EX(X[B+3]); PIN(X); SBAR(); }while(0)
  #define VRD(i) do{ vlo[i]=vtr(vp_+(((i)>>2)*4096+((i)&3)*1024)); vhi[i]=vtr(vp_+(((i)>>2)*4096+((i)&3)*1024+512)); }while(0)
  #define KRD(G,j) do{ if(G){ kload2(kf,kp0+sl_next,j); SBAR(); } }while(0)
  #define STEP(C0,C1,P0,P1,t,GK,GV,GL) do{ SBAR(); \
    const lds_cptr vp_=vp0+sl_prev; \
    VRD(0); SBAR(); float sacc=(P0[0]+P0[1]); \
    GAPA(C0=__builtin_amdgcn_mfma_f32_32x32x16_bf16(kf[0],qr[0],negm,0,0,0), P0[2],P0[3],P0[4],P0[5],     pw0[0]=PKW(P0,0), pw0[1]=PKW(P0,2), pw0); \
    VRD(4); SBAR(); GAPA(C1=__builtin_amdgcn_mfma_f32_32x32x16_bf16(kf[1],qr[0],negm,0,0,0), P0[6],P0[7],P0[8],P0[9],     pw0[2]=PKW(P0,4), pw0[3]=PKW(P0,6), pw0); \
    VRD(1); SBAR(); GAPA(C0=__builtin_amdgcn_mfma_f32_32x32x16_bf16(kf[2],qr[1],C0,0,0,0),   P0[10],P0[11],P0[12],P0[13], pw1[0]=PKW(P0,8), pw1[1]=PKW(P0,10), pw1); \
    VRD(5); SBAR(); GAPA(C1=__builtin_amdgcn_mfma_f32_32x32x16_bf16(kf[3],qr[1],C1,0,0,0),   P0[14],P0[15],P1[0],P1[1],   pw1[2]=PKW(P0,12),pw1[3]=PKW(P0,14), pw1); \
    VRD(2); SBAR(); GAPA(C0=__builtin_amdgcn_mfma_f32_32x32x16_bf16(kf[4],qr[2],C0,0,0,0),   P1[2],P1[3],P1[4],P1[5],     pw2[0]=PKW(P1,0), pw2[1]=PKW(P1,2), pw2); \
    VRD(6); SBAR(); GAPA(C1=__builtin_amdgcn_mfma_f32_32x32x16_bf16(kf[5],qr[2],C1,0,0,0),   P1[6],P1[7],P1[8],P1[9],     pw2[2]=PKW(P1,4), pw2[3]=PKW(P1,6), pw2); \
    VRD(3); SBAR(); GAPA(C0=__builtin_amdgcn_mfma_f32_32x32x16_bf16(kf[6],qr[3],C0,0,0,0),   P1[10],P1[11],P1[12],P1[13], pw3[0]=PKW(P1,8), pw3[1]=PKW(P1,10), pw3); \
    VRD(7); SBAR(); GAPA(C1=__builtin_amdgcn_mfma_f32_32x32x16_bf16(kf[7],qr[3],C1,0,0,0),   P1[14],P1[15],0.f,0.f,       pw3[2]=PKW(P1,12),pw3[3]=PKW(P1,14), pw3); \
    l_reg+=sacc; \
    if(GK){DMA_K((t)+3,sl_cur);} if(GV){DMA_V((t)+1,sl_next);} \
    CMASK(C0,C1,t); \
    { float a=MX3(C0[0],C0[1],C1[0]),b=MX3(C0[2],C0[3],C1[1]); a=MX3(a,C1[2],C1[3]); \
      _Pragma("unroll") for(int r=4;r<16;r+=4){a=MX3(a,C0[r],C0[r+1]);b=MX3(b,C0[r+2],C0[r+3]);a=MX3(a,C1[r],C1[r+1]);b=MX3(b,C1[r+2],C1[r+3]);} \
      float rm=__builtin_fmaxf(a,b); { auto rr=__builtin_amdgcn_permlane32_swap(__float_as_uint(rm),__float_as_uint(rm),false,false); rm=__builtin_fmaxf(__uint_as_float(rr[0]),__uint_as_float(rr[1])); } \
      resc=false; \
      if(__builtin_expect(__any(rm>(float)THRL),0)){ const float dl=__builtin_fmaxf(rm,0.f); mhat+=dl; \
        _Pragma("unroll") for(int r=0;r<16;++r){C0[r]-=dl;C1[r]-=dl;} \
        _Pragma("unroll") for(int r=0;r<16;++r)negm[r]=-mhat; asm volatile("":"+v"(negm)); \
        const float f=__builtin_amdgcn_exp2f(-dl); l_reg*=f; if(hi==0)wsf[r32]=f; resc=true; } } \
    SBAR(); \
    GAPB(o[0]=__builtin_amdgcn_mfma_f32_32x32x16_bf16(PAF(0),VFR(0),o[0],0,0,0), C0,0); \
    GAPB(o[1]=__builtin_amdgcn_mfma_f32_32x32x16_bf16(PAF(0),VFR(4),o[1],0,0,0), C0,4); \
    KRD(GL,0); GAPB(o[0]=__builtin_amdgcn_mfma_f32_32x32x16_bf16(PAF(1),VFR(1),o[0],0,0,0), C0,8); \
    KRD(GL,1); GAPB(o[1]=__builtin_amdgcn_mfma_f32_32x32x16_bf16(PAF(1),VFR(5),o[1],0,0,0), C0,12); \
    KRD(GL,2); GAPB(o[0]=__builtin_amdgcn_mfma_f32_32x32x16_bf16(PAF(2),VFR(2),o[0],0,0,0), C1,0); \
    KRD(GL,3); GAPB(o[1]=__builtin_amdgcn_mfma_f32_32x32x16_bf16(PAF(2),VFR(6),o[1],0,0,0), C1,4); \
    GAPB(o[0]=__builtin_amdgcn_mfma_f32_32x32x16_bf16(PAF(3),VFR(3),o[0],0,0,0), C1,8); \
    GAPB(o[1]=__builtin_amdgcn_mfma_f32_32x32x16_bf16(PAF(3),VFR(7),o[1],0,0,0), C1,12); \
    }while(0)
  int t=1;
  #undef CMASK
  #define CMASK(P0,P1,t) do{}while(0)
  for(;t+5<NT;t+=2){
    STEP(pB0,pB1,pA0,pA1,t,true,true,true);     WAIT_BAR(2); RESC(); ROT();
    STEP(pA0,pA1,pB0,pB1,t+1,true,true,true);   WAIT_BAR(2); RESC(); ROT();
  }
  #undef CMASK
  #define CMASK(P0,P1,t) do{}while(0)
  #define ENDW(tt) do{ if((tt)+3<NT){WAIT_BAR(2);} else if((tt)+2<NT){WAIT_BAR(1);} else {WAIT_BAR(0);} }while(0)
  for(;t+1<NT;t+=2){
    STEP(pB0,pB1,pA0,pA1,t,(t+3<NT),(t+1<NT),(t+1<NT));       ENDW(t);   RESC(); ROT();
    STEP(pA0,pA1,pB0,pB1,t+1,(t+4<NT),(t+2<NT),(t+2<NT));     ENDW(t+1); RESC(); ROT();
  }
  STEP(pB0,pB1,pA0,pA1,NT-1,false,false,false); RESC();
  { float sacc=pB0[0]+pB0[1]; _Pragma("unroll") for(int r=2;r<16;++r)sacc+=pB0[r]; _Pragma("unroll") for(int r=0;r<16;++r)sacc+=pB1[r]; l_reg+=sacc;
    pw0=(u32x4){PKW(pB0,0),PKW(pB0,2),PKW(pB0,4),PKW(pB0,6)};pw1=(u32x4){PKW(pB0,8),PKW(pB0,10),PKW(pB0,12),PKW(pB0,14)};pw2=(u32x4){PKW(pB1,0),PKW(pB1,2),PKW(pB1,4),PKW(pB1,6)};pw3=(u32x4){PKW(pB1,8),PKW(pB1,10),PKW(pB1,12),PKW(pB1,14)};
    SBAR(); pv(o,vb0+sl_cur,PAF(0),PAF(1),PAF(2),PAF(3)); }
  #undef PKW
  #undef PAF
  #undef VFR
  #undef PIN
  #undef MX3
  #undef GAPA
  #undef GAPB
  #undef EX
  #undef VRD
  #undef KRD
  #undef STEP
  #undef ENDW
  {auto rr=__builtin_amdgcn_permlane32_swap(__float_as_uint(l_reg),__float_as_uint(l_reg),false,false);l_reg=__uint_as_float(rr[0])+__uint_as_float(rr[1]);}
  if(hi==0)wsf[32+r32]=l_reg;asm volatile("s_waitcnt lgkmcnt(0)":::"memory");
  float rli[16];
  #pragma unroll
  for(int r=0;r<16;++r)rli[r]=__builtin_amdgcn_rcpf(wsf[32+crow(r,hi)]);
  bf16*Ow=O+(qrow0+wid*QBLK)*QP+h*D;
  { bf16*stg=(bf16*)(shm+LDS_OST)+wid*2048;
    #pragma unroll
    for(int r=0;r<16;++r){const int orow=crow(r,hi);
      #pragma unroll
      for(int d0=0;d0<2;++d0)stg[orow*64+d0*32+r32]=__float2bfloat16(o[d0][r]*rli[r]);}
    asm volatile("s_waitcnt lgkmcnt(0)":::"memory");
    #pragma unroll
    for(int i=0;i<4;++i){const int row=i*8+(lane>>3),ch=lane&7; const u32x4 v=*(const u32x4*)(stg+row*64+ch*8); ATTN_STORE16(Ow+(long)row*QP+ch*8,v);} }
  asm volatile("s_waitcnt lgkmcnt(0)\n\ts_barrier":::"memory");
  #undef DMA_K
  #undef DMA_V
  #undef CMASK
  #undef START
  #undef RESC
  #undef ROT
}

#undef SBAR
#undef WAIT_BAR
}

#define LDSW() asm volatile("s_waitcnt lgkmcnt(0)" ::: "memory")
#define MFMA32(a, b, c) __builtin_amdgcn_mfma_f32_32x32x16_bf16((a), (b), (c), 0, 0, 0)
struct Tctx { int tid, lane, wave, G, blk, gw, NGW; };
DI Tctx opaque_ctx(const Tctx& T0) { Tctx t = T0; asm volatile("" : "+v"(t.tid)); asm volatile("" : "+s"(t.blk)); asm volatile("" : "+s"(t.G));
    t.NGW = t.G * 8; t.lane = t.tid & 63; t.wave = __builtin_amdgcn_readfirstlane(t.tid >> 6); t.gw = t.blk * 8 + t.wave; return t; }

DI void transpose_item64(const float* src, int ld, bf16_t* dst, int ldd, LAS float* scr, int lane) {
    f32x4 v[16];
#pragma unroll
    for (int j = 0; j < 16; ++j) v[j] = *(const f32x4*)(src + (size_t)(4 * j + (lane >> 4)) * ld + 4 * (lane & 15));
#pragma unroll
    for (int j = 0; j < 16; ++j) { LAS float* s = scr + (4 * j + (lane >> 4)) * 65 + 4 * (lane & 15); s[0] = v[j].x; s[1] = v[j].y; s[2] = v[j].z; s[3] = v[j].w; }
    LDSW();
    const int c = lane & 7;
#pragma unroll
    for (int j = 0; j < 8; ++j) { const int n = (lane >> 3) + 8 * j; const LAS float* s = scr + (8 * c) * 65 + n;
        u32x4 o; o.x = pk2(s[0], s[65]); o.y = pk2(s[130], s[195]); o.z = pk2(s[260], s[325]); o.w = pk2(s[390], s[455]);
        *(u32x4*)(dst + (size_t)n * ldd + 8 * c) = o; }
    LDSW();
}
DI void p0_convert(const Params& P, const Tctx& T0, unsigned char* lds) { const Tctx T = opaque_ctx(T0);
    LAS float* scr = (LAS float*)lds + T.wave * (64 * 65);
    bf16_t* WIN = (bf16_t*)(P.ws + WS_WIN); bf16_t* WBR = (bf16_t*)(P.ws + WS_WBR); bf16_t* WO = (bf16_t*)(P.ws + WS_WO); bf16_t* WGU = (bf16_t*)(P.ws + WS_WGU); bf16_t* WD = (bf16_t*)(P.ws + WS_WD);
    constexpr int I_IN = 16 * 104, I_BR = 8 * 16, I_O = 16 * 16, I_G = 16 * 32, I_D = 32 * 16;
    constexpr int PER_LAYER = I_IN + 3 * I_BR + I_O + NEXP * (2 * I_G + I_D);
    for (int it0 = T.gw; it0 < NLAYER * PER_LAYER; it0 += T.NGW) {
        const int l = it0 / PER_LAYER; int it = it0 - l * PER_LAYER;
        if (it < I_IN) { const int kb = it / 104, nb = it % 104; const int scol = nb * 64 + (nb >= 16 ? 16 : 0);
            transpose_item64(P.w_in + ((size_t)l * 1024 + kb * 64) * IN_COLS + scol, IN_COLS, WIN + ((size_t)l * NP + nb * 64) * 1024 + kb * 64, 1024, scr, T.lane); continue; }
        it -= I_IN;
        if (it < 3 * I_BR) { const int j = it / I_BR; it -= j * I_BR; const int kb = it / 16, nb = it % 16; const float* w = (j == 0) ? P.w_br_attn : (j == 1 ? P.w_br_ssd : P.w_br_conv);
            transpose_item64(w + ((size_t)l * 512 + kb * 64) * 1024 + nb * 64, 1024, WBR + (((size_t)l * 3 + j) * 1024 + nb * 64) * 512 + kb * 64, 512, scr, T.lane); continue; }
        it -= 3 * I_BR;
        if (it < I_O) { const int kb = it / 16, nb = it % 16;
            transpose_item64(P.w_o + ((size_t)l * 1024 + kb * 64) * 1024 + nb * 64, 1024, WO + ((size_t)l * 1024 + nb * 64) * 1024 + kb * 64, 1024, scr, T.lane); continue; }
        it -= I_O;
        const int e = it / (2 * I_G + I_D); it -= e * (2 * I_G + I_D);
        if (it < 2 * I_G) { const int up = it / I_G; it -= up * I_G; const int kb = it / 32, nb = it % 32; const float* w = up ? P.w_exp_up : P.w_exp_gate;
            const int f0 = nb * 64, pn = f0 >> 7, within = f0 & 127; const size_t drow = ((size_t)(l * NEXP + e) * 16 + pn) * 256 + up * 128 + within;
            transpose_item64(w + (((size_t)l * NEXP + e) * 1024 + kb * 64) * 2048 + nb * 64, 2048, WGU + drow * 1024 + kb * 64, 1024, scr, T.lane); continue; }
        it -= 2 * I_G;
        { const int kb = it / 16, nb = it % 16;
            transpose_item64(P.w_exp_down + (((size_t)l * NEXP + e) * 2048 + kb * 64) * 1024 + nb * 64, 1024, WD + (((size_t)l * NEXP + e) * 1024 + nb * 64) * 2048 + kb * 64, 2048, scr, T.lane); }
    }
}
DI void p0_modv(const Params& P, const Tctx& T0, unsigned char* lds_, int item) { const Tctx T = opaque_ctx(T0);
    LAS float* lds = (LAS float*)lds_;
    const int layer = item / 96, jb = item % 96;
    for (int i = T.tid; i < 5120; i += 512) { const int row = i >> 10, k = i & 1023; const float cv = row < 4 ? P.c[row * 1024 + k] : P.c_ctx[k]; lds[i] = siluf_(cv); }
    __syncthreads();
    const int col = T.tid & 63, ks = T.tid >> 6;
    const float* w = P.w_mod + ((size_t)layer * 1024 + ks * 128) * 6144 + jb * 64 + col;
    float a0 = 0.f, a1 = 0.f, a2 = 0.f, a3 = 0.f, a4 = 0.f;
#pragma unroll 8
    for (int k = 0; k < 128; ++k) { const float wv = w[(size_t)k * 6144]; const int kk = ks * 128 + k;
        a0 += lds[kk] * wv; a1 += lds[1024 + kk] * wv; a2 += lds[2048 + kk] * wv; a3 += lds[3072 + kk] * wv; a4 += lds[4096 + kk] * wv; }
    LAS float* red = lds + 5120;
    red[(ks * 5 + 0) * 64 + col] = a0; red[(ks * 5 + 1) * 64 + col] = a1; red[(ks * 5 + 2) * 64 + col] = a2; red[(ks * 5 + 3) * 64 + col] = a3; red[(ks * 5 + 4) * 64 + col] = a4;
    __syncthreads();
    if (T.tid < 320) { const int row = T.tid >> 6, cc = T.tid & 63; float s = 0.f;
#pragma unroll
        for (int q = 0; q < 8; ++q) s += red[(q * 5 + row) * 64 + cc];
        ((float*)(P.ws + WS_MODV))[((size_t)layer * 5 + row) * 6144 + jb * 64 + cc] = s + P.b_mod[(size_t)layer * 6144 + jb * 64 + cc]; }
    __syncthreads();
}
DI void p0_rope(const Params& P, const Tctx& T0) { const Tctx T = opaque_ctx(T0);
    float* tab = (float*)(P.ws + WS_ROPE);
    for (int i = T.tid; i < 1024; i += 512) { const int pos = i >> 4, j = i & 15;
        const float inv = exp2f(-(float)j * (13.287712379549449f / 16.f));
        const float ang = (float)pos * inv; float rev = ang * 0.15915494309189535f; rev -= floorf(rev);
        tab[2 * i] = __builtin_amdgcn_cosf(rev); tab[2 * i + 1] = __builtin_amdgcn_sinf(rev); }
}

DI void ln_norm(f32x4 (&v)[4]) {
    float s = 0.f;
#pragma unroll
    for (int j = 0; j < 4; ++j) s += (v[j].x + v[j].y) + (v[j].z + v[j].w);
    const float mean = wave_sum(s) * (1.f / DMODEL); float s2 = 0.f;
#pragma unroll
    for (int j = 0; j < 4; ++j) { v[j] = v[j] - mean; s2 += (v[j].x * v[j].x + v[j].y * v[j].y) + (v[j].z * v[j].z + v[j].w * v[j].w); }
    const float rstd = rsqrtf(wave_sum(s2) * (1.f / DMODEL) + EPSF);
#pragma unroll
    for (int j = 0; j < 4; ++j) v[j] = v[j] * rstd;
}
DI void load_row(const float* p, int lane, f32x4 (&v)[4]) {
#pragma unroll
    for (int j = 0; j < 4; ++j) v[j] = *((const f32x4*)p + lane + 64 * j);
}
DI void store_row(float* p, int lane, const f32x4 (&v)[4]) {
#pragma unroll
    for (int j = 0; j < 4; ++j) *((f32x4*)p + lane + 64 * j) = v[j];
}
DI void store_row_bf16(bf16_t* p, int lane, const f32x4 (&v)[4]) {
#pragma unroll
    for (int j = 0; j < 4; ++j) { u32x2 o; o.x = pk2(v[j].x, v[j].y); o.y = pk2(v[j].z, v[j].w); *((u32x2*)p + lane + 64 * j) = o; }
}
DI void stage_w16(LAS float* Wl, const float* src, int ld, int tid) {
    for (int idx = tid; idx < 16384; idx += 512) { const int k = idx >> 4, jj = idx & 15; const int j = k >> 8, l = (k & 255) >> 2, e = k & 3;
        Wl[((j * 4 + e) * 64 + l) * 16 + jj] = src[(size_t)k * ld + jj]; }
}
DI void row_dot16(const f32x4 (&h)[4], const LAS float* Wl, int lane, float (&s)[16]) {
#pragma unroll
    for (int q = 0; q < 16; ++q) s[q] = 0.f;
#pragma unroll
    for (int j = 0; j < 4; ++j)
#pragma unroll
        for (int e = 0; e < 4; ++e) { const float x = h[j][e]; const LAS f32x4* wp = (const LAS f32x4*)(Wl + ((j * 4 + e) * 64 + lane) * 16);
#pragma unroll
            for (int q = 0; q < 4; ++q) { const f32x4 w = wp[q]; s[4 * q] += x * w.x; s[4 * q + 1] += x * w.y; s[4 * q + 2] += x * w.z; s[4 * q + 3] += x * w.w; }
            if (e & 1) asm volatile("" ::: "memory"); }
}

DI void p1_modulate(const Params& P, const Tctx& T0, unsigned char* lds, int layer) { const Tctx T = opaque_ctx(T0);
    LAS float* Wl = (LAS float*)lds;
    stage_w16(Wl, P.w_in + (size_t)layer * 1024 * IN_COLS + 1024, IN_COLS, T.tid);
    __syncthreads();
    const float* modv = (const float*)(P.ws + WS_MODV) + (size_t)layer * 5 * 6144;
    bf16_t* H = (bf16_t*)(P.ws + WS_H); float* DT = (float*)(P.ws + WS_DT);
    for (int r = T.gw; r < MR; r += T.NGW) {
        int b, p; row_bp(r, b, p); const int mrow = p < CTXL ? 4 : b;
        f32x4 v[4]; load_row(xsrc_row(P, layer, r), T.lane, v); ln_norm(v);
        const float* mv = modv + (size_t)mrow * 6144;
#pragma unroll
        for (int j = 0; j < 4; ++j) { const f32x4 sh = *((const f32x4*)mv + T.lane + 64 * j), sc = *((const f32x4*)(mv + 1024) + T.lane + 64 * j); v[j] = v[j] * (sc + 1.f) + sh; }
        store_row_bf16(H + (size_t)r * DMODEL, T.lane, v);
        float s[16]; row_dot16(v, Wl, T.lane, s); float mine = 0.f;
#pragma unroll
        for (int q = 0; q < 16; ++q) { const float t = wave_sum(s[q]); if (T.lane == q) mine = t; }
        if (T.lane < 16) { const float xx = mine + P.ssd_dt_bias[layer * 16 + T.lane]; DT[(size_t)r * 16 + T.lane] = xx > 20.f ? xx : __logf(1.f + __expf(xx)); }
    }
    __syncthreads();
}

DI void norm_rope8(float (&y)[8], const float* nw, int lq, bool do_rope, const float* tab_row, const float* tab_col, float outscale) {
    float ss = 0.f;
#pragma unroll
    for (int e = 0; e < 8; ++e) ss += y[e] * y[e];
    ss += __shfl_xor(ss, 1); ss += __shfl_xor(ss, 2); ss += __shfl_xor(ss, 4);
    const float rstd = rsqrtf(ss * (1.f / 64.f) + EPSF);
#pragma unroll
    for (int e = 0; e < 8; ++e) y[e] = y[e] * rstd * nw[8 * lq + e];
    if (do_rope) { const int axis = lq >> 2, half = (lq >> 1) & 1, j0 = 8 * (lq & 1); const float* tab = (axis ? tab_col : tab_row) + 2 * j0;
#pragma unroll
        for (int e = 0; e < 8; ++e) { const float pr = __shfl_xor(y[e], 2); const float cs = tab[2 * e], sn = tab[2 * e + 1]; y[e] = half ? y[e] * cs + pr * sn : y[e] * cs - pr * sn; } }
#pragma unroll
    for (int e = 0; e < 8; ++e) y[e] *= outscale;
}
DI void p3_post(const Params& P, const Tctx& T0, int layer) { const Tctx T = opaque_ctx(T0);
    const bf16_t* PROJ = (const bf16_t*)(P.ws + WS_PROJ); const float* rope = (const float*)(P.ws + WS_ROPE);
    bf16_t* Qf = (bf16_t*)(P.ws + WS_Q); bf16_t* Kf = (bf16_t*)(P.ws + WS_K); bf16_t* Vf = (bf16_t*)(P.ws + WS_V); bf16_t* XBC = (bf16_t*)(P.ws + WS_XBC); bf16_t* YC = (bf16_t*)(P.ws + WS_YC);
    const int lane = T.lane, lq = lane & 7;
    for (int r = T.gw; r < MR; r += T.NGW) {
        int b, p; row_bp(r, b, p); const bool isctx = p < CTXL; const int pos = isctx ? 0 : p - CTXL;
        const float* trow = rope + (size_t)(pos >> 6) * 32; const float* tcol = rope + (size_t)(pos & 63) * 32;
        const bf16_t* pr = PROJ + (size_t)r * NP;
        { float y[8]; unpack8(*(const u32x4*)(pr + PQ + 8 * lane), y); norm_rope8(y, P.q_norm + layer * 64, lq, !isctx, trow, tcol, QSCALE); *(u32x4*)(Qf + (size_t)r * 512 + 8 * lane) = pack8(y); }
        { const int l16 = lane & 15; float y[8]; unpack8(*(const u32x4*)(pr + PK + 8 * l16), y); norm_rope8(y, P.k_norm + layer * 64, lq, !isctx, trow, tcol, 1.f);
          if (lane < 16) *(u32x4*)(Kf + (size_t)r * 128 + 8 * lane) = pack8(y);
          else if (lane < 32) *(u32x4*)(Vf + (size_t)r * 128 + 8 * (lane - 16)) = *(const u32x4*)(pr + PV + 8 * (lane - 16)); }
        const bool hasprev = !(p == 0 || p == CTXL), hasnext = !(p == CTXL - 1 || p == TPB - 1);
#pragma unroll
        for (int pass = 0; pass < 2; ++pass) { const int ch0 = 8 * lane + 512 * pass;
            if (ch0 < 768) { float cu[8], pv[8], nx[8]; unpack8(*(const u32x4*)(pr + PXBC + ch0), cu);
                if (hasprev) unpack8(*(const u32x4*)(pr - NP + PXBC + ch0), pv); else {
#pragma unroll
                    for (int e = 0; e < 8; ++e) pv[e] = 0.f; }
                if (hasnext) unpack8(*(const u32x4*)(pr + NP + PXBC + ch0), nx); else {
#pragma unroll
                    for (int e = 0; e < 8; ++e) nx[e] = 0.f; }
                const float* cw = P.ssd_conv_w + (size_t)layer * 3 * 768 + ch0; const float* cb = P.ssd_conv_b + (size_t)layer * 768 + ch0; float o[8];
#pragma unroll
                for (int e = 0; e < 8; ++e) { const float t = cw[e] * pv[e] + cw[768 + e] * cu[e] + cw[1536 + e] * nx[e] + cb[e]; o[e] = siluf_(t); }
                *(u32x4*)(XBC + (size_t)r * 768 + ch0) = pack8(o); } }
        { const int ch0 = 8 * lane; float bq[8], c0[8], x0[8], c1[8], x1[8], c2[8], x2[8];
            unpack8(*(const u32x4*)(pr + PSCB + ch0), bq); unpack8(*(const u32x4*)(pr + PSCC + ch0), c1); unpack8(*(const u32x4*)(pr + PSCX + ch0), x1);
            if (hasprev) { unpack8(*(const u32x4*)(pr - NP + PSCC + ch0), c0); unpack8(*(const u32x4*)(pr - NP + PSCX + ch0), x0); } else {
#pragma unroll
                for (int e = 0; e < 8; ++e) { c0[e] = 0.f; x0[e] = 0.f; } }
            if (hasnext) { unpack8(*(const u32x4*)(pr + NP + PSCC + ch0), c2); unpack8(*(const u32x4*)(pr + NP + PSCX + ch0), x2); } else {
#pragma unroll
                for (int e = 0; e < 8; ++e) { c2[e] = 0.f; x2[e] = 0.f; } }
            const float* cw = P.sc_conv_w + (size_t)layer * 3 * 512 + ch0; float o[8];
#pragma unroll
            for (int e = 0; e < 8; ++e) o[e] = bq[e] * (cw[e] * (c0[e] * x0[e]) + cw[512 + e] * (c1[e] * x1[e]) + cw[1024 + e] * (c2[e] * x2[e]));
            *(u32x4*)(YC + (size_t)r * 512 + ch0) = pack8(o); }
    }
}

constexpr int XT_LD = 136;
DI void ssd_stage_t(const bf16_t* src, int ld, int nch8  , LAS bf16_t* dstT, int tid, int nload) {
    for (int i = 0; i < nload; ++i) { const int q = tid + 512 * i; const int s = q / nch8, ch0 = (q % nch8) * 8;
        const u32x4 v = *(const u32x4*)(src + (size_t)s * ld + ch0); LAS bf16_t* d = dstT + ch0 * XT_LD + s;
        d[0] = (bf16_t)(v.x & 0xffff); d[XT_LD] = (bf16_t)(v.x >> 16); d[2 * XT_LD] = (bf16_t)(v.y & 0xffff); d[3 * XT_LD] = (bf16_t)(v.y >> 16);
        d[4 * XT_LD] = (bf16_t)(v.z & 0xffff); d[5 * XT_LD] = (bf16_t)(v.z >> 16); d[6 * XT_LD] = (bf16_t)(v.w & 0xffff); d[7 * XT_LD] = (bf16_t)(v.w >> 16); }
}
DI bf16x8 scale8(const u32x4 v, const float (&w)[8]) { float f[8]; unpack8(v, f);
#pragma unroll
    for (int e = 0; e < 8; ++e) f[e] *= w[e];
    return __builtin_bit_cast(bf16x8, pack8(f)); }
DI bf16x8 scale8s(const u32x4 v, float w) { float f[8]; unpack8(v, f);
#pragma unroll
    for (int e = 0; e < 8; ++e) f[e] *= w;
    return __builtin_bit_cast(bf16x8, pack8(f)); }

DI void ssd_a(const Params& P, const Tctx& T0, unsigned char* lds_, int layer) { const Tctx T = opaque_ctx(T0);
    const bf16_t* XBC = (const bf16_t*)(P.ws + WS_XBC); const float* DT = (const float*)(P.ws + WS_DT); float* ACS = (float*)(P.ws + WS_ACS); float* ST = (float*)(P.ws + WS_ST);
    LAS bf16_t* XT = (LAS bf16_t*)lds_; LAS bf16_t* BT = (LAS bf16_t*)(lds_ + 69632); LAS float* lw = (LAS float*)(lds_ + 87040);
    const int lane = T.lane, w = T.wave, r = lane & 31, hb = lane >> 5;
    for (int u = T.blk; u < NBATCH * NCH * 2; u += T.G) {
        const int g = u & 1, c = (u >> 1) % NCH, b = u / (2 * NCH); const int r0 = b * TPB + c * 128;
        const int hh = w & 3, dir = w >> 2, h = 4 * g + hh, dh = dir * 8 + h;
        { const float a = -__expf(P.ssd_a_log[layer * 16 + dh]); const int l0 = 2 * lane;
          const float d0 = DT[(size_t)(r0 + l0) * 16 + dh], d1 = DT[(size_t)(r0 + l0 + 1) * 16 + dh]; const float v0 = d0 * a, v1 = d1 * a; const float s = v0 + v1; float Pf = s;
#pragma unroll
          for (int o = 1; o < 64; o <<= 1) { const float t = __shfl_up(Pf, o); if (lane >= o) Pf += t; }
          const float tot = __shfl(Pf, 63); float a0, a1;
          if (dir == 0) { a0 = Pf - v1; a1 = Pf; } else { const float S = tot - Pf + s; a0 = S; a1 = S - v0; }
          ACS[(size_t)(r0 + l0) * 16 + dh] = a0; ACS[(size_t)(r0 + l0 + 1) * 16 + dh] = a1;
          lw[w * 128 + l0] = __expf(tot - a0) * d0; lw[w * 128 + l0 + 1] = __expf(tot - a1) * d1; }
        ssd_stage_t(XBC + (size_t)r0 * 768 + 256 * g, 768, 32, XT, T.tid, 8);
        ssd_stage_t(XBC + (size_t)r0 * 768 + 512 + 64 * g, 768, 8, BT, T.tid, 2);
        __syncthreads();
        f32x16 acc[2][2];
#pragma unroll
        for (int i = 0; i < 2; ++i)
#pragma unroll
            for (int j = 0; j < 2; ++j)
#pragma unroll
                for (int q = 0; q < 16; ++q) acc[i][j][q] = 0.f;
#pragma unroll 2
        for (int kk = 0; kk < 8; ++kk) { float wv[8]; { const f32x4 w0 = *(const LAS f32x4*)(lw + w * 128 + 16 * kk + 8 * hb), w1 = *(const LAS f32x4*)(lw + w * 128 + 16 * kk + 8 * hb + 4);
                wv[0] = w0.x; wv[1] = w0.y; wv[2] = w0.z; wv[3] = w0.w; wv[4] = w1.x; wv[5] = w1.y; wv[6] = w1.z; wv[7] = w1.w; }
            bf16x8 af[2], bfr[2];
#pragma unroll
            for (int pt = 0; pt < 2; ++pt) af[pt] = scale8(*(const LAS u32x4*)(XT + (64 * hh + 32 * pt + r) * XT_LD + 16 * kk + 8 * hb), wv);
#pragma unroll
            for (int nt = 0; nt < 2; ++nt) bfr[nt] = *(const LAS bf16x8*)(BT + (32 * nt + r) * XT_LD + 16 * kk + 8 * hb);
#pragma unroll
            for (int pt = 0; pt < 2; ++pt)
#pragma unroll
                for (int nt = 0; nt < 2; ++nt) acc[pt][nt] = MFMA32(af[pt], bfr[nt], acc[pt][nt]); }
        float* st = ST + ((((size_t)dir * NBATCH + b) * NCH + c) * 8 + h) * 4096;
#pragma unroll
        for (int pt = 0; pt < 2; ++pt)
#pragma unroll
            for (int nt = 0; nt < 2; ++nt)
#pragma unroll
                for (int i = 0; i < 16; ++i) st[(32 * pt + crow(i, hb)) * 64 + 32 * nt + r] = acc[pt][nt][i];
        __syncthreads();
    }
}
DI void ssd_b(const Params& P, const Tctx& T0) { const Tctx T = opaque_ctx(T0);
    float* ST = (float*)(P.ws + WS_ST); const float* ACS = (const float*)(P.ws + WS_ACS);
    for (int e = T.blk * 512 + T.tid; e < 2 * NBATCH * 8 * 4096; e += T.G * 512) {
        const int pn = e & 4095, h = (e >> 12) & 7, b = (e >> 15) & 3, dir = e >> 17; float hs = 0.f;
#pragma unroll 2
        for (int i = 0; i < NCH; ++i) { const int c = dir == 0 ? i : (i < 2 ? 1 - i : NCH + 1 - i);
            float* sp = ST + ((((size_t)dir * NBATCH + b) * NCH + c) * 8 + h) * 4096 + pn;
            const float dec = __expf(ACS[(size_t)(b * TPB + c * 128 + (dir == 0 ? 127 : 0)) * 16 + dir * 8 + h]);
            const float st = *sp; *sp = hs; hs = dec * hs + st; }
    }
}
DI void ssd_c(const Params& P, const Tctx& T0, unsigned char* lds_, int layer) { const Tctx T = opaque_ctx(T0);
    const bf16_t* XBC = (const bf16_t*)(P.ws + WS_XBC); const float* DT = (const float*)(P.ws + WS_DT); const float* ACS = (const float*)(P.ws + WS_ACS); const float* ST = (const float*)(P.ws + WS_ST);
    bf16_t* YRAW = (bf16_t*)(P.ws + WS_YRAW);
    LAS bf16_t* XT = (LAS bf16_t*)lds_; LAS bf16_t* Wst = (LAS bf16_t*)(lds_ + 69632) + T.wave * (32 * XT_LD); LAS float* lacs = (LAS float*)(lds_ + 139264);
    const int lane = T.lane, w = T.wave, r = lane & 31, hb = lane >> 5;
    for (int u = T.blk; u < NBATCH * NCH * 2; u += T.G) {
        const int g = u & 1, c = (u >> 1) % NCH, b = u / (2 * NCH); const int r0 = b * TPB + c * 128;
        const int hh = w & 3, half = w >> 2, h = 4 * g + hh;
        for (int i = T.tid; i < 1024; i += 512) { const int l = i & 127, dd = (i >> 7) & 1, h4 = i >> 8; lacs[i] = ACS[(size_t)(r0 + l) * 16 + dd * 8 + 4 * g + h4]; }
        ssd_stage_t(XBC + (size_t)r0 * 768 + 256 * g, 768, 32, XT, T.tid, 8);
        __syncthreads();
        float acsf_s[4], acsb_s[4], dtf_s[4], dtb_s[4];
#pragma unroll
        for (int j = 0; j < 4; ++j) { const int s = 32 * j + r; acsf_s[j] = lacs[(hh * 2) * 128 + s]; acsb_s[j] = lacs[(hh * 2 + 1) * 128 + s];
            dtf_s[j] = DT[(size_t)(r0 + s) * 16 + h]; dtb_s[j] = DT[(size_t)(r0 + s) * 16 + 8 + h]; }
        const float Dh = P.ssd_d[layer * 8 + h];
        const bf16_t* Cg = XBC + (size_t)r0 * 768 + 640 + 64 * g; const bf16_t* Bg = XBC + (size_t)r0 * 768 + 512 + 64 * g;
#pragma unroll 1
        for (int lb = 0; lb < 2; ++lb) { const int l0 = 64 * half + 32 * lb;
            f32x16 gt[4];
#pragma unroll
            for (int j = 0; j < 4; ++j)
#pragma unroll
                for (int q = 0; q < 16; ++q) gt[j][q] = 0.f;
#pragma unroll
            for (int kk = 0; kk < 4; ++kk) { const bf16x8 af = *(const bf16x8*)(Cg + (size_t)(l0 + r) * 768 + 16 * kk + 8 * hb);
#pragma unroll
                for (int j = 0; j < 4; ++j) { const bf16x8 bfr = *(const bf16x8*)(Bg + (size_t)(32 * j + r) * 768 + 16 * kk + 8 * hb); gt[j] = MFMA32(af, bfr, gt[j]); } }
#pragma unroll
            for (int i = 0; i < 16; ++i) { const int lr = crow(i, hb), l = l0 + lr; const float af_l = lacs[(hh * 2) * 128 + l], ab_l = lacs[(hh * 2 + 1) * 128 + l];
#pragma unroll
                for (int j = 0; j < 4; ++j) { const int s = 32 * j + r;
                    const float argf = (s <= l) ? af_l - acsf_s[j] : -INFINITY, argb = (s >= l) ? ab_l - acsb_s[j] : -INFINITY;
                    const float wgt = __expf(argf) * dtf_s[j] + __expf(argb) * dtb_s[j];
                    const float val = gt[j][i] * wgt + (s == l ? Dh : 0.f);
                    Wst[lr * XT_LD + s] = (bf16_t)(pk2(val, 0.f) & 0xffff); } }
            LDSW();
            f32x16 y[2];
#pragma unroll
            for (int pt = 0; pt < 2; ++pt)
#pragma unroll
                for (int q = 0; q < 16; ++q) y[pt][q] = 0.f;
#pragma unroll 2
            for (int kk = 0; kk < 8; ++kk) { const bf16x8 af = *(const LAS bf16x8*)(Wst + r * XT_LD + 16 * kk + 8 * hb);
#pragma unroll
                for (int pt = 0; pt < 2; ++pt) { const bf16x8 bfr = *(const LAS bf16x8*)(XT + (64 * hh + 32 * pt + r) * XT_LD + 16 * kk + 8 * hb); y[pt] = MFMA32(af, bfr, y[pt]); } }
#pragma unroll 1
            for (int dd = 0; dd < 2; ++dd) { const float el = __expf(lacs[(hh * 2 + dd) * 128 + l0 + r]);
                const float* hs = ST + ((((size_t)dd * NBATCH + b) * NCH + c) * 8 + h) * 4096;
#pragma unroll
                for (int kk = 0; kk < 4; ++kk) { const bf16x8 af = scale8s(*(const u32x4*)(Cg + (size_t)(l0 + r) * 768 + 16 * kk + 8 * hb), el);
#pragma unroll
                    for (int pt = 0; pt < 2; ++pt) { const float* hp = hs + (32 * pt + r) * 64 + 16 * kk + 8 * hb; const f32x4 h0 = *(const f32x4*)hp, h1 = *(const f32x4*)(hp + 4);
                        u32x4 pkd; pkd.x = pk2(h0.x, h0.y); pkd.y = pk2(h0.z, h0.w); pkd.z = pk2(h1.x, h1.y); pkd.w = pk2(h1.z, h1.w);
                        y[pt] = MFMA32(af, __builtin_bit_cast(bf16x8, pkd), y[pt]); } } }
#pragma unroll
            for (int pt = 0; pt < 2; ++pt)
#pragma unroll
                for (int i = 0; i < 16; ++i) YRAW[(size_t)(r0 + l0 + crow(i, hb)) * 512 + h * 64 + 32 * pt + r] = (bf16_t)(pk2(y[pt][i], 0.f) & 0xffff);
            LDSW();
        }
        __syncthreads();
    }
}
DI void ys_finalize(const Params& P, const Tctx& T0, int layer) { const Tctx T = opaque_ctx(T0);
    const bf16_t* YRAW = (const bf16_t*)(P.ws + WS_YRAW); const bf16_t* PROJ = (const bf16_t*)(P.ws + WS_PROJ); bf16_t* YS = (bf16_t*)(P.ws + WS_YS);
    for (int r = T.gw; r < MR; r += T.NGW) {
        if (layer == 1 && (r % TPB) < CTXL) continue;
        float y[8], z[8]; unpack8(*(const u32x4*)(YRAW + (size_t)r * 512 + 8 * T.lane), y); unpack8(*(const u32x4*)(PROJ + (size_t)r * NP + PZ + 8 * T.lane), z);
        float ss = 0.f;
#pragma unroll
        for (int e = 0; e < 8; ++e) { y[e] *= siluf_(z[e]); ss += y[e] * y[e]; }
        const float rstd = rsqrtf(wave_sum(ss) * (1.f / 512.f) + EPSF); const float* nw = P.ssd_norm + layer * 512 + 8 * T.lane;
#pragma unroll
        for (int e = 0; e < 8; ++e) y[e] = y[e] * rstd * nw[e];
        *(u32x4*)(YS + (size_t)r * 512 + 8 * T.lane) = pack8(y);
    }
}

DI void p7_ln_router(const Params& P, const Tctx& T0, unsigned char* lds, int layer) { const Tctx T = opaque_ctx(T0);
    LAS float* Wl = (LAS float*)lds;
    stage_w16(Wl, P.w_router + (size_t)layer * 1024 * 16, 16, T.tid);
    __syncthreads();
    const float* modv = (const float*)(P.ws + WS_MODV) + (size_t)layer * 5 * 6144;
    float* X1 = (float*)(P.ws + WS_X1); bf16_t* H = (bf16_t*)(P.ws + WS_H); float* AFF = (float*)(P.ws + WS_AFF);
    const float* g1 = P.ln1_g + layer * 1024; const float* b1 = P.ln1_b + layer * 1024;
    for (int r = T.gw; r < MR; r += T.NGW) {
        int b, p; row_bp(r, b, p); if (layer == 1 && p < CTXL) continue; const int mrow = p < CTXL ? 4 : b;
        f32x4 v[4]; load_row(X1 + (size_t)r * DMODEL, T.lane, v); ln_norm(v);
#pragma unroll
        for (int j = 0; j < 4; ++j) v[j] = v[j] * *((const f32x4*)g1 + T.lane + 64 * j) + *((const f32x4*)b1 + T.lane + 64 * j);
        store_row(X1 + (size_t)r * DMODEL, T.lane, v);
        ln_norm(v); const float* mv = modv + (size_t)mrow * 6144;
#pragma unroll
        for (int j = 0; j < 4; ++j) { const f32x4 sh = *((const f32x4*)(mv + 3072) + T.lane + 64 * j), sc = *((const f32x4*)(mv + 4096) + T.lane + 64 * j); v[j] = v[j] * (sc + 1.f) + sh; }
        store_row_bf16(H + (size_t)r * DMODEL, T.lane, v);
        float s[16]; row_dot16(v, Wl, T.lane, s); float mine = -INFINITY;
#pragma unroll
        for (int q = 0; q < 16; ++q) { const float t = wave_sum(s[q]); if (T.lane == q) mine = t; }
        float mx = mine;
#pragma unroll
        for (int o = 1; o < 16; o <<= 1) mx = fmaxf(mx, __shfl_xor(mx, o));
        const float ex = (T.lane < 16) ? expf(mine - mx) : 0.f; float sm = ex;
#pragma unroll
        for (int o = 1; o < 16; o <<= 1) sm += __shfl_xor(sm, o);
        if (T.lane < 16) AFF[(size_t)r * 16 + T.lane] = ex / sm;
    }
    __syncthreads();
}

DI unsigned block_scan_excl(unsigned v, LAS unsigned* wt, int lane, int wave, unsigned& total) {
    unsigned inc = v;
#pragma unroll
    for (int o = 1; o < 64; o <<= 1) { const unsigned t = __shfl_up(inc, o); if (lane >= o) inc += t; }
    if (lane == 63) wt[wave] = inc;
    __syncthreads();
    unsigned off = 0, tot = 0;
#pragma unroll
    for (int q = 0; q < 8; ++q) { const unsigned t = wt[q]; if (q < wave) off += t; tot += t; }
    __syncthreads();
    total = tot; return off + inc - v;
}
DI void p8_topk(const Params& P, const Tctx& T0, unsigned char* lds_, int layer) { const Tctx T = opaque_ctx(T0);
    const float* AFF = (const float*)(P.ws + WS_AFF); int* SLOT = (int*)(P.ws + WS_SLOT); float* AFFSEL = (float*)(P.ws + WS_AFFSEL);
    const bf16_t* H = (const bf16_t*)(P.ws + WS_H); bf16_t* XS = (bf16_t*)(P.ws + WS_XS);
    LAS unsigned* cnt = (LAS unsigned*)lds_; LAS unsigned* wt = cnt + 16; LAS int* rows = (LAS int*)(cnt + 32);
    const int ntask = layer == 0 ? 128 : 64;
    for (int task = T.blk; task < ntask; task += T.G) {
        const int set = task >> 6, tt = task & 63, b = tt >> 4, e = tt & 15; const int n = set ? CTXL : SEQL, k = set ? 32 : 512;
        const int rowbase = b * TPB + (set ? 0 : CTXL), slotbase = set ? 2048 + b * 32 : b * 512;
        unsigned key[8];
#pragma unroll
        for (int j = 0; j < 8; ++j) { const int idx = T.tid * 8 + j; key[j] = idx < n ? __float_as_uint(AFF[(size_t)(rowbase + idx) * 16 + e]) : 0u; }
        unsigned prefix = 0;
        for (int bit = 29; bit >= 0; --bit) { const unsigned cand = prefix | (1u << bit); int c = 0;
#pragma unroll
            for (int j = 0; j < 8; ++j) c += key[j] >= cand ? 1 : 0;
            c = wave_sum_i(c); if (T.lane == 0) cnt[(bit & 1) * 8 + T.wave] = (unsigned)c;
            __syncthreads();
            unsigned tot = 0;
#pragma unroll
            for (int q = 0; q < 8; ++q) tot += cnt[(bit & 1) * 8 + q];
            if ((int)tot >= k) prefix = cand; }
        unsigned cg_ = 0, ce_ = 0;
#pragma unroll
        for (int j = 0; j < 8; ++j) { cg_ += key[j] > prefix ? 1u : 0u; ce_ += key[j] == prefix ? 1u : 0u; }
        unsigned total; const unsigned ex1 = block_scan_excl((ce_ << 16) | cg_, wt, T.lane, T.wave, total);
        const int need_eq = k - (int)(total & 0xffffu); int eq_rank = (int)(ex1 >> 16);
        unsigned selm = 0, nsel = 0;
#pragma unroll
        for (int j = 0; j < 8; ++j) { bool s = key[j] > prefix; if (key[j] == prefix) { s = eq_rank < need_eq; ++eq_rank; } if (s) { selm |= 1u << j; ++nsel; } }
        unsigned tot2; unsigned pos = block_scan_excl(nsel, wt, T.lane, T.wave, tot2);
#pragma unroll
        for (int j = 0; j < 8; ++j) { const int idx = T.tid * 8 + j; if (idx < n) { const int r = rowbase + idx;
                if (selm & (1u << j)) { const int slot = slotbase + (int)pos; SLOT[(size_t)r * 16 + e] = slot; AFFSEL[e * ESTR + slot] = __uint_as_float(key[j]); rows[pos] = r; ++pos; }
                else SLOT[(size_t)r * 16 + e] = -1; } }
        __syncthreads();
        for (int s = T.wave; s < k; s += 8) { const int r = rows[s]; const u32x4* src = (const u32x4*)(H + (size_t)r * DMODEL); u32x4* dst = (u32x4*)(XS + ((size_t)e * ESTR + slotbase + s) * DMODEL);
            dst[T.lane] = src[T.lane]; dst[T.lane + 64] = src[T.lane + 64]; }
        __syncthreads();
    }
}

DI void p11_combine(const Params& P, const Tctx& T0, int layer) { const Tctx T = opaque_ctx(T0);
    const float* X1 = (const float*)(P.ws + WS_X1); const int* SLOT = (const int*)(P.ws + WS_SLOT); const bf16_t* Y = (const bf16_t*)(P.ws + WS_XS);
    const float* modv = (const float*)(P.ws + WS_MODV) + (size_t)layer * 5 * 6144; float* XA = (float*)(P.ws + WS_XA);
    const float* g2 = P.ln2_g + layer * 1024; const float* b2 = P.ln2_b + layer * 1024;
    for (int r = T.gw; r < MR; r += T.NGW) {
        int b, p; row_bp(r, b, p); if (layer == 1 && p < CTXL) continue; const int mrow = p < CTXL ? 4 : b;
        f32x4 v[4], acc[4]; load_row(X1 + (size_t)r * DMODEL, T.lane, v);
#pragma unroll
        for (int j = 0; j < 4; ++j) acc[j] = (f32x4){0.f, 0.f, 0.f, 0.f};
        const int sl = SLOT[(size_t)r * 16 + (T.lane & 15)];
        for (int e = 0; e < 16; ++e) { const int s = __shfl(sl, e); if (s >= 0) { const bf16_t* yr = Y + ((size_t)e * ESTR + s) * DMODEL;
#pragma unroll
                for (int j = 0; j < 4; ++j) { const u32x2 w = *((const u32x2*)yr + T.lane + 64 * j); acc[j].x += bflo(w.x); acc[j].y += bfhi(w.x); acc[j].z += bflo(w.y); acc[j].w += bfhi(w.y); } } }
        const float* m5 = modv + (size_t)mrow * 6144 + 5 * 1024;
#pragma unroll
        for (int j = 0; j < 4; ++j) v[j] = v[j] * ALPHA_F + *((const f32x4*)m5 + T.lane + 64 * j) * acc[j];
        ln_norm(v);
#pragma unroll
        for (int j = 0; j < 4; ++j) v[j] = v[j] * *((const f32x4*)g2 + T.lane + 64 * j) + *((const f32x4*)b2 + T.lane + 64 * j);
        float* dst = (layer == 0) ? XA + (size_t)r * DMODEL : P.out + ((size_t)b * SEQL + (p - CTXL)) * DMODEL;
        store_row(dst, T.lane, v);
    }
}

#define RLX_AGENT __ATOMIC_RELAXED, __HIP_MEMORY_SCOPE_AGENT
#define XB_TMO      128
#define XB_XCNT(j)  (256  + 64 * (j))
#define XB_XSUB(j)  (1280 + 64 * (j))
#define XB_XGEN(j)  (2304 + 64 * (j))
#define XB_TOP      3328
#define XB_TOPGEN   3392
#define XCD_BAR_WORDS 3456
#define XB_SPIN_CAP (1u << 18)

__device__ __forceinline__ unsigned xb_ld(unsigned* p)              { return __hip_atomic_load(p, __ATOMIC_RELAXED, __HIP_MEMORY_SCOPE_AGENT); }
__device__ __forceinline__ unsigned xb_add(unsigned* p, unsigned v) { return __hip_atomic_fetch_add(p, v, __ATOMIC_RELAXED, __HIP_MEMORY_SCOPE_AGENT); }
__device__ __forceinline__ unsigned xb_xcc_id() { return (unsigned)__builtin_amdgcn_s_getreg((3 << 11) | 20) & 0xFu; }
#define XB_SPIN(cond, bar) do { unsigned _sp = 0; while (cond) { __builtin_amdgcn_s_sleep(1); \
    if ((++_sp & 255u) == 0u) { if (xb_ld(&(bar)[XB_TMO])) break; if (_sp > XB_SPIN_CAP) { atomicAdd(&(bar)[XB_TMO], 1u); break; } } } } while (0)

struct XcdBarrier {
    unsigned* bar; unsigned x;
    volatile LAS unsigned* st;
};

__device__ __forceinline__ XcdBarrier xcd_barrier_post(unsigned* bar, volatile LAS unsigned* st) {
    XcdBarrier b; b.bar = bar; b.x = xb_xcc_id(); b.st = st;
    if (threadIdx.x == 0) (void)xb_add(&bar[XB_XCNT(b.x)], 1u);
    return b;
}
__device__ __forceinline__ void xcd_barrier_complete(unsigned* bar, unsigned x, unsigned& nloc, unsigned& nx) {
    const unsigned G = gridDim.x * gridDim.y * gridDim.z;
    unsigned sum, cnt, mine, sp = 0u;
    for (;;) {
        sum = 0u; cnt = 0u; mine = 0u;
#pragma unroll
        for (unsigned j = 0; j < 16; ++j) { const unsigned c = xb_ld(&bar[XB_XCNT(j)]); sum += c; cnt += (c > 0u) ? 1u : 0u; mine = (j == x) ? c : mine; }
        if (sum == G) break;
        __builtin_amdgcn_s_sleep(1);
        if ((++sp & 255u) == 0u) { if (xb_ld(&bar[XB_TMO])) break; if (sp > XB_SPIN_CAP) { atomicAdd(&bar[XB_TMO], 1u); break; } }
    }
    nloc = mine > 0u ? mine : 1u; nx = cnt > 0u ? cnt : 1u;
}

__device__ __forceinline__ void xcd_barrier(const XcdBarrier& b) {
    asm volatile("s_waitcnt vmcnt(0)" ::: "memory");
    __syncthreads();
    if (threadIdx.x == 0) {
        unsigned* bar = b.bar;
        __builtin_amdgcn_s_waitcnt(0);
        unsigned nloc = b.st[0], nx = b.st[1];
        if (nloc == 0u) { xcd_barrier_complete(bar, b.x, nloc, nx); b.st[0] = nloc; b.st[1] = nx; }
        const unsigned old = xb_add(&bar[XB_XSUB(b.x)], 1u);
        const unsigned gen = old / nloc;
        if (old + 1u == (gen + 1u) * nloc) {
            __builtin_amdgcn_fence(__ATOMIC_RELEASE, "agent");
            asm volatile("s_waitcnt vmcnt(0)" ::: "memory");
            const unsigned og = xb_add(&bar[XB_TOP], 1u);
            const unsigned tg = og / nx;
            if (og + 1u == (tg + 1u) * nx) xb_add(&bar[XB_TOPGEN], 1u);
            else XB_SPIN(xb_ld(&bar[XB_TOPGEN]) == tg, bar);
            __builtin_amdgcn_fence(__ATOMIC_ACQUIRE, "agent");
            xb_add(&bar[XB_XGEN(b.x)], 1u);
            asm volatile("s_waitcnt vmcnt(0)" ::: "memory");
        } else {
            XB_SPIN(xb_ld(&bar[XB_XGEN(b.x)]) == gen, bar);
            __builtin_amdgcn_fence(__ATOMIC_ACQUIRE, "agent");
            asm volatile("s_waitcnt vmcnt(0)" ::: "memory");
        }
    }
    __syncthreads();
}


#ifndef REP_MASK
#define REP_MASK 0
#endif
#ifndef EXTRA_SYNC
#define EXTRA_SYNC 0
#endif
#define WIN ((const bf16_t*)(P.ws + WS_WIN) + (size_t)layer * NP * 1024)
#define WBR ((const bf16_t*)(P.ws + WS_WBR) + (size_t)layer * 3 * 1024 * 512)
#define WO ((const bf16_t*)(P.ws + WS_WO) + (size_t)layer * 1024 * 1024)
#define WGU ((const bf16_t*)(P.ws + WS_WGU) + (size_t)layer * NEXP * 4096 * 1024)
#define WD ((const bf16_t*)(P.ws + WS_WD) + (size_t)layer * NEXP * 1024 * 2048)
#define modv ((const float*)(P.ws + WS_MODV) + (size_t)layer * 5 * 6144)
typedef const __attribute__((address_space(4))) Params* KParams;
#define SEAM(last_) do { if (!(last_)) { XcdBarrier bar = bar0; asm volatile("" : "+s"(bar.bar)); xcd_barrier(bar); for (int xs_ = 0; xs_ < EXTRA_SYNC; ++xs_) xcd_barrier(bar); } } while (0)
template <int layer> DI void run_layer(KParams Pk, const Tctx& T0, unsigned char* lds, PG8_LAS unsigned char* ldsl, const XcdBarrier& bar0) {
    constexpr bool skipc = layer == NLAYER - 1;
    for (int rep_ = 0; rep_ <= ((REP_MASK >> 1) & 1); ++rep_) { KParams Pq = Pk; asm volatile("" : "+s"(Pq)); const Params& P = *(const Params*)Pq; const Tctx T = opaque_ctx(T0);
            p1_modulate(P, T, lds, layer);
    }
    SEAM(layer == NLAYER - 1 && 1 == 14);
    for (int rep_ = 0; rep_ <= ((REP_MASK >> 2) & 1); ++rep_) { KParams Pq = Pk; asm volatile("" : "+s"(Pq)); const Params& P = *(const Params*)Pq; const Tctx T = opaque_ctx(T0);
            pg8::SchedInProj S; S.A = (const char*)(P.ws + WS_H); S.Bt = (const char*)WIN; S.G = T.G; S.c = T.blk;
            pg8::EpiStoreBf16 E{(bf16_t*)(P.ws + WS_PROJ), NP};
            pg8::gemm_phase<pg8::EpiStoreBf16, pg8::SchedInProj, true, true>(ldsl, 1024, S, E);
    }
    SEAM(layer == NLAYER - 1 && 2 == 14);
    for (int rep_ = 0; rep_ <= ((REP_MASK >> 3) & 1); ++rep_) { KParams Pq = Pk; asm volatile("" : "+s"(Pq)); const Params& P = *(const Params*)Pq; const Tctx T = opaque_ctx(T0);
            p3_post(P, T, layer);
    }
    SEAM(layer == NLAYER - 1 && 3 == 14);
    for (int rep_ = 0; rep_ <= ((REP_MASK >> 4) & 1); ++rep_) { KParams Pq = Pk; asm volatile("" : "+s"(Pq)); const Params& P = *(const Params*)Pq; const Tctx T = opaque_ctx(T0);
            ssd_a(P, T, lds, layer);
    }
    SEAM(layer == NLAYER - 1 && 4 == 14);
    for (int rep_ = 0; rep_ <= ((REP_MASK >> 5) & 1); ++rep_) { KParams Pq = Pk; asm volatile("" : "+s"(Pq)); const Params& P = *(const Params*)Pq; const Tctx T = opaque_ctx(T0);
            ssd_b(P, T);
    }
    SEAM(layer == NLAYER - 1 && 5 == 14);
    for (int rep_ = 0; rep_ <= ((REP_MASK >> 6) & 1); ++rep_) { KParams Pq = Pk; asm volatile("" : "+s"(Pq)); const Params& P = *(const Params*)Pq; const Tctx T = opaque_ctx(T0);
            ssd_c(P, T, lds, layer);
    }
    SEAM(layer == NLAYER - 1 && 6 == 14);
    for (int rep_ = 0; rep_ <= ((REP_MASK >> 7) & 1); ++rep_) { KParams Pq = Pk; asm volatile("" : "+s"(Pq)); const Params& P = *(const Params*)Pq; const Tctx T = opaque_ctx(T0);
            ys_finalize(P, T, layer);
            const attn_body::bf16* Qf = (const attn_body::bf16*)(P.ws + WS_Q); const attn_body::bf16* Kf = (const attn_body::bf16*)(P.ws + WS_K); const attn_body::bf16* Vf = (const attn_body::bf16*)(P.ws + WS_V);
            attn_body::bf16* YA = (attn_body::bf16*)(P.ws + WS_YA);
            __syncthreads();
            const int nu = skipc ? 512 : 544;
            for (int u = T.blk; u < nu; u += T.G) {
                long q0, k0; int nt, h;
                if (u < 512) { const int b = u >> 7, qb = u & 15; h = (u >> 4) & 7; q0 = (long)b * TPB + CTXL + qb * 256; k0 = (long)b * TPB; nt = TPB / 64; }
                else { const int v = u - 512, b = v >> 3; h = v & 7; q0 = (long)b * TPB; k0 = q0; nt = CTXL / 64; }
                attn_body::attn_unit<8>(q0, k0, nt, h, h >> 2, Qf, Kf, Vf, YA, (char*)lds); }
    }
    SEAM(layer == NLAYER - 1 && 7 == 14);
    for (int rep_ = 0; rep_ <= ((REP_MASK >> 8) & 1); ++rep_) { KParams Pq = Pk; asm volatile("" : "+s"(Pq)); const Params& P = *(const Params*)Pq; const Tctx T = opaque_ctx(T0);
            pg8::SchedTok<3> S; S.A0 = (const char*)(P.ws + WS_YA); S.A1 = (const char*)(P.ws + WS_YS); S.A2 = (const char*)(P.ws + WS_YC); S.Bt = (const char*)WBR; S.KA = 512;
            S.ntile = skipc ? 256 : 272; S.skip_ctx = skipc; S.G = T.G; S.c = T.blk;
            pg8::EpiMerge E{(const bf16_t*)(P.ws + WS_PROJ), (bf16_t*)(P.ws + WS_M)};
            pg8::gemm_phase<pg8::EpiMerge, pg8::SchedTok<3>, true, true>(ldsl, 512, S, E);
    }
    SEAM(layer == NLAYER - 1 && 8 == 14);
    for (int rep_ = 0; rep_ <= ((REP_MASK >> 9) & 1); ++rep_) { KParams Pq = Pk; asm volatile("" : "+s"(Pq)); const Params& P = *(const Params*)Pq; const Tctx T = opaque_ctx(T0);
            pg8::SchedTok<1> S; S.A0 = (const char*)(P.ws + WS_M); S.A1 = S.A0; S.A2 = S.A0; S.Bt = (const char*)WO; S.KA = 1024;
            S.ntile = skipc ? 256 : 272; S.skip_ctx = skipc; S.G = T.G; S.c = T.blk;
            pg8::EpiWo E{P.x, P.ctx, (const float*)(P.ws + WS_XA), layer, modv, (float*)(P.ws + WS_X1)};
            pg8::gemm_phase<pg8::EpiWo, pg8::SchedTok<1>, true, true>(ldsl, 1024, S, E);
    }
    SEAM(layer == NLAYER - 1 && 9 == 14);
    for (int rep_ = 0; rep_ <= ((REP_MASK >> 10) & 1); ++rep_) { KParams Pq = Pk; asm volatile("" : "+s"(Pq)); const Params& P = *(const Params*)Pq; const Tctx T = opaque_ctx(T0);
            p7_ln_router(P, T, lds, layer);
    }
    SEAM(layer == NLAYER - 1 && 10 == 14);
    for (int rep_ = 0; rep_ <= ((REP_MASK >> 11) & 1); ++rep_) { KParams Pq = Pk; asm volatile("" : "+s"(Pq)); const Params& P = *(const Params*)Pq; const Tctx T = opaque_ctx(T0);
            p8_topk(P, T, lds, layer);
    }
    SEAM(layer == NLAYER - 1 && 11 == 14);
    for (int rep_ = 0; rep_ <= ((REP_MASK >> 12) & 1); ++rep_) { KParams Pq = Pk; asm volatile("" : "+s"(Pq)); const Params& P = *(const Params*)Pq; const Tctx T = opaque_ctx(T0);
            pg8::SchedExp S; S.A = (const char*)(P.ws + WS_XS); S.Bt = (const char*)WGU; S.KA = 1024; S.NMT = skipc ? 8 : 9; S.NPN = 16; S.OCW = 128; S.G = T.G; S.c = T.blk;
            pg8::EpiGU E{(bf16_t*)(P.ws + WS_HID)};
            pg8::gemm_phase<pg8::EpiGU, pg8::SchedExp, true, true>(ldsl, 1024, S, E);
    }
    SEAM(layer == NLAYER - 1 && 12 == 14);
    for (int rep_ = 0; rep_ <= ((REP_MASK >> 13) & 1); ++rep_) { KParams Pq = Pk; asm volatile("" : "+s"(Pq)); const Params& P = *(const Params*)Pq; const Tctx T = opaque_ctx(T0);
            pg8::SchedExp S; S.A = (const char*)(P.ws + WS_HID); S.Bt = (const char*)WD; S.KA = 2048; S.NMT = skipc ? 8 : 9; S.NPN = 4; S.OCW = 256; S.G = T.G; S.c = T.blk;
            pg8::EpiDown E{(bf16_t*)(P.ws + WS_XS), (const float*)(P.ws + WS_AFFSEL)};
            pg8::gemm_phase<pg8::EpiDown, pg8::SchedExp, true, true>(ldsl, 2048, S, E);
    }
    SEAM(layer == NLAYER - 1 && 13 == 14);
    for (int rep_ = 0; rep_ <= ((REP_MASK >> 14) & 1); ++rep_) { KParams Pq = Pk; asm volatile("" : "+s"(Pq)); const Params& P = *(const Params*)Pq; const Tctx T = opaque_ctx(T0);
            p11_combine(P, T, layer);
    }
    SEAM(layer == NLAYER - 1 && 14 == 14);
}

__global__ void __launch_bounds__(512, 2) fwd_mega(Params P_unused_) {
    const __attribute__((address_space(4))) Params* Pk = (const __attribute__((address_space(4))) Params*)__builtin_amdgcn_kernarg_segment_ptr();
    const Params& P = *(const Params*)Pk;
    extern __shared__ __attribute__((aligned(16))) unsigned char lds[];
    cg::grid_group grid = cg::this_grid();
    Tctx T0; { Tctx& T = T0; T.tid = threadIdx.x; T.lane = T.tid & 63; T.wave = __builtin_amdgcn_readfirstlane(T.tid >> 6); T.G = gridDim.x; T.blk = blockIdx.x; T.gw = T.blk * 8 + T.wave; T.NGW = T.G * 8; }
    const Tctx& T = T0;
    PG8_LAS unsigned char* ldsl = (PG8_LAS unsigned char*)lds;
    volatile LAS unsigned* MISC = (volatile LAS unsigned*)(ldsl + (LDS_BYTES - 256));
    if (T.tid < 64) MISC[T.tid] = 0u;
    unsigned* barw = (unsigned*)(P.ws + WS_BAR);
    if (T.blk == 0) for (int i = T.tid; i < XCD_BAR_WORDS; i += 512) barw[i] = 0u;
    __syncthreads();
    if (T.blk < 192) p0_modv(P, T, lds, T.blk);
    if (T.blk == T.G - 1) p0_rope(P, T);
    p0_convert(P, T, lds);
    grid.sync();
    const XcdBarrier bar0 = xcd_barrier_post(barw, MISC + 8);
    run_layer<0>(Pk, T0, lds, ldsl, bar0);
    run_layer<1>(Pk, T0, lds, ldsl, bar0);
}

constexpr int N_PHASES = 1 + NLAYER * 14;

extern "C" void kernel_launch(void* const* d_in, const int* in_sizes, int n_in, void* d_out, int out_size, void* d_ws, size_t ws_size, hipStream_t stream) {
    static int grid = 0;
    if (grid == 0) {
        if (n_in != 28 || ws_size < WS_END) { fprintf(stderr, "kernel_launch: unexpected n_in %d / ws %zu (need %zu)\n", n_in, ws_size, (size_t)WS_END); grid = -1; return; }
        int dev = 0, cus = 0, per_cu = 0;
        (void)hipGetDevice(&dev); (void)hipDeviceGetAttribute(&cus, hipDeviceAttributeMultiprocessorCount, dev);
        (void)hipFuncSetAttribute((const void*)fwd_mega, hipFuncAttributeMaxDynamicSharedMemorySize, LDS_BYTES);
        (void)hipOccupancyMaxActiveBlocksPerMultiprocessor(&per_cu, (const void*)fwd_mega, 512, LDS_BYTES);
        if (per_cu < 1) { fprintf(stderr, "kernel_launch: occupancy query says %d blocks/CU\n", per_cu); per_cu = 1; }
        grid = cus * per_cu;
    }
    if (grid < 0) return;
    Params p{};
    const float** f = (const float**)&p;
    for (int i = 0; i < 28; ++i) f[i] = (const float*)d_in[i];
    p.out = (float*)d_out; p.ws = (unsigned char*)d_ws;
    p.ph_lo = 0; p.ph_hi = 0;
    void* args[] = {&p};
    hipError_t e = hipLaunchCooperativeKernel((const void*)fwd_mega, dim3(grid), dim3(512), args, LDS_BYTES, stream);
    if (e != hipSuccess) fprintf(stderr, "cooperative launch failed: %s (grid %d)\n", hipGetErrorString(e), grid);
}
```

```cpp
#include <hip/hip_runtime.h>
#include <hip/hip_bf16.h>
#include <hip/hip_cooperative_groups.h>
#include <cstdio>
#include <cstdint>
namespace cg = cooperative_groups;

#define DI __device__ __forceinline__
#define LAS __attribute__((address_space(3)))
typedef unsigned short bf16_t;
typedef short bf16x8 __attribute__((ext_vector_type(8)));
typedef float f32x4 __attribute__((ext_vector_type(4)));
typedef float f32x2 __attribute__((ext_vector_type(2)));
typedef float f32x16 __attribute__((ext_vector_type(16)));
typedef unsigned u32x4 __attribute__((ext_vector_type(4)));
typedef unsigned u32x2 __attribute__((ext_vector_type(2)));

constexpr int DMODEL = 1024, NBATCH = 4, SEQL = 4096, CTXL = 256, TPB = SEQL + CTXL  , MR = NBATCH * TPB  ;
constexpr int NLAYER = 2, IN_COLS = 6672, NP = 6656;
constexpr int PK = 0, PV = 128, PXBC = 256, PQ = 1024, PZ = 1536, PSCB = 2048, PSCC = 2560, PSCX = 3072, PG = 3584;
constexpr int NEXP = 16, FF = 2048, ESTR = 2304  , NCH = 34  ;
constexpr float EPSF = 1e-6f;
constexpr float ALPHA_F = 1.4142135623730951f;
constexpr float QSCALE = 0.125f * 1.4426950408889634f;

constexpr size_t al256(size_t x) { return (x + 255) & ~(size_t)255; }
constexpr size_t WS_WIN = 0;
constexpr size_t WS_WBR = WS_WIN + al256((size_t)NLAYER * NP * 1024 * 2);
constexpr size_t WS_WO = WS_WBR + al256((size_t)NLAYER * 3 * 1024 * 512 * 2);
constexpr size_t WS_WGU = WS_WO + al256((size_t)NLAYER * 1024 * 1024 * 2);
constexpr size_t WS_WD = WS_WGU + al256((size_t)NLAYER * NEXP * 4096 * 1024 * 2);
constexpr size_t WS_XA = WS_WD + al256((size_t)NLAYER * NEXP * 1024 * 2048 * 2);
constexpr size_t WS_X1 = WS_XA + al256((size_t)MR * 1024 * 4);
constexpr size_t WS_H = WS_X1 + al256((size_t)MR * 1024 * 4);
constexpr size_t WS_PROJ = WS_H + al256((size_t)MR * 1024 * 2);
constexpr size_t WS_XS = WS_PROJ;
constexpr size_t WS_HID = WS_PROJ + al256((size_t)NEXP * ESTR * 1024 * 2);
constexpr size_t WS_Q = WS_PROJ + al256((size_t)MR * NP * 2);
constexpr size_t WS_K = WS_Q + al256((size_t)MR * 512 * 2);
constexpr size_t WS_V = WS_K + al256((size_t)MR * 128 * 2);
constexpr size_t WS_XBC = WS_V + al256((size_t)MR * 128 * 2);
constexpr size_t WS_YC = WS_XBC + al256((size_t)MR * 768 * 2);
constexpr size_t WS_YA = WS_YC + al256((size_t)MR * 512 * 2);
constexpr size_t WS_YS = WS_YA + al256((size_t)MR * 512 * 2);
constexpr size_t WS_YRAW = WS_YS + al256((size_t)MR * 512 * 2);
constexpr size_t WS_M = WS_YRAW + al256((size_t)MR * 512 * 2);
constexpr size_t WS_ST = WS_M + al256((size_t)MR * 1024 * 2);
constexpr size_t WS_DT = WS_ST + al256((size_t)2 * NBATCH * NCH * 8 * 4096 * 4);
constexpr size_t WS_ACS = WS_DT + al256((size_t)MR * 16 * 4);
constexpr size_t WS_AFF = WS_ACS + al256((size_t)MR * 16 * 4);
constexpr size_t WS_SLOT = WS_AFF + al256((size_t)MR * 16 * 4);
constexpr size_t WS_AFFSEL = WS_SLOT + al256((size_t)MR * 16 * 4);
constexpr size_t WS_MODV = WS_AFFSEL + al256((size_t)NEXP * ESTR * 4);
constexpr size_t WS_ROPE = WS_MODV + al256((size_t)NLAYER * 5 * 6144 * 4);
constexpr size_t WS_BAR = WS_ROPE + al256((size_t)64 * 16 * 2 * 4);
constexpr size_t WS_IDX = WS_BAR + 16384;
constexpr size_t WS_SSQ = WS_IDX + al256((size_t)NEXP * ESTR * 4);
constexpr size_t WS_END = WS_SSQ + al256((size_t)MR * 4);
static_assert(WS_HID + (size_t)NEXP * ESTR * 2048 * 2 <= WS_Q, "MoE overlays fit inside PROJ");
static_assert(WS_END <= (size_t)1073741824, "workspace fits 1 GiB");

constexpr int LDS_BYTES = 147456;
constexpr int RING_BYTES = 131072;

struct Params {
    const float *x, *c, *ctx, *c_ctx, *w_mod, *b_mod, *w_in, *q_norm, *k_norm, *ssd_conv_w, *ssd_conv_b, *ssd_a_log, *ssd_dt_bias, *ssd_d, *ssd_norm, *sc_conv_w,
        *w_br_attn, *w_br_ssd, *w_br_conv, *w_o, *ln1_g, *ln1_b, *w_router, *w_exp_gate, *w_exp_up, *w_exp_down, *ln2_g, *ln2_b;
    float* out; unsigned char* ws; int ph_lo, ph_hi;
};

template <int CTRL> DI float dppf(float v) { return __int_as_float(__builtin_amdgcn_update_dpp(0, __float_as_int(v), CTRL, 0xF, 0xF, true)); }
DI float swap16_add(float a, float b) { auto r = __builtin_amdgcn_permlane16_swap(__float_as_uint(a), __float_as_uint(b), false, false); return __uint_as_float(r[0]) + __uint_as_float(r[1]); }
DI float swap32_add(float a, float b) { auto r = __builtin_amdgcn_permlane32_swap(__float_as_uint(a), __float_as_uint(b), false, false); return __uint_as_float(r[0]) + __uint_as_float(r[1]); }
DI float wave_sum(float v) {
    v += dppf<0xB1>(v); v += dppf<0x4E>(v); v += dppf<0x141>(v); v += dppf<0x140>(v);
    v = swap16_add(v, v); v = swap32_add(v, v); return v;
}
DI float wave_max(float v) {
    v = fmaxf(v, dppf<0xB1>(v)); v = fmaxf(v, dppf<0x4E>(v)); v = fmaxf(v, dppf<0x141>(v)); v = fmaxf(v, dppf<0x140>(v));
    { auto r = __builtin_amdgcn_permlane16_swap(__float_as_uint(v), __float_as_uint(v), false, false); v = fmaxf(__uint_as_float(r[0]), __uint_as_float(r[1])); }
    { auto r = __builtin_amdgcn_permlane32_swap(__float_as_uint(v), __float_as_uint(v), false, false); v = fmaxf(__uint_as_float(r[0]), __uint_as_float(r[1])); }
    return v;
}
DI int wave_sum_i(int v) {
#pragma unroll
    for (int o = 1; o < 64; o <<= 1) v += __shfl_xor(v, o);
    return v;
}
DI float reduce16(const float (&s)[16], int lane) {
    float t[8], u[4], w[2];
#pragma unroll
    for (int q = 0; q < 8; ++q) t[q] = swap32_add(s[q], s[q + 8]);
#pragma unroll
    for (int q = 0; q < 4; ++q) u[q] = swap16_add(t[q], t[q + 4]);
    const bool b3 = (lane & 8) != 0, b2 = (lane & 4) != 0;
#pragma unroll
    for (int q = 0; q < 2; ++q) { const float send = b3 ? u[q] : u[q + 2], keep = b3 ? u[q + 2] : u[q]; w[q] = keep + dppf<0x128>(send); }
    float v; { const float send = b2 ? w[0] : w[1], keep = b2 ? w[1] : w[0]; v = keep + __shfl_xor(send, 4); }
    v += dppf<0xB1>(v); v += dppf<0x4E>(v); return v;
}
DI int lane_j16(int lane) { return ((lane >> 5) & 1) * 8 + ((lane >> 4) & 1) * 4 + ((lane >> 3) & 1) * 2 + ((lane >> 2) & 1); }
typedef __bf16 bf16x2_t __attribute__((ext_vector_type(2)));
DI unsigned pk2(float lo, float hi) { f32x2 v = {lo, hi}; bf16x2_t b = __builtin_convertvector(v, bf16x2_t); return __builtin_bit_cast(unsigned, b); }
DI float bflo(unsigned w) { return __uint_as_float(w << 16); }
DI float bfhi(unsigned w) { return __uint_as_float(w & 0xffff0000u); }
DI void unpack8(const u32x4 v, float (&f)[8]) { f[0] = bflo(v.x); f[1] = bfhi(v.x); f[2] = bflo(v.y); f[3] = bfhi(v.y); f[4] = bflo(v.z); f[5] = bfhi(v.z); f[6] = bflo(v.w); f[7] = bfhi(v.w); }
DI u32x4 pack8(const float (&f)[8]) { u32x4 o; o.x = pk2(f[0], f[1]); o.y = pk2(f[2], f[3]); o.z = pk2(f[4], f[5]); o.w = pk2(f[6], f[7]); return o; }
DI float sigmoidf_(float x) { return __builtin_amdgcn_rcpf(1.f + __expf(-x)); }
DI float siluf_(float x) { return x * __builtin_amdgcn_rcpf(1.f + __expf(-x)); }
DI int crow(int r, int hi) { return (r & 3) + 8 * (r >> 2) + 4 * hi; }
DI void row_bp(int r, int& b, int& p) { b = r / TPB; p = r - b * TPB; }
DI const float* xsrc_row(const Params& P, int layer, int r) {
    if (layer == 0) { int b, p; row_bp(r, b, p); return p < CTXL ? P.ctx + ((size_t)b * CTXL + p) * DMODEL : P.x + ((size_t)b * SEQL + (p - CTXL)) * DMODEL; }
    return (const float*)(P.ws + WS_XA) + (size_t)r * DMODEL;
}

namespace pg8 {
#define PG8_LAS __attribute__((address_space(3)))
constexpr int BM = 256, BK = 64, HALF = 128, HTB = HALF * BK * 2, STAGE_BYTES = 8 * HTB;
DI int lds_byte(int r, int c) { const int st = (r >> 4) * 2 + (c >> 5), rr = r & 15, cc = c & 31, ob = rr * 64 + cc * 2; return st * 1024 + (ob ^ (((ob >> 9) & 1) << 5)); }
DI void stage_rc(int b, int& R, int& C) { const int st = b / 1024, sb = b % 1024, swz = sb ^ (((sb >> 9) & 1) << 5); R = (st >> 1) * 16 + swz / 64; C = (st & 1) * 32 + (swz % 64) / 2; }
DI int perm32(int rho) { const int n = rho >> 4, i = rho & 15; return 8 * (i >> 2) + 4 * n + (i & 3); }
struct Unit { const char* a; const char* b; int orow, ocol, aux, keep, nt; };
DI unsigned cvt_pk_bf16(float lo, float hi) { return pk2(lo, hi); }
template <class Epi, class Sched, bool ALIGN_EPI = false, bool SP2 = false, bool GATHER = false>
__device__ __forceinline__ void gemm_phase(PG8_LAS unsigned char* lds, const int K_, const Sched& S, const Epi& E, const int* gidx = nullptr) {
    int tid = threadIdx.x; asm volatile("" : "+v"(tid)); const int wid = __builtin_amdgcn_readfirstlane(tid >> 6), lane = tid & 63, wr = wid >> 2, wc = wid & 3, fr = lane & 15, fq = lane >> 4;
    const int K = K_, nt = K / BK;
    unsigned voffA[2], voffB[2]; unsigned gA0[2] = {0u, 0u}, gA1[2] = {0u, 0u}, nA0[2] = {0u, 0u}, nA1[2] = {0u, 0u}; int gR[2], gC[2];
#pragma unroll
    for (int i = 0; i < 2; ++i) { int R, C; stage_rc(tid * 16 + i * 8192, R, C); gR[i] = R; gC[i] = C; const int Rb = Epi::PERM ? ((R & ~31) + perm32(R & 31)) : R;
        voffA[i] = (unsigned)(R * K + C) * 2u; voffB[i] = (unsigned)(Rb * K + C) * 2u; }
    const size_t kstep = (size_t)(BK * 2);
    const size_t hstep = (size_t)HALF * K * 2;
    const unsigned ldsw = (unsigned)wid * 1024u;
    const int aoff = lds_byte(wr * 64 + fr, fq * 8), boff = lds_byte(wc * 32 + fr, fq * 8);
#define PG8_SA(b, h) (((b) * 2 + (h)) * HTB)
#define PG8_SB(b, h) ((4 + (b) * 2 + (h)) * HTB)
#define PG8_STAGE(bufoff, gbase, voff) do { _Pragma("unroll") for (int _i = 0; _i < 2; ++_i) \
        __builtin_amdgcn_global_load_lds((const unsigned*)((const char*)(gbase) + (voff)[_i]), (PG8_LAS unsigned*)(lds + (bufoff) + ldsw + _i * 8192), 16, 0, 0); } while (0)
#define PG8_GLOAD(d0, d1, U) do { _Pragma("unroll") for (int _i = 0; _i < 2; ++_i) { d0[_i] = (unsigned)(gidx[(U).orow + gR[_i]] * K + gC[_i]) * 2u; d1[_i] = (unsigned)(gidx[(U).orow + 128 + gR[_i]] * K + gC[_i]) * 2u; } } while (0)
#define PG8_STAGEA(b, h, ptr, nx) do { if constexpr (GATHER) { _Pragma("unroll") for (int _i = 0; _i < 2; ++_i) { const unsigned _o = (nx) ? ((h) ? nA1[_i] : nA0[_i]) : ((h) ? gA1[_i] : gA0[_i]); \
        __builtin_amdgcn_global_load_lds((const unsigned*)((const char*)(ptr) + _o), (PG8_LAS unsigned*)(lds + PG8_SA(b, h) + ldsw + _i * 8192), 16, 0, 0); } } \
    else { PG8_STAGE(PG8_SA(b, h), (ptr) + ((h) ? hstep : 0), voffA); } } while (0)
#define PG8_LDA(dst, b, h) do { _Pragma("unroll") for (int m = 0; m < 4; ++m) _Pragma("unroll") for (int k = 0; k < 2; ++k) dst[m][k] = *(const PG8_LAS bf16x8*)(lds + PG8_SA(b, h) + aoff + m * 2048 + k * 1024); } while (0)
#define PG8_LDB(dst, b, h) do { _Pragma("unroll") for (int n = 0; n < 2; ++n) _Pragma("unroll") for (int k = 0; k < 2; ++k) dst[n][k] = *(const PG8_LAS bf16x8*)(lds + PG8_SB(b, h) + boff + n * 2048 + k * 1024); } while (0)
#define PG8_MMA(ai, bj, At, Bt) do { __builtin_amdgcn_s_setprio(1); _Pragma("unroll") for (int m = 0; m < 4; ++m) _Pragma("unroll") for (int n = 0; n < 2; ++n) _Pragma("unroll") for (int k = 0; k < 2; ++k) \
        acc[ai][bj][m][n] = __builtin_amdgcn_mfma_f32_16x16x32_bf16(Bt[n][k], At[m][k], acc[ai][bj][m][n], 0, 0, 0); __builtin_amdgcn_s_setprio(0); } while (0)
#define PG8_WAIT_V(n) asm volatile("s_waitcnt vmcnt(" #n ")" ::: "memory")
#define PG8_WAIT_L(n) asm volatile("s_waitcnt lgkmcnt(" #n ")" ::: "memory")
#define PG8_BAR __builtin_amdgcn_s_barrier()
#define PG8_SCHED __builtin_amdgcn_sched_barrier(0)
    Unit cur, nxt; int ui = 0;
    if (!S.next(0, cur)) return;
    f32x4 acc[2][2][4][2];
#pragma unroll
    for (int a = 0; a < 2; ++a)
#pragma unroll
        for (int b = 0; b < 2; ++b)
#pragma unroll
            for (int m = 0; m < 4; ++m)
#pragma unroll
                for (int n = 0; n < 2; ++n) acc[a][b][m][n] = (f32x4){0.f, 0.f, 0.f, 0.f};
    bf16x8 At[4][2], B0[2][2], B1[2][2];
    const char* cA = cur.a; const char* cB = cur.b;
    if constexpr (GATHER) { PG8_GLOAD(gA0, gA1, cur); }
    S.a_ready(cur);
    if constexpr (SP2) {
        PG8_STAGE(PG8_SB(0, 0), cB, voffB); PG8_STAGE(PG8_SB(0, 1), cB + hstep, voffB); PG8_STAGEA(0, 0, cA, false); PG8_STAGEA(0, 1, cA, false);
        if (wr == 1) PG8_BAR;
        PG8_WAIT_V(2); PG8_BAR;
        PG8_STAGE(PG8_SB(1, 0), cB + kstep, voffB); PG8_STAGEA(1, 0, cA + kstep, false); PG8_STAGE(PG8_SB(1, 1), cB + hstep + kstep, voffB);
        PG8_WAIT_V(6); PG8_BAR;
    } else {
        PG8_STAGE(PG8_SB(0, 0), cB, voffB); PG8_STAGEA(0, 0, cA, false); PG8_STAGE(PG8_SB(0, 1), cB + hstep, voffB); PG8_STAGEA(0, 1, cA, false);
        if (wr == 1) PG8_BAR;
        PG8_WAIT_V(4); PG8_BAR;
        PG8_STAGE(PG8_SB(1, 0), cB + kstep, voffB); PG8_STAGEA(1, 0, cA + kstep, false); PG8_STAGE(PG8_SB(1, 1), cB + hstep + kstep, voffB);
        PG8_WAIT_V(6); PG8_BAR;
    }
    for (;;) {
        const bool has_next = S.next(ui + 1, nxt);
        if constexpr (GATHER) { if (has_next) { PG8_GLOAD(nA0, nA1, nxt); } else { nA0[0] = gA0[0]; nA0[1] = gA0[1]; nA1[0] = gA1[0]; nA1[1] = gA1[1]; } }
        const char* nA = has_next ? nxt.a : cA; const char* nB = has_next ? nxt.b : cB;
        const int ntu = cur.nt ? cur.nt : nt;
        for (int t = 0; t < ntu; t += 2) {
            const bool last = (t == ntu - 2);
            const char* a1 = cA + (size_t)(t + 1) * kstep;
            const char* a2 = last ? nA : cA + (size_t)(t + 2) * kstep; const char* b2 = last ? nB : cB + (size_t)(t + 2) * kstep;
            const char* a3 = a2 + kstep; const char* b3 = b2 + kstep;
            if (last && has_next) S.a_ready(nxt);
            if constexpr (SP2) {
            PG8_LDB(B0, 0, 0); PG8_LDB(B1, 0, 1); PG8_SCHED; PG8_LDA(At, 0, 0); PG8_STAGEA(1, 1, a1, false);
            PG8_WAIT_V(8); PG8_WAIT_L(0); PG8_BAR; PG8_MMA(0, 0, At, B0); PG8_MMA(0, 1, At, B1); PG8_BAR; PG8_SCHED;
            PG8_LDA(At, 0, 1); PG8_STAGE(PG8_SB(0, 0), b2, voffB); PG8_STAGE(PG8_SB(0, 1), b2 + hstep, voffB); PG8_STAGEA(0, 0, a2, last);
            PG8_WAIT_V(8); PG8_WAIT_L(0); PG8_BAR; PG8_MMA(1, 0, At, B0); PG8_MMA(1, 1, At, B1); PG8_BAR; PG8_SCHED;
            PG8_LDB(B0, 1, 0); PG8_LDB(B1, 1, 1); PG8_SCHED; PG8_LDA(At, 1, 0); PG8_STAGEA(0, 1, a2, last);
            PG8_WAIT_V(8); PG8_WAIT_L(0); PG8_BAR; PG8_MMA(0, 0, At, B0); PG8_MMA(0, 1, At, B1); PG8_BAR; PG8_SCHED;
            PG8_LDA(At, 1, 1); PG8_STAGE(PG8_SB(1, 0), b3, voffB); PG8_STAGE(PG8_SB(1, 1), b3 + hstep, voffB); PG8_STAGEA(1, 0, a3, last);
            PG8_WAIT_V(8); PG8_WAIT_L(0); PG8_BAR; PG8_MMA(1, 0, At, B0); PG8_MMA(1, 1, At, B1); PG8_BAR; PG8_SCHED;
            } else {
            PG8_LDB(B0, 0, 0); PG8_SCHED; PG8_LDA(At, 0, 0); PG8_STAGEA(1, 1, a1, false);
            PG8_WAIT_L(8); PG8_BAR; PG8_WAIT_L(0); PG8_MMA(0, 0, At, B0); PG8_BAR; PG8_SCHED;
            PG8_LDB(B1, 0, 1); PG8_STAGE(PG8_SB(0, 0), b2, voffB);
            PG8_BAR; PG8_WAIT_L(0); PG8_MMA(0, 1, At, B1); PG8_BAR;
            PG8_LDA(At, 0, 1); PG8_STAGEA(0, 0, a2, last);
            PG8_BAR; PG8_WAIT_L(0); PG8_MMA(1, 0, At, B0); PG8_BAR; PG8_SCHED;
            PG8_STAGE(PG8_SB(0, 1), b2 + hstep, voffB);
            PG8_WAIT_V(6); PG8_BAR; PG8_MMA(1, 1, At, B1); PG8_BAR;
            PG8_LDB(B0, 1, 0); PG8_SCHED; PG8_LDA(At, 1, 0); PG8_STAGEA(0, 1, a2, last);
            PG8_WAIT_L(8); PG8_BAR; PG8_WAIT_L(0); PG8_MMA(0, 0, At, B0); PG8_BAR; PG8_SCHED;
            PG8_LDB(B1, 1, 1); PG8_STAGE(PG8_SB(1, 0), b3, voffB);
            PG8_BAR; PG8_WAIT_L(0); PG8_MMA(0, 1, At, B1); PG8_BAR;
            PG8_LDA(At, 1, 1); PG8_STAGEA(1, 0, a3, last);
            PG8_BAR; PG8_WAIT_L(0); PG8_MMA(1, 0, At, B0); PG8_BAR; PG8_SCHED;
            PG8_STAGE(PG8_SB(1, 1), b3 + hstep, voffB);
            PG8_WAIT_V(6); PG8_BAR; PG8_MMA(1, 1, At, B1); PG8_BAR;
            }
        }
        if constexpr (ALIGN_EPI) { if (wr == 0) PG8_BAR; }
        if constexpr (!Epi::AFTER_DRAIN) { E(acc, cur, wr, wc, fr, fq); S.done(cur); }
        if (!has_next) break;
        if (!cur.keep) {
#pragma unroll
        for (int a = 0; a < 2; ++a)
#pragma unroll
            for (int b = 0; b < 2; ++b)
#pragma unroll
                for (int m = 0; m < 4; ++m)
#pragma unroll
                    for (int n = 0; n < 2; ++n) acc[a][b][m][n] = (f32x4){0.f, 0.f, 0.f, 0.f};
        }
        cur = nxt; cA = nA; cB = nB; ++ui;
        if constexpr (GATHER) { gA0[0] = nA0[0]; gA0[1] = nA0[1]; gA1[0] = nA1[0]; gA1[1] = nA1[1]; }
        if constexpr (ALIGN_EPI) { if (wr == 1) PG8_BAR; }
    }
    PG8_WAIT_V(0);
    if constexpr (!ALIGN_EPI) { if (wr == 0) PG8_BAR; }
    PG8_BAR;
    if constexpr (Epi::AFTER_DRAIN) { E.fused(acc, cur, wr, wc, fr, fq, lds, wid, lane); S.done(cur); }
#undef PG8_SA
#undef PG8_SB
#undef PG8_STAGE
#undef PG8_LDA
#undef PG8_GLOAD
#undef PG8_STAGEA
#undef PG8_LDB
#undef PG8_MMA
#undef PG8_WAIT_V
#undef PG8_WAIT_L
#undef PG8_BAR
#undef PG8_SCHED
}


typedef f32x4 AccT[2][2][4][2];
struct EpiStoreBf16 {
    static constexpr bool PERM = true, AFTER_DRAIN = false;
    bf16_t* O; int ldc;
    DI void operator()(AccT& acc, const Unit& u, int wr, int wc, int fr, int fq) const {
        const int row0 = u.orow + wr * 64 + fr, col0 = u.ocol + wc * 32 + 8 * fq;
#pragma unroll
        for (int ai = 0; ai < 2; ++ai)
#pragma unroll
            for (int m = 0; m < 4; ++m) { bf16_t* rowp = O + (size_t)(row0 + ai * HALF + m * 16) * ldc + col0;
#pragma unroll
                for (int bj = 0; bj < 2; ++bj) { const f32x4 v0 = acc[ai][bj][m][0], v1 = acc[ai][bj][m][1];
                    u32x4 w; w.x = pk2(v0[0], v0[1]); w.y = pk2(v0[2], v0[3]); w.z = pk2(v1[0], v1[1]); w.w = pk2(v1[2], v1[3]);
                    *(u32x4*)(rowp + bj * HALF) = w; } }
    }
};
struct EpiMerge {
    static constexpr bool PERM = true, AFTER_DRAIN = false;
    const bf16_t* PROJ; bf16_t* Mo; const float* ssq; bf16_t* pb;
    DI void operator()(AccT& acc, const Unit& u, int wr, int wc, int fr, int fq) const {
        const int rl0 = wr * 64 + fr, cl0 = wc * 32 + 8 * fq; const int j = u.aux;
        bf16_t* pbl = pb + rl0 * 256 + cl0; asm volatile("" : "+v"(pbl));
        if (j < 2) {
#pragma unroll
            for (int ai = 0; ai < 2; ++ai)
#pragma unroll
                for (int m = 0; m < 4; ++m) { bf16_t* rowp = pbl + (size_t)j * 65536 + (ai * HALF + m * 16) * 256;
#pragma unroll
                    for (int bj = 0; bj < 2; ++bj) { const f32x4 v0 = acc[ai][bj][m][0], v1 = acc[ai][bj][m][1];
                        u32x4 w; w.x = pk2(v0[0], v0[1]); w.y = pk2(v0[2], v0[3]); w.z = pk2(v1[0], v1[1]); w.w = pk2(v1[2], v1[3]);
                        *(u32x4*)(rowp + bj * HALF) = w; } }
            return;
        }
#pragma unroll
        for (int ai = 0; ai < 2; ++ai)
#pragma unroll
            for (int m = 0; m < 4; ++m) { const int rl = rl0 + ai * HALF + m * 16; const size_t row = (size_t)(u.orow + rl);
                const float rs = rsqrtf(ssq[row] * (1.f / 512.f) + EPSF);
#pragma unroll
                for (int bj = 0; bj < 2; ++bj) { const bf16_t* gp = PROJ + row * NP + PG + u.ocol + cl0 + bj * HALF; const bf16_t* pp = pbl + (ai * HALF + m * 16) * 256 + bj * HALF;
                    const u32x4 g0 = *(const u32x4*)gp, g1 = *(const u32x4*)(gp + 1024), g2 = *(const u32x4*)(gp + 2048), p0 = *(const u32x4*)pp, p1 = *(const u32x4*)(pp + 65536);
                    const f32x4 v0 = acc[ai][bj][m][0], v1 = acc[ai][bj][m][1]; u32x4 w;
#define MRG2(gw0, gw1, gw2, pw0, pw1, xlo, xhi) pk2(sigmoidf_(bflo(gw0)) * bflo(pw0) + rs * sigmoidf_(bflo(gw1)) * bflo(pw1) + sigmoidf_(bflo(gw2)) * (xlo), \
                                                     sigmoidf_(bfhi(gw0)) * bfhi(pw0) + rs * sigmoidf_(bfhi(gw1)) * bfhi(pw1) + sigmoidf_(bfhi(gw2)) * (xhi))
                    w.x = MRG2(g0.x, g1.x, g2.x, p0.x, p1.x, v0[0], v0[1]); w.y = MRG2(g0.y, g1.y, g2.y, p0.y, p1.y, v0[2], v0[3]);
                    w.z = MRG2(g0.z, g1.z, g2.z, p0.z, p1.z, v1[0], v1[1]); w.w = MRG2(g0.w, g1.w, g2.w, p0.w, p1.w, v1[2], v1[3]);
#undef MRG2
                    *(u32x4*)(Mo + row * 1024 + u.ocol + cl0 + bj * HALF) = w;
                    if (bj == 1 && (m & 1)) asm volatile("" ::: "memory"); } }
    }
};
struct EpiWo {
    static constexpr bool PERM = false, AFTER_DRAIN = false;
    const float* x_in; const float* ctx_in; const float* XA; int layer; const float* modv  ; float* X1;
    DI void operator()(AccT& acc, const Unit& u, int wr, int wc, int fr, int fq) const {
        const int b = u.orow / TPB, p = u.orow - b * TPB;
        const float* xb; int mrow;
        if (p < CTXL) mrow = 4; else mrow = b;
        if (layer == 0) xb = (p < CTXL) ? ctx_in + (size_t)b * CTXL * DMODEL : x_in + ((size_t)b * SEQL + (p - CTXL)) * DMODEL;
        else xb = XA + (size_t)u.orow * DMODEL;
        const int rl0 = wr * 64 + fr, col0 = u.ocol + wc * 32 + 4 * fq;
        const float* m2 = modv + (size_t)mrow * 6144 + 2 * 1024;
        f32x4 mv[2][2];
#pragma unroll
        for (int bj = 0; bj < 2; ++bj)
#pragma unroll
            for (int n = 0; n < 2; ++n) mv[bj][n] = *(const f32x4*)(m2 + col0 + bj * HALF + n * 16);
#pragma unroll
        for (int ai = 0; ai < 2; ++ai) {
            f32x4 xv[4][2][2];
#pragma unroll
            for (int m = 0; m < 4; ++m) { const int rl = rl0 + ai * HALF + m * 16; const float* xr = xb + (size_t)rl * DMODEL + col0;
#pragma unroll
                for (int bj = 0; bj < 2; ++bj)
#pragma unroll
                    for (int n = 0; n < 2; ++n) xv[m][bj][n] = *(const f32x4*)(xr + bj * HALF + n * 16); }
#pragma unroll
            for (int m = 0; m < 4; ++m) { const int rl = rl0 + ai * HALF + m * 16; float* orow = X1 + (size_t)(u.orow + rl) * DMODEL + col0;
#pragma unroll
                for (int bj = 0; bj < 2; ++bj)
#pragma unroll
                    for (int n = 0; n < 2; ++n) *(f32x4*)(orow + bj * HALF + n * 16) = xv[m][bj][n] * ALPHA_F + mv[bj][n] * acc[ai][bj][m][n]; } }
    }
};
struct EpiGU {
    static constexpr bool PERM = true, AFTER_DRAIN = false;
    bf16_t* HID;
    DI void operator()(AccT& acc, const Unit& u, int wr, int wc, int fr, int fq) const {
        const int row0 = u.orow + wr * 64 + fr, col0 = u.ocol + wc * 32 + 8 * fq;
#pragma unroll
        for (int ai = 0; ai < 2; ++ai)
#pragma unroll
            for (int m = 0; m < 4; ++m) { bf16_t* rowp = HID + (size_t)(row0 + ai * HALF + m * 16) * FF + col0;
                const f32x4 g0 = acc[ai][0][m][0], g1 = acc[ai][0][m][1], u0 = acc[ai][1][m][0], u1 = acc[ai][1][m][1];
                u32x4 w; w.x = pk2(siluf_(g0[0]) * u0[0], siluf_(g0[1]) * u0[1]); w.y = pk2(siluf_(g0[2]) * u0[2], siluf_(g0[3]) * u0[3]);
                w.z = pk2(siluf_(g1[0]) * u1[0], siluf_(g1[1]) * u1[1]); w.w = pk2(siluf_(g1[2]) * u1[2], siluf_(g1[3]) * u1[3]);
                *(u32x4*)rowp = w; }
    }
};
struct EpiDown {
    static constexpr bool PERM = true, AFTER_DRAIN = false;
    bf16_t* Y; const float* affsel; bf16_t* YP;
    DI void operator()(AccT& acc, const Unit& u, int wr, int wc, int fr, int fq) const {
        const int row0 = u.orow + wr * 64 + fr, col0 = u.ocol + wc * 32 + 8 * fq; const int ks = u.aux >> 8, e = u.aux & 255;
        float sv[2][4];
#pragma unroll
        for (int ai = 0; ai < 2; ++ai)
#pragma unroll
            for (int m = 0; m < 4; ++m) sv[ai][m] = affsel[row0 + ai * HALF + m * 16];
#pragma unroll
        for (int ai = 0; ai < 2; ++ai)
#pragma unroll
            for (int m = 0; m < 4; ++m) { const int row = row0 + ai * HALF + m * 16; const float s = sv[ai][m];
                bf16_t* rowp = (ks == 0) ? Y + (size_t)row * 1024 + col0 : YP + ((size_t)(ks - 1) * 4096 + e * 256 + (row - u.orow)) * 1024 + col0;
#pragma unroll
                for (int bj = 0; bj < 2; ++bj) { const f32x4 v0 = acc[ai][bj][m][0] * s, v1 = acc[ai][bj][m][1] * s;
                    u32x4 w; w.x = pk2(v0[0], v0[1]); w.y = pk2(v0[2], v0[3]); w.z = pk2(v1[0], v1[1]); w.w = pk2(v1[2], v1[3]);
                    *(u32x4*)(rowp + bj * HALF) = w; } }
    }
};

struct NoHooks { DI void a_ready(const Unit&) const {} DI void done(const Unit&) const {} };
struct SchedInProj : NoHooks {
    const char* A; const char* Bt; int G, c;
    DI bool next(int i, Unit& u) const {
        constexpr int nM = MR / 256, nN = NP / 256, nwg = nM * nN, NXCD = 8, WGM = 8;
        const long L = (long)i * G + c; if (L >= nwg) return false;
        int wgid = (int)L; { const int q = nwg / NXCD, r = nwg % NXCD, xcd = wgid % NXCD, off = wgid / NXCD; wgid = (xcd < r ? xcd * (q + 1) : r * (q + 1) + (xcd - r) * q) + off; }
        const int nig = WGM * nN, gid = wgid / nig, fm = gid * WGM, gsz = (nM - fm) < WGM ? (nM - fm) : WGM;
        const int pm = fm + ((wgid % nig) % gsz), pn = (wgid % nig) / gsz;
        u.a = A + (size_t)pm * 256 * 1024 * 2; u.b = Bt + (size_t)pn * 256 * 1024 * 2; u.orow = pm * 256; u.ocol = pn * 256; u.aux = 0; u.keep = 0; u.nt = 0; return true;
    }
};
template <int NBR> struct SchedTok : NoHooks {
    const char* A0; const char* A1; const char* A2; const char* Bt; int KA  ; int ntile; bool skip_ctx; int G, c;
    DI bool next(int i, Unit& u) const {
        const int k = i / NBR, j = i - k * NBR; const int t = k * G + c; if (t >= ntile) return false;
        const int lt = t >> 2, pn = t & 3; const int pm = skip_ctx ? (lt / 16) * 17 + 1 + (lt % 16) : lt;
        const char* Ab = (j == 0) ? A0 : (j == 1 ? A1 : A2);
        u.a = Ab + (size_t)pm * 256 * KA * 2; u.b = Bt + ((size_t)j * 1024 + pn * 256) * KA * 2; u.orow = pm * 256; u.ocol = pn * 256; u.aux = j; u.keep = 0; u.nt = 0; return true;
    }
};
struct SchedExp : NoHooks {
    const char* A; const char* Bt; int KA; int NMT, NPN, OCW  ; int G, c; bool gather  ;
    DI bool next(int i, Unit& u) const {
        const int id = i * G + c; if (id >= NEXP * NMT * NPN) return false;
        const int mt = id % NMT, pn = (id / NMT) % NPN, e = id / (NMT * NPN);
        u.a = gather ? A : A + ((size_t)e * ESTR + mt * 256) * KA * 2; u.b = Bt + ((size_t)e * NPN + pn) * 256 * KA * 2; u.orow = e * ESTR + mt * 256; u.ocol = pn * OCW; u.aux = e; u.keep = 0; u.nt = 0; return true;
    }
};
struct SchedDownSplit : NoHooks {
    const char* A; const char* Bt; int G, c;
    DI bool next(int i, Unit& u) const {
        const int id = i * G + c; if (id >= 768) return false;
        if (id < 512) { const int mt = id & 7, pn = (id >> 3) & 3, e = id >> 5;
            u.a = A + ((size_t)e * ESTR + mt * 256) * 2048 * 2; u.b = Bt + ((size_t)e * 4 + pn) * 256 * 2048 * 2; u.orow = e * ESTR + mt * 256; u.ocol = pn * 256; u.aux = e; u.keep = 0; u.nt = 0; }
        else { const int j = id - 512, ks = j & 3, pn = (j >> 2) & 3, e = j >> 4;
            u.a = A + ((size_t)e * ESTR + 2048) * 2048 * 2 + ks * 512 * 2; u.b = Bt + ((size_t)e * 4 + pn) * 256 * 2048 * 2 + ks * 512 * 2; u.orow = e * ESTR + 2048; u.ocol = pn * 256; u.aux = e | (ks << 8); u.keep = 0; u.nt = 8; }
        return true;
    }
};
}

namespace attn_body {
using bf16=__hip_bfloat16;
using bf16x8=__attribute__((ext_vector_type(8)))short;
using s16x4=__attribute__((ext_vector_type(4)))short;
using f32x16=__attribute__((ext_vector_type(16)))float;
using u32x4=__attribute__((ext_vector_type(4)))unsigned;
constexpr int D=64,NW=8,QBLK=32,QB=QBLK*NW,KVBLK=64,QP=512,KP=128;
__device__ __forceinline__ int crow(int r,int hi){return (r&3)+8*(r>>2)+4*hi;}
#define SBAR() __builtin_amdgcn_sched_barrier(0)
__device__ __forceinline__ void cmask(f32x16&p0,f32x16&p1,int jb,int qrel,int hi){
  const float NEG=-INFINITY; int kb=64*jb+4*hi;
  #pragma unroll
  for(int r=0;r<16;++r){int kv=kb+(r&3)+8*(r>>2); if(kv>qrel)p0[r]=NEG; if(kv+32>qrel)p1[r]=NEG;}
}

constexpr int NSLOT=3, SLOTB=8192;
constexpr int LDS_K=0, LDS_V=NSLOT*SLOTB, LDS_WS=2*NSLOT*SLOTB, LDS_OST=LDS_WS+NW*64*4, LDS_BYTES=LDS_OST+NW*4096;
constexpr float C2=0.125f*1.4426950408889634f;
__device__ __forceinline__ void glds16(const void*gsrc,unsigned lds_dst){unsigned keep;
  asm volatile("s_mov_b32 %0, m0\n\ts_mov_b32 m0, %2\n\ts_nop 0\n\tglobal_load_lds_dwordx4 %1, off\n\ts_mov_b32 m0, %0":"=&s"(keep):"v"(gsrc),"s"(lds_dst):"memory");}
__device__ __forceinline__ float max3f(float a,float b,float c){float r;asm("v_max3_f32 %0, %1, %2, %3":"=v"(r):"v"(a),"v"(b),"v"(c));return r;}
__device__ __forceinline__ float max2f(float a,float b){float r;asm("v_max_f32_e32 %0, %1, %2":"=v"(r):"v"(a),"v"(b));return r;}
__device__ __forceinline__ float fadd_s(float a,float b){float r;asm("v_add_f32_e32 %0, %1, %2":"=v"(r):"v"(a),"v"(b));return r;}
__device__ __forceinline__ float fsub_s(float a,float b){float r;asm("v_sub_f32_e32 %0, %1, %2":"=v"(r):"v"(a),"v"(b));return r;}
typedef float f32x2_t __attribute__((ext_vector_type(2))); typedef __bf16 bf16x2_t __attribute__((ext_vector_type(2)));
__device__ __forceinline__ unsigned cvtpk_s(float lo,float hi){f32x2_t v={lo,hi};bf16x2_t b=__builtin_convertvector(v,bf16x2_t);return __builtin_bit_cast(unsigned,b);}
#define WAIT_BAR(N) asm volatile("s_waitcnt vmcnt(" #N ") lgkmcnt(0)\n\ts_barrier":::"memory")

__device__ __forceinline__ void qkt(f32x16&p0,f32x16&p1,const char*Kslot,const bf16x8*qr,const f32x16&negm,int r32,int hi){
  const char*kb=Kslot+hi*1024+r32*16;
  #pragma unroll
  for(int d0=0;d0<4;++d0){
    const bf16x8 b0=*reinterpret_cast<const bf16x8*>(kb+d0*2048);
    const bf16x8 b1=*reinterpret_cast<const bf16x8*>(kb+d0*2048+512);
    if(d0==0){p0=__builtin_amdgcn_mfma_f32_32x32x16_bf16(b0,qr[0],negm,0,0,0);p1=__builtin_amdgcn_mfma_f32_32x32x16_bf16(b1,qr[0],negm,0,0,0);}
    else{p0=__builtin_amdgcn_mfma_f32_32x32x16_bf16(b0,qr[d0],p0,0,0,0);p1=__builtin_amdgcn_mfma_f32_32x32x16_bf16(b1,qr[d0],p1,0,0,0);}}
}
typedef __attribute__((address_space(3))) const char* lds_cptr;
typedef short v4i16_t __attribute__((ext_vector_type(4)));
__device__ __forceinline__ void kload8(bf16x8*kf,lds_cptr kp){
  kf[0]=*(const __attribute__((address_space(3))) bf16x8*)(kp);      kf[1]=*(const __attribute__((address_space(3))) bf16x8*)(kp+512);
  kf[2]=*(const __attribute__((address_space(3))) bf16x8*)(kp+2048); kf[3]=*(const __attribute__((address_space(3))) bf16x8*)(kp+2560);
  kf[4]=*(const __attribute__((address_space(3))) bf16x8*)(kp+4096); kf[5]=*(const __attribute__((address_space(3))) bf16x8*)(kp+4608);
  kf[6]=*(const __attribute__((address_space(3))) bf16x8*)(kp+6144); kf[7]=*(const __attribute__((address_space(3))) bf16x8*)(kp+6656);
}
__device__ __forceinline__ void kload2(bf16x8*kf,lds_cptr kp,int j){ kf[2*j]=*(const __attribute__((address_space(3))) bf16x8*)(kp+j*2048); kf[2*j+1]=*(const __attribute__((address_space(3))) bf16x8*)(kp+j*2048+512); }
__device__ __forceinline__ s16x4 vtr(lds_cptr p){ return __builtin_bit_cast(s16x4,__builtin_amdgcn_ds_read_tr16_b64_v4i16((__attribute__((address_space(3))) v4i16_t*)p)); }
__device__ __forceinline__ float rowmax(const f32x16&p0,const f32x16&p1){
  float a=max3f(p0[0],p0[1],p1[0]),b=max3f(p0[2],p0[3],p1[1]);a=max3f(a,p1[2],p1[3]);
  #pragma unroll
  for(int r=4;r<16;r+=4){a=max3f(a,p0[r],p0[r+1]);b=max3f(b,p0[r+2],p0[r+3]);a=max3f(a,p1[r],p1[r+1]);b=max3f(b,p1[r+2],p1[r+3]);}
  const float m=max2f(a,b);
  auto rr=__builtin_amdgcn_permlane32_swap(__float_as_uint(m),__float_as_uint(m),false,false);
  return max2f(__uint_as_float(rr[0]),__uint_as_float(rr[1]));
}
__device__ __forceinline__ void pv(f32x16*o,int vb,bf16x8 pa0,bf16x8 pa1,bf16x8 pa2,bf16x8 pa3){
  #pragma unroll
  for(int d0=0;d0<2;++d0){s16x4 lo[4],hi[4];
    #pragma unroll
    for(int ks=0;ks<4;++ks){
      asm volatile("ds_read_b64_tr_b16 %0,%1 offset:%c2":"=&v"(lo[ks]):"v"(vb),"i"(d0*4096+ks*1024):"memory");
      asm volatile("ds_read_b64_tr_b16 %0,%1 offset:%c2":"=&v"(hi[ks]):"v"(vb),"i"(d0*4096+ks*1024+512):"memory");}
    asm volatile("s_waitcnt lgkmcnt(0)":::"memory");SBAR();
    #define PK(k) (bf16x8){lo[k][0],lo[k][1],lo[k][2],lo[k][3],hi[k][0],hi[k][1],hi[k][2],hi[k][3]}
    o[d0]=__builtin_amdgcn_mfma_f32_32x32x16_bf16(pa0,PK(0),o[d0],0,0,0);
    o[d0]=__builtin_amdgcn_mfma_f32_32x32x16_bf16(pa1,PK(1),o[d0],0,0,0);
    o[d0]=__builtin_amdgcn_mfma_f32_32x32x16_bf16(pa2,PK(2),o[d0],0,0,0);
    o[d0]=__builtin_amdgcn_mfma_f32_32x32x16_bf16(pa3,PK(3),o[d0],0,0,0);
    #undef PK
  }
}

#ifndef ATTN_STORE16
#define ATTN_STORE16(p,v) (*(u32x4*)(p)=(v))
#endif
template<int THRL> __device__ __forceinline__ void attn_unit(long qrow0,long krow0,int NT_,int h,int g,const bf16*Q,const bf16*__restrict__ K,const bf16*__restrict__ V,bf16*O,char*shm){
  int tid=threadIdx.x; asm volatile("":"+v"(tid)); const int lane=tid&63,r32=lane&31,hi=lane>>5; const int wid=__builtin_amdgcn_readfirstlane(tid>>6);
  const bf16*Qw=Q+(qrow0+wid*QBLK)*QP+h*D;
  const bf16*Kh=K+krow0*KP+g*D,*Vh=V+krow0*KP+g*D;
  const unsigned lds0=(unsigned)(uintptr_t)shm;
  float*wsf=(float*)(shm+LDS_WS)+wid*64;
  const bf16*ksrc=Kh+(long)lane*KP+wid*8;
  const bf16*vsrc=Vh+(long)(16*(wid&3)+(lane>>2))*KP+(wid>>2)*32+(lane&3)*8;
  const unsigned kdst=lds0+LDS_K+wid*1024, vdst=lds0+LDS_V+wid*1024;
  #define DMA_K(t,slot) glds16(ksrc+(long)(t)*KVBLK*KP,(unsigned)__builtin_amdgcn_readfirstlane(kdst+(slot)))
  #define DMA_V(t,slot) glds16(vsrc+(long)(t)*KVBLK*KP,(unsigned)__builtin_amdgcn_readfirstlane(vdst+(slot)))
  const int vb0=(int)(lds0+LDS_V)+((lane>>4)&1)*32+(lane&3)*8+(4*hi+((lane&15)>>2))*64;
  const char*Kbase=shm+LDS_K; bf16x8 kf[8];
  const lds_cptr shm3=(lds_cptr)shm; const lds_cptr kp0=shm3+LDS_K+hi*1024+r32*16; const lds_cptr vp0=shm3+LDS_V+((lane>>4)&1)*32+(lane&3)*8+(4*hi+((lane&15)>>2))*64;
  const int NT=NT_;
  DMA_K(0,0);DMA_V(0,0);DMA_K(1,SLOTB);
  bf16x8 qr[4];
  #pragma unroll
  for(int d0=0;d0<4;++d0)qr[d0]=*reinterpret_cast<const bf16x8*>(&Qw[(long)r32*QP+d0*16+hi*8]);
  float mhat=0.f,l_reg=0.f;f32x16 o[2];o[0]=f32x16{};o[1]=f32x16{};f32x16 negm=f32x16{};asm volatile("":"+v"(negm));
  const int qrel=wid*QBLK+r32;
  #define CMASK(P0,P1,t) do{}while(0)
  bool resc=false;
  #define START(P0,P1) do{ const float rm=rowmax(P0,P1); resc=false; \
    { const float dl=rm; mhat=fadd_s(mhat,dl); \
      _Pragma("unroll") for(int r=0;r<16;++r){P0[r]=fsub_s(P0[r],dl);P1[r]=fsub_s(P1[r],dl);} \
      _Pragma("unroll") for(int r=0;r<16;++r)negm[r]=-mhat; asm volatile("":"+v"(negm)); } \
    _Pragma("unroll") for(int r=0;r<16;++r)P0[r]=__builtin_amdgcn_exp2f(P0[r]); }while(0)
  #define RESC() do{ if(resc){ asm volatile("s_waitcnt lgkmcnt(0)":::"memory"); \
      _Pragma("unroll") for(int d_=0;d_<2;++d_) _Pragma("unroll") for(int r=0;r<16;++r)o[d_][r]*=wsf[crow(r,hi)]; } }while(0)
  f32x16 pA0,pA1,pB0,pB1;
  int sl_prev=0,sl_cur=0,sl_next=SLOTB;
  #define ROT() do{sl_prev=sl_cur;sl_cur=sl_next;sl_next=(sl_next==(NSLOT-1)*SLOTB)?0:sl_next+SLOTB;}while(0)
  DMA_K(2,2*SLOTB);
  WAIT_BAR(3);
  qkt(pA0,pA1,Kbase,qr,negm,r32,hi);asm volatile("s_nop 15\n\ts_nop 7":"+v"(pA0),"+v"(pA1));CMASK(pA0,pA1,0);
  START(pA0,pA1);
  _Pragma("unroll") for(int r=0;r<16;++r)pA1[r]=__builtin_amdgcn_exp2f(pA1[r]);
  WAIT_BAR(0);
  DMA_K(3,0);DMA_V(1,SLOTB);
  ROT();
  kload8(kf,kp0+sl_cur);
  WAIT_BAR(2);
  s16x4 vlo[8],vhi[8]; u32x4 pw0,pw1,pw2,pw3;
  #define PKW(P,B) cvtpk_s(P[B],P[B+1])
  #define PAF(k) __builtin_bit_cast(bf16x8,pw##k)
  #define VFR(i) (bf16x8){vlo[i][0],vlo[i][1],vlo[i][2],vlo[i][3],vhi[i][0],vhi[i][1],vhi[i][2],vhi[i][3]}
  #define PIN(x) asm volatile("":"+v"(x))
  #define MX3(a,b,c) __builtin_fmaxf(__builtin_fmaxf((a),(b)),(c))
  #define GAPA(MF,A0,A1,A2,A3,W0,W1,PW) do{ MF; sacc+=A0; sacc+=A1; sacc+=A2; sacc+=A3; PIN(sacc); W0; W1; PIN(PW); SBAR(); }while(0)
  #define EX(v) __builtin_amdgcn_exp2f(v)
  #define GAPB(MF,X,B) do{ MF; X[B]=EX(X[B]); X[B+1]=EX(X[B+1]); X[B+2]=EX(X[B+2]); X[B+3]=EX(X[B+3]); PIN(X); SBAR(); }while(0)
  #define VRD(i) do{ vlo[i]=vtr(vp_+(((i)>>2)*4096+((i)&3)*1024)); vhi[i]=vtr(vp_+(((i)>>2)*4096+((i)&3)*1024+512)); }while(0)
  #define KRD(G,j) do{ if(G){ kload2(kf,kp0+sl_next,j); SBAR(); } }while(0)
  #define STEP(C0,C1,P0,P1,t,GK,GV,GL) do{ SBAR(); \
    const lds_cptr vp_=vp0+sl_prev; \
    VRD(0); SBAR(); float sacc=(P0[0]+P0[1]); \
    GAPA(C0=__builtin_amdgcn_mfma_f32_32x32x16_bf16(kf[0],qr[0],negm,0,0,0), P0[2],P0[3],P0[4],P0[5],     pw0[0]=PKW(P0,0), pw0[1]=PKW(P0,2), pw0); \
    VRD(4); SBAR(); GAPA(C1=__builtin_amdgcn_mfma_f32_32x32x16_bf16(kf[1],qr[0],negm,0,0,0), P0[6],P0[7],P0[8],P0[9],     pw0[2]=PKW(P0,4), pw0[3]=PKW(P0,6), pw0); \
    VRD(1); SBAR(); GAPA(C0=__builtin_amdgcn_mfma_f32_32x32x16_bf16(kf[2],qr[1],C0,0,0,0),   P0[10],P0[11],P0[12],P0[13], pw1[0]=PKW(P0,8), pw1[1]=PKW(P0,10), pw1); \
    VRD(5); SBAR(); GAPA(C1=__builtin_amdgcn_mfma_f32_32x32x16_bf16(kf[3],qr[1],C1,0,0,0),   P0[14],P0[15],P1[0],P1[1],   pw1[2]=PKW(P0,12),pw1[3]=PKW(P0,14), pw1); \
    VRD(2); SBAR(); GAPA(C0=__builtin_amdgcn_mfma_f32_32x32x16_bf16(kf[4],qr[2],C0,0,0,0),   P1[2],P1[3],P1[4],P1[5],     pw2[0]=PKW(P1,0), pw2[1]=PKW(P1,2), pw2); \
    VRD(6); SBAR(); GAPA(C1=__builtin_amdgcn_mfma_f32_32x32x16_bf16(kf[5],qr[2],C1,0,0,0),   P1[6],P1[7],P1[8],P1[9],     pw2[2]=PKW(P1,4), pw2[3]=PKW(P1,6), pw2); \
    VRD(3); SBAR(); GAPA(C0=__builtin_amdgcn_mfma_f32_32x32x16_bf16(kf[6],qr[3],C0,0,0,0),   P1[10],P1[11],P1[12],P1[13], pw3[0]=PKW(P1,8), pw3[1]=PKW(P1,10), pw3); \
    VRD(7); SBAR(); GAPA(C1=__builtin_amdgcn_mfma_f32_32x32x16_bf16(kf[7],qr[3],C1,0,0,0),   P1[14],P1[15],0.f,0.f,       pw3[2]=PKW(P1,12),pw3[3]=PKW(P1,14), pw3); \
    l_reg+=sacc; \
    if(GK){DMA_K((t)+3,sl_cur);} if(GV){DMA_V((t)+1,sl_next);} \
    CMASK(C0,C1,t); \
    { float a=MX3(C0[0],C0[1],C1[0]),b=MX3(C0[2],C0[3],C1[1]); a=MX3(a,C1[2],C1[3]); \
      _Pragma("unroll") for(int r=4;r<16;r+=4){a=MX3(a,C0[r],C0[r+1]);b=MX3(b,C0[r+2],C0[r+3]);a=MX3(a,C1[r],C1[r+1]);b=MX3(b,C1[r+2],C1[r+3]);} \
      float rm=__builtin_fmaxf(a,b); { auto rr=__builtin_amdgcn_permlane32_swap(__float_as_uint(rm),__float_as_uint(rm),false,false); rm=__builtin_fmaxf(__uint_as_float(rr[0]),__uint_as_float(rr[1])); } \
      resc=false; \
      if(__builtin_expect(__any(rm>(float)THRL),0)){ const float dl=__builtin_fmaxf(rm,0.f); mhat+=dl; \
        _Pragma("unroll") for(int r=0;r<16;++r){C0[r]-=dl;C1[r]-=dl;} \
        _Pragma("unroll") for(int r=0;r<16;++r)negm[r]=-mhat; asm volatile("":"+v"(negm)); \
        const float f=__builtin_amdgcn_exp2f(-dl); l_reg*=f; if(hi==0)wsf[r32]=f; resc=true; } } \
    SBAR(); \
    GAPB(o[0]=__builtin_amdgcn_mfma_f32_32x32x16_bf16(PAF(0),VFR(0),o[0],0,0,0), C0,0); \
    GAPB(o[1]=__builtin_amdgcn_mfma_f32_32x32x16_bf16(PAF(0),VFR(4),o[1],0,0,0), C0,4); \
    KRD(GL,0); GAPB(o[0]=__builtin_amdgcn_mfma_f32_32x32x16_bf16(PAF(1),VFR(1),o[0],0,0,0), C0,8); \
    KRD(GL,1); GAPB(o[1]=__builtin_amdgcn_mfma_f32_32x32x16_bf16(PAF(1),VFR(5),o[1],0,0,0), C0,12); \
    KRD(GL,2); GAPB(o[0]=__builtin_amdgcn_mfma_f32_32x32x16_bf16(PAF(2),VFR(2),o[0],0,0,0), C1,0); \
    KRD(GL,3); GAPB(o[1]=__builtin_amdgcn_mfma_f32_32x32x16_bf16(PAF(2),VFR(6),o[1],0,0,0), C1,4); \
    GAPB(o[0]=__builtin_amdgcn_mfma_f32_32x32x16_bf16(PAF(3),VFR(3),o[0],0,0,0), C1,8); \
    GAPB(o[1]=__builtin_amdgcn_mfma_f32_32x32x16_bf16(PAF(3),VFR(7),o[1],0,0,0), C1,12); \
    }while(0)
  int t=1;
  #undef CMASK
  #define CMASK(P0,P1,t) do{}while(0)
  for(;t+5<NT;t+=2){
    STEP(pB0,pB1,pA0,pA1,t,true,true,true);     WAIT_BAR(2); RESC(); ROT();
    STEP(pA0,pA1,pB0,pB1,t+1,true,true,true);   WAIT_BAR(2); RESC(); ROT();
  }
  #undef CMASK
  #define CMASK(P0,P1,t) do{}while(0)
  #define ENDW(tt) do{ if((tt)+3<NT){WAIT_BAR(2);} else if((tt)+2<NT){WAIT_BAR(1);} else {WAIT_BAR(0);} }while(0)
  for(;t+1<NT;t+=2){
    STEP(pB0,pB1,pA0,pA1,t,(t+3<NT),(t+1<NT),(t+1<NT));       ENDW(t);   RESC(); ROT();
    STEP(pA0,pA1,pB0,pB1,t+1,(t+4<NT),(t+2<NT),(t+2<NT));     ENDW(t+1); RESC(); ROT();
  }
  STEP(pB0,pB1,pA0,pA1,NT-1,false,false,false); RESC();
  { float sacc=pB0[0]+pB0[1]; _Pragma("unroll") for(int r=2;r<16;++r)sacc+=pB0[r]; _Pragma("unroll") for(int r=0;r<16;++r)sacc+=pB1[r]; l_reg+=sacc;
    pw0=(u32x4){PKW(pB0,0),PKW(pB0,2),PKW(pB0,4),PKW(pB0,6)};pw1=(u32x4){PKW(pB0,8),PKW(pB0,10),PKW(pB0,12),PKW(pB0,14)};pw2=(u32x4){PKW(pB1,0),PKW(pB1,2),PKW(pB1,4),PKW(pB1,6)};pw3=(u32x4){PKW(pB1,8),PKW(pB1,10),PKW(pB1,12),PKW(pB1,14)};
    SBAR(); pv(o,vb0+sl_cur,PAF(0),PAF(1),PAF(2),PAF(3)); }
  #undef PKW
  #undef PAF
  #undef VFR
  #undef PIN
  #undef MX3
  #undef GAPA
  #undef GAPB
  #undef EX
  #undef VRD
  #undef KRD
  #undef STEP
  #undef ENDW
  {auto rr=__builtin_amdgcn_permlane32_swap(__float_as_uint(l_reg),__float_as_uint(l_reg),false,false);l_reg=__uint_as_float(rr[0])+__uint_as_float(rr[1]);}
  if(hi==0)wsf[32+r32]=l_reg;asm volatile("s_waitcnt lgkmcnt(0)":::"memory");
  float rli[16];
  #pragma unroll
  for(int r=0;r<16;++r)rli[r]=__builtin_amdgcn_rcpf(wsf[32+crow(r,hi)]);
  bf16*Ow=O+(qrow0+wid*QBLK)*QP+h*D;
  { bf16*stg=(bf16*)(shm+LDS_OST)+wid*2048;
    #pragma unroll
    for(int r=0;r<16;++r){const int orow=crow(r,hi);
      #pragma unroll
      for(int d0=0;d0<2;++d0)stg[orow*64+d0*32+r32]=__float2bfloat16(o[d0][r]*rli[r]);}
    asm volatile("s_waitcnt lgkmcnt(0)":::"memory");
    #pragma unroll
    for(int i=0;i<4;++i){const int row=i*8+(lane>>3),ch=lane&7; const u32x4 v=*(const u32x4*)(stg+row*64+ch*8); ATTN_STORE16(Ow+(long)row*QP+ch*8,v);} }
  asm volatile("s_waitcnt lgkmcnt(0)\n\ts_barrier":::"memory");
  #undef DMA_K
  #undef DMA_V
  #undef CMASK
  #undef START
  #undef RESC
  #undef ROT
}

#undef SBAR
#undef WAIT_BAR
}

#define LDSW() asm volatile("s_waitcnt lgkmcnt(0)" ::: "memory")
#define MFMA32(a, b, c) __builtin_amdgcn_mfma_f32_32x32x16_bf16((a), (b), (c), 0, 0, 0)
struct Tctx { int tid, lane, wave, G, blk, gw, NGW; };
DI Tctx opaque_ctx(const Tctx& T0) { Tctx t = T0; asm volatile("" : "+v"(t.tid)); asm volatile("" : "+s"(t.blk)); asm volatile("" : "+s"(t.G));
    t.NGW = t.G * 8; t.lane = t.tid & 63; t.wave = __builtin_amdgcn_readfirstlane(t.tid >> 6); t.gw = t.blk * 8 + t.wave; return t; }

DI int row_skip(int r, int NGW, bool skipc) { if (skipc && r < MR) { const int p = r % TPB; if (p < CTXL) r += ((CTXL - p + NGW - 1) / NGW) * NGW; } return r; }
struct CvItem { const float* src; bf16_t* dst; int ld, ldd; };
DI void cv_load(const CvItem& it, int lane, f32x4 (&v)[16]) {
#pragma unroll
    for (int j = 0; j < 16; ++j) v[j] = __builtin_nontemporal_load((const f32x4*)(it.src + (size_t)(4 * j + (lane >> 4)) * it.ld + 4 * (lane & 15)));
}
DI void cv_store(const CvItem& it, int lane, const f32x4 (&v)[16], LAS float* scr) {
#pragma unroll
    for (int j = 0; j < 16; ++j) { LAS float* s = scr + (4 * j + (lane >> 4)) * 65 + 4 * (lane & 15); s[0] = v[j].x; s[1] = v[j].y; s[2] = v[j].z; s[3] = v[j].w; }
    LDSW();
    const int c = lane & 7;
#pragma unroll
    for (int j = 0; j < 8; ++j) { const int n = (lane >> 3) + 8 * j; const LAS float* s = scr + (8 * c) * 65 + n;
        u32x4 o; o.x = pk2(s[0], s[65]); o.y = pk2(s[130], s[195]); o.z = pk2(s[260], s[325]); o.w = pk2(s[390], s[455]);
        __builtin_nontemporal_store(o, (u32x4*)(it.dst + (size_t)n * it.ldd + 8 * c)); }
    LDSW();
}
DI CvItem cv_decode(const Params& P, int it0) {
    bf16_t* WIN = (bf16_t*)(P.ws + WS_WIN); bf16_t* WBR = (bf16_t*)(P.ws + WS_WBR); bf16_t* WO = (bf16_t*)(P.ws + WS_WO); bf16_t* WGU = (bf16_t*)(P.ws + WS_WGU); bf16_t* WD = (bf16_t*)(P.ws + WS_WD);
    constexpr int I_IN = 16 * 104, I_BR = 8 * 16, I_O = 16 * 16, I_G = 16 * 32, I_D = 32 * 16;
    constexpr int PER_LAYER = I_IN + 3 * I_BR + I_O + NEXP * (2 * I_G + I_D);
    CvItem r;
    const int l = it0 / PER_LAYER; int it = it0 - l * PER_LAYER;
    if (it < I_IN) { const int kb = it / 104, nb = it % 104; const int scol = nb * 64 + (nb >= 16 ? 16 : 0);
        r.src = P.w_in + ((size_t)l * 1024 + kb * 64) * IN_COLS + scol; r.ld = IN_COLS; r.dst = WIN + ((size_t)l * NP + nb * 64) * 1024 + kb * 64; r.ldd = 1024; return r; }
    it -= I_IN;
    if (it < 3 * I_BR) { const int j = it / I_BR; it -= j * I_BR; const int kb = it / 16, nb = it % 16; const float* w = (j == 0) ? P.w_br_attn : (j == 1 ? P.w_br_ssd : P.w_br_conv);
        r.src = w + ((size_t)l * 512 + kb * 64) * 1024 + nb * 64; r.ld = 1024; r.dst = WBR + (((size_t)l * 3 + j) * 1024 + nb * 64) * 512 + kb * 64; r.ldd = 512; return r; }
    it -= 3 * I_BR;
    if (it < I_O) { const int kb = it / 16, nb = it % 16;
        r.src = P.w_o + ((size_t)l * 1024 + kb * 64) * 1024 + nb * 64; r.ld = 1024; r.dst = WO + ((size_t)l * 1024 + nb * 64) * 1024 + kb * 64; r.ldd = 1024; return r; }
    it -= I_O;
    const int e = it / (2 * I_G + I_D); it -= e * (2 * I_G + I_D);
    if (it < 2 * I_G) { const int up = it / I_G; it -= up * I_G; const int kb = it / 32, nb = it % 32; const float* w = up ? P.w_exp_up : P.w_exp_gate;
        const int f0 = nb * 64, pn = f0 >> 7, within = f0 & 127; const size_t drow = ((size_t)(l * NEXP + e) * 16 + pn) * 256 + up * 128 + within;
        r.src = w + (((size_t)l * NEXP + e) * 1024 + kb * 64) * 2048 + nb * 64; r.ld = 2048; r.dst = WGU + drow * 1024 + kb * 64; r.ldd = 1024; return r; }
    it -= 2 * I_G;
    { const int kb = it / 16, nb = it % 16;
        r.src = P.w_exp_down + (((size_t)l * NEXP + e) * 2048 + kb * 64) * 1024 + nb * 64; r.ld = 1024; r.dst = WD + (((size_t)l * NEXP + e) * 1024 + nb * 64) * 2048 + kb * 64; r.ldd = 2048; return r; }
}
DI void p0_convert(const Params& P, const Tctx& T0, unsigned char* lds) { const Tctx T = opaque_ctx(T0);
    LAS float* scr = (LAS float*)lds + T.wave * (64 * 65);
    constexpr int NITEM = NLAYER * (16 * 104 + 3 * 8 * 16 + 16 * 16 + NEXP * (2 * 16 * 32 + 32 * 16));
    int it = T.gw; if (it >= NITEM) return;
    CvItem cur = cv_decode(P, it); f32x4 va[16], vb[16]; cv_load(cur, T.lane, va);
    for (;;) {
        int nit = it + T.NGW; CvItem nxt = cur; const bool hn = nit < NITEM; if (hn) { nxt = cv_decode(P, nit); cv_load(nxt, T.lane, vb); }
        cv_store(cur, T.lane, va, scr);
        if (!hn) break;
        it = nit + T.NGW; cur = nxt; const bool hn2 = it < NITEM; if (hn2) { cur = cv_decode(P, it); cv_load(cur, T.lane, va); }
        cv_store(nxt, T.lane, vb, scr);
        if (!hn2) break;
    }
}
DI void p0_modv(const Params& P, const Tctx& T0, unsigned char* lds_, int item) { const Tctx T = opaque_ctx(T0);
    LAS float* lds = (LAS float*)lds_;
    const int layer = item / 96, jb = item % 96;
    for (int i = T.tid; i < 5120; i += 512) { const int row = i >> 10, k = i & 1023; const float cv = row < 4 ? P.c[row * 1024 + k] : P.c_ctx[k]; lds[i] = siluf_(cv); }
    __syncthreads();
    const int col = T.tid & 63, ks = T.tid >> 6;
    const float* w = P.w_mod + ((size_t)layer * 1024 + ks * 128) * 6144 + jb * 64 + col;
    float a0 = 0.f, a1 = 0.f, a2 = 0.f, a3 = 0.f, a4 = 0.f;
#pragma unroll 1
    for (int k0 = 0; k0 < 128; k0 += 32) { float wv[32];
#pragma unroll
        for (int q = 0; q < 32; ++q) wv[q] = w[(size_t)(k0 + q) * 6144];
#pragma unroll
        for (int q = 0; q < 32; ++q) { const int kk = ks * 128 + k0 + q;
            a0 += lds[kk] * wv[q]; a1 += lds[1024 + kk] * wv[q]; a2 += lds[2048 + kk] * wv[q]; a3 += lds[3072 + kk] * wv[q]; a4 += lds[4096 + kk] * wv[q]; } }
    LAS float* red = lds + 5120;
    red[(ks * 5 + 0) * 64 + col] = a0; red[(ks * 5 + 1) * 64 + col] = a1; red[(ks * 5 + 2) * 64 + col] = a2; red[(ks * 5 + 3) * 64 + col] = a3; red[(ks * 5 + 4) * 64 + col] = a4;
    __syncthreads();
    if (T.tid < 320) { const int row = T.tid >> 6, cc = T.tid & 63; float s = 0.f;
#pragma unroll
        for (int q = 0; q < 8; ++q) s += red[(q * 5 + row) * 64 + cc];
        ((float*)(P.ws + WS_MODV))[((size_t)layer * 5 + row) * 6144 + jb * 64 + cc] = s + P.b_mod[(size_t)layer * 6144 + jb * 64 + cc]; }
    __syncthreads();
}
DI void p0_rope(const Params& P, const Tctx& T0) { const Tctx T = opaque_ctx(T0);
    float* tab = (float*)(P.ws + WS_ROPE);
    for (int i = T.tid; i < 1024; i += 512) { const int pos = i >> 4, j = i & 15;
        const float inv = exp2f(-(float)j * (13.287712379549449f / 16.f));
        const float ang = (float)pos * inv; float rev = ang * 0.15915494309189535f; rev -= floorf(rev);
        tab[2 * i] = __builtin_amdgcn_cosf(rev); tab[2 * i + 1] = __builtin_amdgcn_sinf(rev); }
}

DI void ln_norm(f32x4 (&v)[4]) {
    float s = 0.f;
#pragma unroll
    for (int j = 0; j < 4; ++j) s += (v[j].x + v[j].y) + (v[j].z + v[j].w);
    const float mean = wave_sum(s) * (1.f / DMODEL); float s2 = 0.f;
#pragma unroll
    for (int j = 0; j < 4; ++j) { v[j] = v[j] - mean; s2 += (v[j].x * v[j].x + v[j].y * v[j].y) + (v[j].z * v[j].z + v[j].w * v[j].w); }
    const float rstd = rsqrtf(wave_sum(s2) * (1.f / DMODEL) + EPSF);
#pragma unroll
    for (int j = 0; j < 4; ++j) v[j] = v[j] * rstd;
}
DI void load_row(const float* p, int lane, f32x4 (&v)[4]) {
#pragma unroll
    for (int j = 0; j < 4; ++j) v[j] = *((const f32x4*)p + lane + 64 * j);
}
DI void store_row(float* p, int lane, const f32x4 (&v)[4]) {
#pragma unroll
    for (int j = 0; j < 4; ++j) *((f32x4*)p + lane + 64 * j) = v[j];
}
DI void store_row_bf16(bf16_t* p, int lane, const f32x4 (&v)[4]) {
#pragma unroll
    for (int j = 0; j < 4; ++j) { u32x2 o; o.x = pk2(v[j].x, v[j].y); o.y = pk2(v[j].z, v[j].w); *((u32x2*)p + lane + 64 * j) = o; }
}
DI void stage_w16(LAS float* Wl, const float* src, int ld, int tid) {
    for (int idx = tid; idx < 16384; idx += 512) { const int k = idx >> 4, jj = idx & 15; const int j = k >> 8, l = (k & 255) >> 2, e = k & 3;
        Wl[((j * 4 + e) * 64 + l) * 16 + jj] = src[(size_t)k * ld + jj]; }
}
DI void row_dot16(const f32x4 (&h)[4], const LAS float* Wl, int lane, float (&s)[16]) {
#pragma unroll
    for (int q = 0; q < 16; ++q) s[q] = 0.f;
#pragma unroll
    for (int j = 0; j < 4; ++j)
#pragma unroll
        for (int e = 0; e < 4; ++e) { const float x = h[j][e]; const LAS f32x4* wp = (const LAS f32x4*)(Wl + ((j * 4 + e) * 64 + lane) * 16);
#pragma unroll
            for (int q = 0; q < 4; ++q) { const f32x4 w = wp[q]; s[4 * q] += x * w.x; s[4 * q + 1] += x * w.y; s[4 * q + 2] += x * w.z; s[4 * q + 3] += x * w.w; }
            if (e & 1) asm volatile("" ::: "memory"); }
}

DI void row_dot16x2(const f32x4 (&ha)[4], const f32x4 (&hb)[4], const LAS float* Wl, int lane, float (&sa)[16], float (&sb)[16]) {
#pragma unroll
    for (int o = 0; o < 16; ++o) { sa[o] = 0.f; sb[o] = 0.f; }
#pragma unroll
    for (int j = 0; j < 4; ++j)
#pragma unroll
        for (int e = 0; e < 4; ++e) { const LAS f32x4* wp = (const LAS f32x4*)(Wl + ((j * 4 + e) * 64 + lane) * 16); const float xa = ha[j][e], xb = hb[j][e];
#pragma unroll
            for (int o4 = 0; o4 < 4; ++o4) { const f32x4 w = wp[o4];
                sa[4 * o4] += xa * w.x; sa[4 * o4 + 1] += xa * w.y; sa[4 * o4 + 2] += xa * w.z; sa[4 * o4 + 3] += xa * w.w;
                sb[4 * o4] += xb * w.x; sb[4 * o4 + 1] += xb * w.y; sb[4 * o4 + 2] += xb * w.z; sb[4 * o4 + 3] += xb * w.w; }
            if (e & 1) asm volatile("" ::: "memory"); }
}
DI void p1_row(const Params& P, int layer, const float* modv, bf16_t* H, int r, bool ok, int lane, f32x4 (&v)[4]) {
    int b, p; row_bp(r, b, p); const int mrow = p < CTXL ? 4 : b; ln_norm(v); const float* mv = modv + (size_t)mrow * 6144;
#pragma unroll
    for (int j = 0; j < 4; ++j) { const f32x4 sh = *((const f32x4*)mv + lane + 64 * j), sc = *((const f32x4*)(mv + 1024) + lane + 64 * j); v[j] = v[j] * (sc + 1.f) + sh; }
    if (ok) store_row_bf16(H + (size_t)r * DMODEL, lane, v);
}
DI void p1_modulate(const Params& P, const Tctx& T0, unsigned char* lds, int layer) { const Tctx T = opaque_ctx(T0);
    LAS float* Wl = (LAS float*)lds;
    stage_w16(Wl, P.w_in + (size_t)layer * 1024 * IN_COLS + 1024, IN_COLS, T.tid);
    __syncthreads();
    const float* modv = (const float*)(P.ws + WS_MODV) + (size_t)layer * 5 * 6144;
    bf16_t* H = (bf16_t*)(P.ws + WS_H); float* DT = (float*)(P.ws + WS_DT);
    const int jl = lane_j16(T.lane); const float dtb = P.ssd_dt_bias[layer * 16 + jl];
#pragma unroll 1
    for (int r = T.gw; r < MR; r += 2 * T.NGW) {
        const int r2 = r + T.NGW; const bool ok2 = r2 < MR; const int rb = ok2 ? r2 : r;
        f32x4 va[4], vb[4]; load_row(xsrc_row(P, layer, r), T.lane, va); load_row(xsrc_row(P, layer, rb), T.lane, vb);
        p1_row(P, layer, modv, H, r, true, T.lane, va); p1_row(P, layer, modv, H, rb, ok2, T.lane, vb);
        float sa[16], sb[16]; row_dot16x2(va, vb, Wl, T.lane, sa, sb);
        const float xa = reduce16(sa, T.lane) + dtb, xb = reduce16(sb, T.lane) + dtb;
        if ((T.lane & 3) == 0) { DT[(size_t)r * 16 + jl] = xa > 20.f ? xa : __logf(1.f + __expf(xa)); if (ok2) DT[(size_t)r2 * 16 + jl] = xb > 20.f ? xb : __logf(1.f + __expf(xb)); }
    }
    __syncthreads();
}

DI void norm_rope8(float (&y)[8], const float (&nw)[8], int lq, bool do_rope, const float* tab_row, const float* tab_col, float outscale) {
    float ss = 0.f;
#pragma unroll
    for (int e = 0; e < 8; ++e) ss += y[e] * y[e];
    ss += dppf<0xB1>(ss); ss += dppf<0x4E>(ss); ss += dppf<0x141>(ss);
    const float rstd = rsqrtf(ss * (1.f / 64.f) + EPSF);
#pragma unroll
    for (int e = 0; e < 8; ++e) y[e] = y[e] * rstd * nw[e];
    if (do_rope) { const int axis = lq >> 2, half = (lq >> 1) & 1, j0 = 8 * (lq & 1); const float* tab = (axis ? tab_col : tab_row) + 2 * j0;
#pragma unroll
        for (int e = 0; e < 8; ++e) { const float pr = dppf<0x4E>(y[e]); const float cs = tab[2 * e], sn = tab[2 * e + 1]; y[e] = half ? y[e] * cs + pr * sn : y[e] * cs - pr * sn; } }
#pragma unroll
    for (int e = 0; e < 8; ++e) y[e] *= outscale;
}
struct P3In { u32x4 qv, kv, xc0, xp0, xn0, xc1, xp1, xn1, sb, sc1, sx1, sc0, sx0, sc2, sx2; };
DI void p3_load(const bf16_t* PROJ, int r, int lane, P3In& I) {
    const int p = r % TPB; const bf16_t* pr = PROJ + (size_t)r * NP;
    const bool hasprev = !(p == 0 || p == CTXL), hasnext = !(p == CTXL - 1 || p == TPB - 1);
    const bf16_t* pp = hasprev ? pr - NP : pr; const bf16_t* pq = hasnext ? pr + NP : pr; const int l16 = lane & 15, ch1 = 512 + 8 * (lane & 31);
    I.qv = *(const u32x4*)(pr + PQ + 8 * lane); I.kv = *(const u32x4*)(pr + (lane < 16 ? PK : PV) + 8 * l16);
    I.xc0 = *(const u32x4*)(pr + PXBC + 8 * lane); I.xp0 = *(const u32x4*)(pp + PXBC + 8 * lane); I.xn0 = *(const u32x4*)(pq + PXBC + 8 * lane);
    I.xc1 = *(const u32x4*)(pr + PXBC + ch1); I.xp1 = *(const u32x4*)(pp + PXBC + ch1); I.xn1 = *(const u32x4*)(pq + PXBC + ch1);
    I.sb = *(const u32x4*)(pr + PSCB + 8 * lane); I.sc1 = *(const u32x4*)(pr + PSCC + 8 * lane); I.sx1 = *(const u32x4*)(pr + PSCX + 8 * lane);
    I.sc0 = *(const u32x4*)(pp + PSCC + 8 * lane); I.sx0 = *(const u32x4*)(pp + PSCX + 8 * lane); I.sc2 = *(const u32x4*)(pq + PSCC + 8 * lane); I.sx2 = *(const u32x4*)(pq + PSCX + 8 * lane);
}
DI void p3_post(const Params& P, const Tctx& T0, int layer) { const Tctx T = opaque_ctx(T0);
    const bf16_t* PROJ = (const bf16_t*)(P.ws + WS_PROJ); const float* rope = (const float*)(P.ws + WS_ROPE);
    bf16_t* Qf = (bf16_t*)(P.ws + WS_Q); bf16_t* Kf = (bf16_t*)(P.ws + WS_K); bf16_t* Vf = (bf16_t*)(P.ws + WS_V); bf16_t* XBC = (bf16_t*)(P.ws + WS_XBC); bf16_t* YC = (bf16_t*)(P.ws + WS_YC);
    const int lane = T.lane, lq = lane & 7;
    const u32x4 z4 = {0u, 0u, 0u, 0u};
    float qn[8], kn[8], cw0[3][8], cb0[8], sw[3][8];
    {
#pragma unroll
      for (int e = 0; e < 8; ++e) { qn[e] = P.q_norm[layer * 64 + 8 * lq + e]; kn[e] = P.k_norm[layer * 64 + 8 * lq + e];
          cb0[e] = P.ssd_conv_b[(size_t)layer * 768 + 8 * lane + e];
#pragma unroll
          for (int t = 0; t < 3; ++t) { cw0[t][e] = P.ssd_conv_w[((size_t)layer * 3 + t) * 768 + 8 * lane + e]; sw[t][e] = P.sc_conv_w[((size_t)layer * 3 + t) * 512 + 8 * lane + e]; } } }
    P3In In; if (T.gw < MR) p3_load(PROJ, T.gw, lane, In);
    for (int r = T.gw; r < MR; r += T.NGW) {
        const P3In I = In; if (r + T.NGW < MR) p3_load(PROJ, r + T.NGW, lane, In);
        if (lane == 0) ((float*)(P.ws + WS_SSQ))[r] = 0.f;
        int b, p; row_bp(r, b, p); const bool isctx = p < CTXL; const int pos = isctx ? 0 : p - CTXL;
        const float* trow = rope + (size_t)(pos >> 6) * 32; const float* tcol = rope + (size_t)(pos & 63) * 32;
        const bool hasprev = !(p == 0 || p == CTXL), hasnext = !(p == CTXL - 1 || p == TPB - 1);
        const int ch1 = 512 + 8 * (lane & 31);
        { float y[8]; unpack8(I.qv, y); norm_rope8(y, qn, lq, !isctx, trow, tcol, QSCALE); *(u32x4*)(Qf + (size_t)r * 512 + 8 * lane) = pack8(y); }
        { float y[8]; unpack8(I.kv, y); norm_rope8(y, kn, lq, !isctx, trow, tcol, 1.f);
          if (lane < 16) *(u32x4*)(Kf + (size_t)r * 128 + 8 * lane) = pack8(y);
          else if (lane < 32) *(u32x4*)(Vf + (size_t)r * 128 + 8 * (lane - 16)) = I.kv; }
#pragma unroll
        for (int pass = 0; pass < 2; ++pass) { const int ch0 = pass ? ch1 : 8 * lane;
            if (pass == 0 || lane < 32) { float cu[8], pv[8], nx[8]; unpack8(pass ? I.xc1 : I.xc0, cu); unpack8(hasprev ? (pass ? I.xp1 : I.xp0) : z4, pv); unpack8(hasnext ? (pass ? I.xn1 : I.xn0) : z4, nx);
                float o[8];
#pragma unroll
                for (int e = 0; e < 8; ++e) { const float* cwp = P.ssd_conv_w + (size_t)layer * 3 * 768 + ch1; const float t = pass ? cwp[e] * pv[e] + cwp[768 + e] * cu[e] + cwp[1536 + e] * nx[e] + P.ssd_conv_b[(size_t)layer * 768 + ch1 + e] : cw0[0][e] * pv[e] + cw0[1][e] * cu[e] + cw0[2][e] * nx[e] + cb0[e]; o[e] = siluf_(t); }
                *(u32x4*)(XBC + (size_t)r * 768 + ch0) = pack8(o); } }
        { const int ch0 = 8 * lane; float bq[8], c0[8], x0[8], c1[8], x1[8], c2[8], x2[8];
            unpack8(I.sb, bq); unpack8(I.sc1, c1); unpack8(I.sx1, x1); unpack8(hasprev ? I.sc0 : z4, c0); unpack8(hasprev ? I.sx0 : z4, x0); unpack8(hasnext ? I.sc2 : z4, c2); unpack8(hasnext ? I.sx2 : z4, x2);
            float o[8];
#pragma unroll
            for (int e = 0; e < 8; ++e) o[e] = bq[e] * (sw[0][e] * (c0[e] * x0[e]) + sw[1][e] * (c1[e] * x1[e]) + sw[2][e] * (c2[e] * x2[e]));
            *(u32x4*)(YC + (size_t)r * 512 + ch0) = pack8(o); }
    }
}

constexpr int XS_LD = 272;
constexpr int BS_LD = 80;
typedef short v4i16_t __attribute__((ext_vector_type(4)));
typedef short s16x4 __attribute__((ext_vector_type(4)));
DI s16x4 tr_read(const LAS bf16_t* p) { return __builtin_bit_cast(s16x4, __builtin_amdgcn_ds_read_tr16_b64_v4i16((LAS v4i16_t*)p)); }
DI bf16x8 cat8(s16x4 lo, s16x4 hi) { return __builtin_shufflevector(lo, hi, 0, 1, 2, 3, 4, 5, 6, 7); }
DI bf16x8 scale8(const bf16x8 vv, const float (&w)[8]) { float f[8]; unpack8(__builtin_bit_cast(u32x4, vv), f);
#pragma unroll
    for (int e = 0; e < 8; ++e) f[e] *= w[e];
    return __builtin_bit_cast(bf16x8, pack8(f)); }
DI bf16x8 scale8s(const u32x4 v, float w) { float f[8]; unpack8(v, f);
#pragma unroll
    for (int e = 0; e < 8; ++e) f[e] *= w;
    return __builtin_bit_cast(bf16x8, pack8(f)); }
DI void ssd_stage_rows(const bf16_t* src, int ld, int nch8, LAS bf16_t* dst, int dld, int tid, int nload) {
    for (int i = 0; i < nload; ++i) { const int q = tid + 512 * i; const int s = q / nch8, ch0 = (q % nch8) * 8;
        *(LAS u32x4*)(dst + s * dld + ch0) = *(const u32x4*)(src + (size_t)s * ld + ch0); }
}

DI void ssd_a(const Params& P, const Tctx& T0, unsigned char* lds_, int layer) { const Tctx T = opaque_ctx(T0);
    const bf16_t* XBC = (const bf16_t*)(P.ws + WS_XBC); const float* DT = (const float*)(P.ws + WS_DT); float* ACS = (float*)(P.ws + WS_ACS); float* ST = (float*)(P.ws + WS_ST);
    LAS bf16_t* XR = (LAS bf16_t*)lds_; LAS bf16_t* BR = (LAS bf16_t*)(lds_ + 69632); LAS float* lw = (LAS float*)(lds_ + 69632 + 20480);
    const int lane = T.lane, w = T.wave, r = lane & 31, hb = lane >> 5, qq = (lane & 15) >> 2, pp = lane & 3, blk = (lane >> 4) & 1;
    for (int u = T.blk; u < NBATCH * NCH * 4; u += T.G) {
        const int dir = u & 1, g = (u >> 1) & 1, c = (u >> 2) % NCH, b = u / (4 * NCH); const int r0 = b * TPB + c * 128;
        const int hh = w & 3, ph = w >> 2, h = 4 * g + hh, dh = dir * 8 + h;
        if (w < 4) { const float a = -__expf(P.ssd_a_log[layer * 16 + dh]); const int l0 = 2 * lane;
          const float d0 = DT[(size_t)(r0 + l0) * 16 + dh], d1 = DT[(size_t)(r0 + l0 + 1) * 16 + dh]; const float v0 = d0 * a, v1 = d1 * a; const float sm = v0 + v1; float Pf = sm;
#pragma unroll
          for (int o = 1; o < 64; o <<= 1) { const float t = __shfl_up(Pf, o); if (lane >= o) Pf += t; }
          const float tot = __shfl(Pf, 63); float a0, a1;
          if (dir == 0) { a0 = Pf - v1; a1 = Pf; } else { const float S = tot - Pf + sm; a0 = S; a1 = S - v0; }
          ACS[(size_t)(r0 + l0) * 16 + dh] = a0; ACS[(size_t)(r0 + l0 + 1) * 16 + dh] = a1;
          lw[hh * 128 + l0] = __expf(tot - a0) * d0; lw[hh * 128 + l0 + 1] = __expf(tot - a1) * d1; }
        ssd_stage_rows(XBC + (size_t)r0 * 768 + 256 * g, 768, 32, XR, XS_LD, T.tid, 8);
        ssd_stage_rows(XBC + (size_t)r0 * 768 + 512 + 64 * g, 768, 8, BR, BS_LD, T.tid, 2);
        __syncthreads();
        f32x16 acc[2];
#pragma unroll
        for (int j = 0; j < 2; ++j)
#pragma unroll
            for (int q = 0; q < 16; ++q) acc[j][q] = 0.f;
#pragma unroll 2
        for (int kk = 0; kk < 8; ++kk) { float wv[8]; { const f32x4 w0 = *(const LAS f32x4*)(lw + hh * 128 + 16 * kk + 8 * hb), w1 = *(const LAS f32x4*)(lw + hh * 128 + 16 * kk + 8 * hb + 4);
                wv[0] = w0.x; wv[1] = w0.y; wv[2] = w0.z; wv[3] = w0.w; wv[4] = w1.x; wv[5] = w1.y; wv[6] = w1.z; wv[7] = w1.w; }
            const int rb = 16 * kk + 8 * hb + qq;
            const LAS bf16_t* xa = XR + rb * XS_LD + 64 * hh + 32 * ph + 16 * blk + 4 * pp;
            const bf16x8 af = scale8(cat8(tr_read(xa), tr_read(xa + 4 * XS_LD)), wv);
#pragma unroll
            for (int nt = 0; nt < 2; ++nt) { const LAS bf16_t* ba = BR + rb * BS_LD + 32 * nt + 16 * blk + 4 * pp;
                const bf16x8 bfr = cat8(tr_read(ba), tr_read(ba + 4 * BS_LD)); acc[nt] = MFMA32(af, bfr, acc[nt]); } }
        float* st = ST + ((((size_t)dir * NBATCH + b) * NCH + c) * 8 + h) * 4096;
#pragma unroll
        for (int nt = 0; nt < 2; ++nt)
#pragma unroll
            for (int i = 0; i < 16; ++i) st[(32 * ph + crow(i, hb)) * 64 + 32 * nt + r] = acc[nt][i];
        __syncthreads();
    }
}
DI void ssd_b(const Params& P, const Tctx& T0) { const Tctx T = opaque_ctx(T0);
    float* ST = (float*)(P.ws + WS_ST); const float* ACS = (const float*)(P.ws + WS_ACS);
    for (int e = T.blk * 512 + T.tid; e < 2 * NBATCH * 8 * 4096; e += T.G * 512) {
        const int pn = e & 4095, h = (e >> 12) & 7, b = (e >> 15) & 3, dir = e >> 17;
        float* base = ST + (((size_t)dir * NBATCH + b) * NCH * 8 + h) * 4096 + pn;
        const float* ab = ACS + (size_t)(b * TPB + (dir == 0 ? 127 : 0)) * 16 + dir * 8 + h;
        float st[NCH], dec[NCH];
#pragma unroll
        for (int c = 0; c < NCH; ++c) { st[c] = base[(size_t)c * 8 * 4096]; dec[c] = ab[(size_t)c * 128 * 16]; }
        float hs = 0.f;
        if (dir == 0) {
#pragma unroll
            for (int c = 0; c < NCH; ++c) { base[(size_t)c * 8 * 4096] = hs; hs = __expf(dec[c]) * hs + st[c]; }
        } else {
            base[(size_t)1 * 8 * 4096] = hs; hs = __expf(dec[1]) * hs + st[1];
            base[0] = hs; hs = __expf(dec[0]) * hs + st[0];
#pragma unroll
            for (int c = NCH - 1; c >= 2; --c) { base[(size_t)c * 8 * 4096] = hs; hs = __expf(dec[c]) * hs + st[c]; }
        }
    }
}
DI void ssd_c(const Params& P, const Tctx& T0, unsigned char* lds_, int layer) { const Tctx T = opaque_ctx(T0);
    const bf16_t* XBC = (const bf16_t*)(P.ws + WS_XBC); const float* DT = (const float*)(P.ws + WS_DT); const float* ACS = (const float*)(P.ws + WS_ACS); const float* ST = (const float*)(P.ws + WS_ST);
    bf16_t* YRAW = (bf16_t*)(P.ws + WS_YRAW);
    LAS bf16_t* XR = (LAS bf16_t*)lds_; LAS float* bfw = (LAS float*)(lds_ + 69632); LAS float* lacs = (LAS float*)(lds_ + 69632 + 4096);
    const int lane = T.lane, w = T.wave, r = lane & 31, hb = lane >> 5, qq = (lane & 15) >> 2, pp = lane & 3, blk = (lane >> 4) & 1;
    for (int u = T.blk; u < NBATCH * NCH * 4; u += T.G) {
        const int half = u & 1, g = (u >> 1) & 1, c = (u >> 2) % NCH, b = u / (4 * NCH); const int r0 = b * TPB + c * 128;
        const int hh = w & 3, h = 4 * g + hh, l0 = 64 * half + 32 * (w >> 2), l = l0 + r;
        for (int i = T.tid; i < 1024; i += 512) { const int ll = i & 127, dd = (i >> 7) & 1, h4 = i >> 8; const size_t o = (size_t)(r0 + ll) * 16 + dd * 8 + 4 * g + h4;
            const float a = ACS[o]; lacs[i] = a; bfw[i] = a - __logf(DT[o]); }
        ssd_stage_rows(XBC + (size_t)r0 * 768 + 256 * g, 768, 32, XR, XS_LD, T.tid, 8);
        __syncthreads();
        const float af_l = lacs[(hh * 2) * 128 + l], ab_l = lacs[(hh * 2 + 1) * 128 + l]; const float Dh = P.ssd_d[layer * 8 + h];
        const bf16_t* Cg = XBC + (size_t)r0 * 768 + 640 + 64 * g; const bf16_t* Bg = XBC + (size_t)r0 * 768 + 512 + 64 * g;
        f32x16 gt[4];
#pragma unroll
        for (int j = 0; j < 4; ++j)
#pragma unroll
            for (int q = 0; q < 16; ++q) gt[j][q] = 0.f;
#pragma unroll
        for (int kk = 0; kk < 4; ++kk) { const bf16x8 cfr = *(const bf16x8*)(Cg + (size_t)l * 768 + 16 * kk + 8 * hb);
#pragma unroll
            for (int js = 0; js < 4; ++js) { const bf16x8 bfr = *(const bf16x8*)(Bg + (size_t)(32 * js + r) * 768 + 16 * kk + 8 * hb); gt[js] = MFMA32(bfr, cfr, gt[js]); } }
        f32x16 y[2];
#pragma unroll
        for (int pt = 0; pt < 2; ++pt)
#pragma unroll
            for (int q = 0; q < 16; ++q) y[pt][q] = 0.f;
#pragma unroll
        for (int js = 0; js < 4; ++js) {
#pragma unroll
            for (int q = 0; q < 4; ++q) { const int s0 = 32 * js + 8 * q + 4 * hb;
                const f32x4 f4 = *(const LAS f32x4*)(bfw + (hh * 2) * 128 + s0), b4 = *(const LAS f32x4*)(bfw + (hh * 2 + 1) * 128 + s0);
#pragma unroll
                for (int e = 0; e < 4; ++e) { const int sx = s0 + e; const float argf = (sx <= l) ? af_l - f4[e] : -INFINITY, argb = (sx >= l) ? ab_l - b4[e] : -INFINITY;
                    gt[js][4 * q + e] = gt[js][4 * q + e] * (__expf(argf) + __expf(argb)) + (sx == l ? Dh : 0.f); } }
#pragma unroll
            for (int ks = 0; ks < 2; ++ks) { u32x4 pk; pk.x = pk2(gt[js][8 * ks], gt[js][8 * ks + 1]); pk.y = pk2(gt[js][8 * ks + 2], gt[js][8 * ks + 3]); pk.z = pk2(gt[js][8 * ks + 4], gt[js][8 * ks + 5]); pk.w = pk2(gt[js][8 * ks + 6], gt[js][8 * ks + 7]);
                const bf16x8 wfr = __builtin_bit_cast(bf16x8, pk); const int rb = 32 * js + 16 * ks + 4 * hb + qq;
#pragma unroll
                for (int pt = 0; pt < 2; ++pt) { const LAS bf16_t* xa = XR + rb * XS_LD + 64 * hh + 32 * pt + 16 * blk + 4 * pp;
                    y[pt] = MFMA32(cat8(tr_read(xa), tr_read(xa + 8 * XS_LD)), wfr, y[pt]); } } }
#pragma unroll 1
        for (int dd = 0; dd < 2; ++dd) { const float el = __expf(dd ? ab_l : af_l);
            const float* hs = ST + ((((size_t)dd * NBATCH + b) * NCH + c) * 8 + h) * 4096;
#pragma unroll
            for (int kk = 0; kk < 4; ++kk) { const bf16x8 cfr = scale8s(*(const u32x4*)(Cg + (size_t)l * 768 + 16 * kk + 8 * hb), el);
#pragma unroll
                for (int pt = 0; pt < 2; ++pt) { const float* hp = hs + (32 * pt + r) * 64 + 16 * kk + 8 * hb; const f32x4 h0 = *(const f32x4*)hp, h1 = *(const f32x4*)(hp + 4);
                    u32x4 pkd; pkd.x = pk2(h0.x, h0.y); pkd.y = pk2(h0.z, h0.w); pkd.z = pk2(h1.x, h1.y); pkd.w = pk2(h1.z, h1.w);
                    y[pt] = MFMA32(__builtin_bit_cast(bf16x8, pkd), cfr, y[pt]); } } }
        { const bf16_t* zr = (const bf16_t*)(P.ws + WS_PROJ) + (size_t)(r0 + l) * NP + PZ + h * 64; const float* nw = P.ssd_norm + layer * 512 + h * 64;
          bf16_t* yo = (bf16_t*)(P.ws + WS_YS) + (size_t)(r0 + l) * 512 + h * 64; float ss = 0.f;
#pragma unroll
          for (int pt = 0; pt < 2; ++pt)
#pragma unroll
            for (int q = 0; q < 4; ++q) { const int po = 32 * pt + 8 * q + 4 * hb; const u32x2 zz = *(const u32x2*)(zr + po); const f32x4 wv = *(const f32x4*)(nw + po);
                const float t0 = y[pt][4 * q] * siluf_(bflo(zz.x)), t1 = y[pt][4 * q + 1] * siluf_(bfhi(zz.x)), t2 = y[pt][4 * q + 2] * siluf_(bflo(zz.y)), t3 = y[pt][4 * q + 3] * siluf_(bfhi(zz.y));
                ss += (t0 * t0 + t1 * t1) + (t2 * t2 + t3 * t3);
                u32x2 o; o.x = pk2(t0 * wv.x, t1 * wv.y); o.y = pk2(t2 * wv.z, t3 * wv.w); *(u32x2*)(yo + po) = o; }
          ss = swap32_add(ss, ss);
          if (hb == 0) atomicAdd((float*)(P.ws + WS_SSQ) + (r0 + l), ss); }
        __syncthreads();
    }
}
DI void ys_finalize(const Params& P, const Tctx& T0, int layer) { const Tctx T = opaque_ctx(T0);
    const bf16_t* YRAW = (const bf16_t*)(P.ws + WS_YRAW); const bf16_t* PROJ = (const bf16_t*)(P.ws + WS_PROJ); bf16_t* YS = (bf16_t*)(P.ws + WS_YS);
    for (int r = T.gw; r < MR; r += T.NGW) {
        if (layer == 1 && (r % TPB) < CTXL) continue;
        float y[8], z[8]; unpack8(*(const u32x4*)(YRAW + (size_t)r * 512 + 8 * T.lane), y); unpack8(*(const u32x4*)(PROJ + (size_t)r * NP + PZ + 8 * T.lane), z);
        float ss = 0.f;
#pragma unroll
        for (int e = 0; e < 8; ++e) { y[e] *= siluf_(z[e]); ss += y[e] * y[e]; }
        const float rstd = rsqrtf(wave_sum(ss) * (1.f / 512.f) + EPSF); const float* nw = P.ssd_norm + layer * 512 + 8 * T.lane;
#pragma unroll
        for (int e = 0; e < 8; ++e) y[e] = y[e] * rstd * nw[e];
        *(u32x4*)(YS + (size_t)r * 512 + 8 * T.lane) = pack8(y);
    }
}

DI float softmax16(float lg) { const float mx = wave_max(lg); const float ex = expf(lg - mx); return ex / (wave_sum(ex) * 0.25f); }
DI void p7_ln_router(const Params& P, const Tctx& T0, unsigned char* lds, int layer) { const Tctx T = opaque_ctx(T0);
    LAS float* Wl = (LAS float*)lds;
    stage_w16(Wl, P.w_router + (size_t)layer * 1024 * 16, 16, T.tid);
    __syncthreads();
    const float* modv = (const float*)(P.ws + WS_MODV) + (size_t)layer * 5 * 6144;
    float* X1 = (float*)(P.ws + WS_X1); bf16_t* H = (bf16_t*)(P.ws + WS_H); float* AFF = (float*)(P.ws + WS_AFF);
    f32x4 g1v[4], b1v[4];
#pragma unroll
    for (int j = 0; j < 4; ++j) { g1v[j] = *((const f32x4*)(P.ln1_g + layer * 1024) + T.lane + 64 * j); b1v[j] = *((const f32x4*)(P.ln1_b + layer * 1024) + T.lane + 64 * j); }
    const int jl = lane_j16(T.lane);
    int r0 = T.gw; if (layer == 1 && (r0 % TPB) < CTXL) r0 += ((CTXL - (r0 % TPB) + T.NGW - 1) / T.NGW) * T.NGW;
    f32x4 pend[4]; int pr = -1;
#pragma unroll
    for (int j = 0; j < 4; ++j) pend[j] = (f32x4){0.f, 0.f, 0.f, 0.f};
    f32x4 nv[4]; int nr = r0; if (r0 < MR) load_row(X1 + (size_t)r0 * DMODEL, T.lane, nv);
    for (int r = r0; r < MR; r = nr) {
        int b, p; row_bp(r, b, p); const int mrow = p < CTXL ? 4 : b;
        f32x4 v[4];
#pragma unroll
        for (int j = 0; j < 4; ++j) v[j] = nv[j];
        { int rn = r + T.NGW; if (layer == 1 && rn < MR && (rn % TPB) < CTXL) rn += ((CTXL - (rn % TPB) + T.NGW - 1) / T.NGW) * T.NGW; if (rn < MR) load_row(X1 + (size_t)rn * DMODEL, T.lane, nv); nr = rn; }
        ln_norm(v);
#pragma unroll
        for (int j = 0; j < 4; ++j) v[j] = v[j] * g1v[j] + b1v[j];
        store_row(X1 + (size_t)r * DMODEL, T.lane, v);
        ln_norm(v); const float* mv = modv + (size_t)mrow * 6144;
#pragma unroll
        for (int j = 0; j < 4; ++j) { const f32x4 sh = *((const f32x4*)(mv + 3072) + T.lane + 64 * j), sc = *((const f32x4*)(mv + 4096) + T.lane + 64 * j); v[j] = v[j] * (sc + 1.f) + sh; }
        store_row_bf16(H + (size_t)r * DMODEL, T.lane, v);
        if (pr < 0) { pr = r;
#pragma unroll
            for (int j = 0; j < 4; ++j) pend[j] = v[j]; }
        else { float sa[16], sb[16]; row_dot16x2(pend, v, Wl, T.lane, sa, sb);
            const float pa = softmax16(reduce16(sa, T.lane)), pb = softmax16(reduce16(sb, T.lane));
            if ((T.lane & 3) == 0) { AFF[(size_t)pr * 16 + jl] = pa; AFF[(size_t)r * 16 + jl] = pb; }
            pr = -1; }
    }
    if (pr >= 0) { float s[16]; row_dot16(pend, Wl, T.lane, s); const float pa = softmax16(reduce16(s, T.lane));
        if ((T.lane & 3) == 0) AFF[(size_t)pr * 16 + jl] = pa; }
    __syncthreads();
}

DI unsigned block_scan_excl(unsigned v, LAS unsigned* wt, int lane, int wave, unsigned& total) {
    unsigned inc = v;
#pragma unroll
    for (int o = 1; o < 64; o <<= 1) { const unsigned t = __shfl_up(inc, o); if (lane >= o) inc += t; }
    if (lane == 63) wt[wave] = inc;
    __syncthreads();
    unsigned off = 0, tot = 0;
#pragma unroll
    for (int q = 0; q < 8; ++q) { const unsigned t = wt[q]; if (q < wave) off += t; tot += t; }
    __syncthreads();
    total = tot; return off + inc - v;
}
DI void p8_topk(const Params& P, const Tctx& T0, unsigned char* lds_, int layer) { const Tctx T = opaque_ctx(T0);
    const float* AFF = (const float*)(P.ws + WS_AFF); int* SLOT = (int*)(P.ws + WS_SLOT); float* AFFSEL = (float*)(P.ws + WS_AFFSEL);
    const bf16_t* H = (const bf16_t*)(P.ws + WS_H); bf16_t* XS = (bf16_t*)(P.ws + WS_XS);
    LAS unsigned* cnt = (LAS unsigned*)lds_; LAS unsigned* wt = cnt + 16; LAS int* rows = (LAS int*)(cnt + 32);
    const int ntask = layer == 0 ? 128 : 64;
    for (int task = T.blk; task < ntask; task += T.G) {
        const int set = task >> 6, tt = task & 63, b = tt >> 4, e = tt & 15; const int n = set ? CTXL : SEQL, k = set ? 32 : 512;
        const int rowbase = b * TPB + (set ? 0 : CTXL), slotbase = set ? 2048 + b * 32 : b * 512;
        unsigned key[8];
#pragma unroll
        for (int j = 0; j < 8; ++j) { const int idx = T.tid * 8 + j; key[j] = idx < n ? __float_as_uint(AFF[(size_t)(rowbase + idx) * 16 + e]) : 0u; }
        unsigned prefix = 0;
        for (int bit = 29; bit >= 0; --bit) { const unsigned cand = prefix | (1u << bit); int c = 0;
#pragma unroll
            for (int j = 0; j < 8; ++j) c += __popcll(__ballot(key[j] >= cand));
            if (T.lane == 0) cnt[(bit & 1) * 8 + T.wave] = (unsigned)c;
            __syncthreads();
            unsigned tot = 0;
#pragma unroll
            for (int q = 0; q < 8; ++q) tot += cnt[(bit & 1) * 8 + q];
            if ((int)tot >= k) prefix = cand; }
        unsigned cg_ = 0, ce_ = 0;
#pragma unroll
        for (int j = 0; j < 8; ++j) { cg_ += key[j] > prefix ? 1u : 0u; ce_ += key[j] == prefix ? 1u : 0u; }
        unsigned total; const unsigned ex1 = block_scan_excl((ce_ << 16) | cg_, wt, T.lane, T.wave, total);
        const int need_eq = k - (int)(total & 0xffffu); int eq_rank = (int)(ex1 >> 16);
        unsigned selm = 0, nsel = 0;
#pragma unroll
        for (int j = 0; j < 8; ++j) { bool s = key[j] > prefix; if (key[j] == prefix) { s = eq_rank < need_eq; ++eq_rank; } if (s) { selm |= 1u << j; ++nsel; } }
        unsigned tot2; unsigned pos = block_scan_excl(nsel, wt, T.lane, T.wave, tot2);
#pragma unroll
        for (int j = 0; j < 8; ++j) { const int idx = T.tid * 8 + j; if (idx < n) { const int r = rowbase + idx;
                if (selm & (1u << j)) { const int slot = slotbase + (int)pos; SLOT[(size_t)r * 16 + e] = slot; AFFSEL[e * ESTR + slot] = __uint_as_float(key[j]); rows[pos] = r; ++pos; }
                else SLOT[(size_t)r * 16 + e] = -1; } }
        __syncthreads();
        { int* IDX = (int*)(P.ws + WS_IDX) + e * ESTR;
          for (int s = T.tid; s < k; s += 512) IDX[slotbase + s] = rows[s];
          if (set == 1 && b == 0 && T.tid < 128) IDX[2176 + T.tid] = 0; }
        __syncthreads();
    }
}

DI void p11_combine(const Params& P, const Tctx& T0, unsigned char* lds, int layer) { const Tctx T = opaque_ctx(T0);
    const bool fuse = layer + 1 < NLAYER;
    LAS float* Wl = (LAS float*)lds;
    if (fuse) { stage_w16(Wl, P.w_in + (size_t)(layer + 1) * 1024 * IN_COLS + 1024, IN_COLS, T.tid); __syncthreads(); }
    const float* modn = (const float*)(P.ws + WS_MODV) + (size_t)(layer + 1) * 5 * 6144; bf16_t* H = (bf16_t*)(P.ws + WS_H); float* DT = (float*)(P.ws + WS_DT);
    const int jl = lane_j16(T.lane); const float dtb = fuse ? P.ssd_dt_bias[(layer + 1) * 16 + jl] : 0.f;
    const float* X1 = (const float*)(P.ws + WS_X1); const int* SLOT = (const int*)(P.ws + WS_SLOT); const bf16_t* Y = (const bf16_t*)(P.ws + WS_XS);
    const float* modv = (const float*)(P.ws + WS_MODV) + (size_t)layer * 5 * 6144; float* XA = (float*)(P.ws + WS_XA);
    f32x4 g2v[4], b2v[4];
#pragma unroll
    for (int j = 0; j < 4; ++j) { g2v[j] = *((const f32x4*)(P.ln2_g + layer * 1024) + T.lane + 64 * j); b2v[j] = *((const f32x4*)(P.ln2_b + layer * 1024) + T.lane + 64 * j); }
    const bool skipc = layer == 1;
    int r = row_skip(T.gw, T.NGW, skipc);
    f32x4 pend[4]; int pr = -1;
#pragma unroll
    for (int j = 0; j < 4; ++j) pend[j] = (f32x4){0.f, 0.f, 0.f, 0.f};
    f32x4 nv[4]; int nsl = -1;
    if (r < MR) { load_row(X1 + (size_t)r * DMODEL, T.lane, nv); nsl = SLOT[(size_t)r * 16 + (T.lane & 15)]; }
    while (r < MR) {
        int b, p; row_bp(r, b, p); const int mrow = p < CTXL ? 4 : b;
        f32x4 v[4], acc[4]; const int sl = nsl;
#pragma unroll
        for (int j = 0; j < 4; ++j) { v[j] = nv[j]; acc[j] = (f32x4){0.f, 0.f, 0.f, 0.f}; }
        const int rn = row_skip(r + T.NGW, T.NGW, skipc);
        if (rn < MR) { load_row(X1 + (size_t)rn * DMODEL, T.lane, nv); nsl = SLOT[(size_t)rn * 16 + (T.lane & 15)]; }
        unsigned mask = (unsigned)__ballot(T.lane < 16 && sl >= 0) & 0xffffu;
        while (mask) {
            const int e0 = __builtin_ctz(mask); mask &= mask - 1; const bool two = mask != 0; const int e1 = two ? __builtin_ctz(mask) : e0; if (two) mask &= mask - 1;
            const int s0 = __builtin_amdgcn_readlane(sl, e0), s1 = __builtin_amdgcn_readlane(sl, e1);
            const bf16_t* y0 = Y + ((size_t)e0 * ESTR + s0) * DMODEL; const bf16_t* y1 = Y + ((size_t)e1 * ESTR + s1) * DMODEL;
            u32x2 w0[4], w1[4];
#pragma unroll
            for (int j = 0; j < 4; ++j) { w0[j] = *((const u32x2*)y0 + T.lane + 64 * j); w1[j] = *((const u32x2*)y1 + T.lane + 64 * j); }
            const float f1 = two ? 1.f : 0.f;
#pragma unroll
            for (int j = 0; j < 4; ++j) { acc[j].x += bflo(w0[j].x) + f1 * bflo(w1[j].x); acc[j].y += bfhi(w0[j].x) + f1 * bfhi(w1[j].x); acc[j].z += bflo(w0[j].y) + f1 * bflo(w1[j].y); acc[j].w += bfhi(w0[j].y) + f1 * bfhi(w1[j].y); }
            if (layer == 0 && p < CTXL) {
                const bf16_t* YP = (const bf16_t*)(P.ws + WS_Q);
#pragma unroll 1
                for (int ks = 0; ks < 3; ++ks) { const bf16_t* q0 = YP + ((size_t)ks * 4096 + e0 * 256 + (s0 - 2048)) * DMODEL; const bf16_t* q1 = YP + ((size_t)ks * 4096 + e1 * 256 + (s1 - 2048)) * DMODEL;
#pragma unroll
                    for (int j = 0; j < 4; ++j) { const u32x2 a0 = *((const u32x2*)q0 + T.lane + 64 * j), a1 = *((const u32x2*)q1 + T.lane + 64 * j);
                        acc[j].x += bflo(a0.x) + f1 * bflo(a1.x); acc[j].y += bfhi(a0.x) + f1 * bfhi(a1.x); acc[j].z += bflo(a0.y) + f1 * bflo(a1.y); acc[j].w += bfhi(a0.y) + f1 * bfhi(a1.y); } } }
        }
        const float* m5 = modv + (size_t)mrow * 6144 + 5 * 1024;
#pragma unroll
        for (int j = 0; j < 4; ++j) v[j] = v[j] * ALPHA_F + *((const f32x4*)m5 + T.lane + 64 * j) * acc[j];
        ln_norm(v);
#pragma unroll
        for (int j = 0; j < 4; ++j) v[j] = v[j] * g2v[j] + b2v[j];
        float* dst = (layer == 0) ? XA + (size_t)r * DMODEL : P.out + ((size_t)b * SEQL + (p - CTXL)) * DMODEL;
        store_row(dst, T.lane, v);
        if (fuse) { ln_norm(v); const float* mv = modn + (size_t)mrow * 6144;
#pragma unroll
            for (int j = 0; j < 4; ++j) { const f32x4 sh = *((const f32x4*)mv + T.lane + 64 * j), sc = *((const f32x4*)(mv + 1024) + T.lane + 64 * j); v[j] = v[j] * (sc + 1.f) + sh; }
            store_row_bf16(H + (size_t)r * DMODEL, T.lane, v);
            if (pr < 0) { pr = r;
#pragma unroll
                for (int j = 0; j < 4; ++j) pend[j] = v[j]; }
            else { float sa[16], sb[16]; row_dot16x2(pend, v, Wl, T.lane, sa, sb);
                const float xa = reduce16(sa, T.lane) + dtb, xb = reduce16(sb, T.lane) + dtb;
                if ((T.lane & 3) == 0) { DT[(size_t)pr * 16 + jl] = xa > 20.f ? xa : __logf(1.f + __expf(xa)); DT[(size_t)r * 16 + jl] = xb > 20.f ? xb : __logf(1.f + __expf(xb)); }
                pr = -1; } }
        r = rn;
    }
    if (fuse && pr >= 0) { float sd[16]; row_dot16(pend, Wl, T.lane, sd); const float xx = reduce16(sd, T.lane) + dtb;
        if ((T.lane & 3) == 0) DT[(size_t)pr * 16 + jl] = xx > 20.f ? xx : __logf(1.f + __expf(xx)); }
    if (fuse) __syncthreads();
}

#define RLX_AGENT __ATOMIC_RELAXED, __HIP_MEMORY_SCOPE_AGENT
#define XB_TMO      128
#define XB_XCNT(j)  (256  + 64 * (j))
#define XB_XSUB(j)  (1280 + 64 * (j))
#define XB_XGEN(j)  (2304 + 64 * (j))
#define XB_TOP      3328
#define XB_TOPGEN   3392
#define XCD_BAR_WORDS 3456
#define XB_SPIN_CAP (1u << 18)

__device__ __forceinline__ unsigned xb_ld(unsigned* p)              { return __hip_atomic_load(p, __ATOMIC_RELAXED, __HIP_MEMORY_SCOPE_AGENT); }
__device__ __forceinline__ unsigned xb_add(unsigned* p, unsigned v) { return __hip_atomic_fetch_add(p, v, __ATOMIC_RELAXED, __HIP_MEMORY_SCOPE_AGENT); }
__device__ __forceinline__ unsigned xb_xcc_id() { return (unsigned)__builtin_amdgcn_s_getreg((3 << 11) | 20) & 0xFu; }
#define XB_SPIN(cond, bar) do { unsigned _sp = 0; while (cond) { __builtin_amdgcn_s_sleep(1); \
    if ((++_sp & 255u) == 0u) { if (xb_ld(&(bar)[XB_TMO])) break; if (_sp > XB_SPIN_CAP) { atomicAdd(&(bar)[XB_TMO], 1u); break; } } } } while (0)

struct XcdBarrier {
    unsigned* bar; unsigned x;
    volatile LAS unsigned* st;
};

__device__ __forceinline__ XcdBarrier xcd_barrier_post(unsigned* bar, volatile LAS unsigned* st) {
    XcdBarrier b; b.bar = bar; b.x = xb_xcc_id(); b.st = st;
    if (threadIdx.x == 0) (void)xb_add(&bar[XB_XCNT(b.x)], 1u);
    return b;
}
__device__ __forceinline__ void xcd_barrier_complete(unsigned* bar, unsigned x, unsigned& nloc, unsigned& nx) {
    const unsigned G = gridDim.x * gridDim.y * gridDim.z;
    unsigned sum, cnt, mine, sp = 0u;
    for (;;) {
        sum = 0u; cnt = 0u; mine = 0u;
#pragma unroll
        for (unsigned j = 0; j < 16; ++j) { const unsigned c = xb_ld(&bar[XB_XCNT(j)]); sum += c; cnt += (c > 0u) ? 1u : 0u; mine = (j == x) ? c : mine; }
        if (sum == G) break;
        __builtin_amdgcn_s_sleep(1);
        if ((++sp & 255u) == 0u) { if (xb_ld(&bar[XB_TMO])) break; if (sp > XB_SPIN_CAP) { atomicAdd(&bar[XB_TMO], 1u); break; } }
    }
    nloc = mine > 0u ? mine : 1u; nx = cnt > 0u ? cnt : 1u;
}

__device__ __forceinline__ void xcd_barrier(const XcdBarrier& b) {
    asm volatile("s_waitcnt vmcnt(0)" ::: "memory");
    __syncthreads();
    if (threadIdx.x == 0) {
        unsigned* bar = b.bar;
        __builtin_amdgcn_s_waitcnt(0);
        unsigned nloc = b.st[0], nx = b.st[1];
        if (nloc == 0u) { xcd_barrier_complete(bar, b.x, nloc, nx); b.st[0] = nloc; b.st[1] = nx; }
        const unsigned old = xb_add(&bar[XB_XSUB(b.x)], 1u);
        const unsigned gen = old / nloc;
        if (old + 1u == (gen + 1u) * nloc) {
            __builtin_amdgcn_fence(__ATOMIC_RELEASE, "agent");
            asm volatile("s_waitcnt vmcnt(0)" ::: "memory");
            const unsigned og = xb_add(&bar[XB_TOP], 1u);
            const unsigned tg = og / nx;
            if (og + 1u == (tg + 1u) * nx) xb_add(&bar[XB_TOPGEN], 1u);
            else XB_SPIN(xb_ld(&bar[XB_TOPGEN]) == tg, bar);
            __builtin_amdgcn_fence(__ATOMIC_ACQUIRE, "agent");
            xb_add(&bar[XB_XGEN(b.x)], 1u);
            asm volatile("s_waitcnt vmcnt(0)" ::: "memory");
        } else {
            XB_SPIN(xb_ld(&bar[XB_XGEN(b.x)]) == gen, bar);
            __builtin_amdgcn_fence(__ATOMIC_ACQUIRE, "agent");
            asm volatile("s_waitcnt vmcnt(0)" ::: "memory");
        }
    }
    __syncthreads();
}


#ifndef REP_MASK
#define REP_MASK 0
#endif
#ifndef EXTRA_SYNC
#define EXTRA_SYNC 0
#endif
#define WIN ((const bf16_t*)(P.ws + WS_WIN) + (size_t)layer * NP * 1024)
#define WBR ((const bf16_t*)(P.ws + WS_WBR) + (size_t)layer * 3 * 1024 * 512)
#define WO ((const bf16_t*)(P.ws + WS_WO) + (size_t)layer * 1024 * 1024)
#define WGU ((const bf16_t*)(P.ws + WS_WGU) + (size_t)layer * NEXP * 4096 * 1024)
#define WD ((const bf16_t*)(P.ws + WS_WD) + (size_t)layer * NEXP * 1024 * 2048)
#define modv ((const float*)(P.ws + WS_MODV) + (size_t)layer * 5 * 6144)
typedef const __attribute__((address_space(4))) Params* KParams;
#ifdef TIME_A
#define STAMP(idx_) do { if (T0.blk == 0 && T0.tid == 0) ((volatile LAS unsigned long long*)(ldsl + 143616))[(idx_)] = __builtin_amdgcn_s_memrealtime(); } while (0)
#else
#define STAMP(idx_) do { } while (0)
#endif
#define SEAM(last_) do { if (!(last_)) { XcdBarrier bar = bar0; asm volatile("" : "+s"(bar.bar)); xcd_barrier(bar); for (int xs_ = 0; xs_ < EXTRA_SYNC; ++xs_) xcd_barrier(bar); } } while (0)
template <int layer> DI void run_layer(KParams Pk, const Tctx& T0, unsigned char* lds, PG8_LAS unsigned char* ldsl, const XcdBarrier& bar0) {
    constexpr bool skipc = layer == NLAYER - 1;
    if constexpr (layer == 0)
    for (int rep_ = 0; rep_ <= ((REP_MASK >> 1) & 1); ++rep_) { KParams Pq = Pk; asm volatile("" : "+s"(Pq)); const Params& P = *(const Params*)Pq; const Tctx T = opaque_ctx(T0);
            p1_modulate(P, T, lds, layer);
    }
    if constexpr (layer == 0) { SEAM(false); } STAMP(layer * 14 + 1);
    for (int rep_ = 0; rep_ <= ((REP_MASK >> 2) & 1); ++rep_) { KParams Pq = Pk; asm volatile("" : "+s"(Pq)); const Params& P = *(const Params*)Pq; const Tctx T = opaque_ctx(T0);
            pg8::SchedInProj S; S.A = (const char*)(P.ws + WS_H); S.Bt = (const char*)WIN; S.G = T.G; S.c = T.blk;
            pg8::EpiStoreBf16 E{(bf16_t*)(P.ws + WS_PROJ), NP};
            pg8::gemm_phase<pg8::EpiStoreBf16, pg8::SchedInProj, true, true>(ldsl, 1024, S, E);
    }
    SEAM(layer == NLAYER - 1 && 2 == 14); STAMP(layer * 14 + 2);
    for (int rep_ = 0; rep_ <= ((REP_MASK >> 3) & 1); ++rep_) { KParams Pq = Pk; asm volatile("" : "+s"(Pq)); const Params& P = *(const Params*)Pq; const Tctx T = opaque_ctx(T0);
            p3_post(P, T, layer);
    }
    SEAM(layer == NLAYER - 1 && 3 == 14); STAMP(layer * 14 + 3);
    for (int rep_ = 0; rep_ <= ((REP_MASK >> 4) & 1); ++rep_) { KParams Pq = Pk; asm volatile("" : "+s"(Pq)); const Params& P = *(const Params*)Pq; const Tctx T = opaque_ctx(T0);
            ssd_a(P, T, lds, layer);
    }
    SEAM(layer == NLAYER - 1 && 4 == 14); STAMP(layer * 14 + 4);
    for (int rep_ = 0; rep_ <= ((REP_MASK >> 5) & 1); ++rep_) { KParams Pq = Pk; asm volatile("" : "+s"(Pq)); const Params& P = *(const Params*)Pq; const Tctx T = opaque_ctx(T0);
            ssd_b(P, T);
    }
    SEAM(layer == NLAYER - 1 && 5 == 14); STAMP(layer * 14 + 5);
    STAMP(layer * 14 + 6);
    for (int rep_ = 0; rep_ <= ((REP_MASK >> 7) & 1); ++rep_) { KParams Pq = Pk; asm volatile("" : "+s"(Pq)); const Params& P = *(const Params*)Pq; const Tctx T = opaque_ctx(T0);
            ssd_c(P, T, lds, layer);
            const attn_body::bf16* Qf = (const attn_body::bf16*)(P.ws + WS_Q); const attn_body::bf16* Kf = (const attn_body::bf16*)(P.ws + WS_K); const attn_body::bf16* Vf = (const attn_body::bf16*)(P.ws + WS_V);
            attn_body::bf16* YA = (attn_body::bf16*)(P.ws + WS_YA);
            __syncthreads();
            const int nu = skipc ? 512 : 544;
            const int nlat = (512 - T.blk + T.G - 1) / T.G;
            for (int it = 0; ; ++it) {
                int u = it * T.G + T.blk;
                if (it >= nlat) { const int v = ((T.blk - 32 % T.G + T.G) % T.G) + (it - nlat) * T.G; if (skipc || v >= 32) break; u = 512 + v; }
                long q0, k0; int nt, h;
                if (u < 512) { const int b = u >> 7, qb = u & 15; h = (u >> 4) & 7; q0 = (long)b * TPB + CTXL + qb * 256; k0 = (long)b * TPB; nt = TPB / 64; }
                else { const int v = u - 512, b = v >> 3; h = v & 7; q0 = (long)b * TPB; k0 = q0; nt = CTXL / 64; }
                attn_body::attn_unit<8>(q0, k0, nt, h, h >> 2, Qf, Kf, Vf, YA, (char*)lds); }
    }
    SEAM(layer == NLAYER - 1 && 7 == 14); STAMP(layer * 14 + 7);
    for (int rep_ = 0; rep_ <= ((REP_MASK >> 8) & 1); ++rep_) { KParams Pq = Pk; asm volatile("" : "+s"(Pq)); const Params& P = *(const Params*)Pq; const Tctx T = opaque_ctx(T0);
            pg8::SchedTok<3> S; S.A0 = (const char*)(P.ws + WS_YA); S.A1 = (const char*)(P.ws + WS_YS); S.A2 = (const char*)(P.ws + WS_YC); S.Bt = (const char*)WBR; S.KA = 512;
            S.ntile = skipc ? 256 : 272; S.skip_ctx = skipc; S.G = T.G; S.c = (T.G % 8 == 0) ? (T.blk % 8) * (T.G / 8) + T.blk / 8 : T.blk;
            pg8::EpiMerge E{(const bf16_t*)(P.ws + WS_PROJ), (bf16_t*)(P.ws + WS_M), (const float*)(P.ws + WS_SSQ), (bf16_t*)(P.ws + WS_X1) + (size_t)T.blk * 131072};
            pg8::gemm_phase<pg8::EpiMerge, pg8::SchedTok<3>, true, true>(ldsl, 512, S, E);
    }
    SEAM(layer == NLAYER - 1 && 8 == 14); STAMP(layer * 14 + 8);
    for (int rep_ = 0; rep_ <= ((REP_MASK >> 9) & 1); ++rep_) { KParams Pq = Pk; asm volatile("" : "+s"(Pq)); const Params& P = *(const Params*)Pq; const Tctx T = opaque_ctx(T0);
            pg8::SchedTok<1> S; S.A0 = (const char*)(P.ws + WS_M); S.A1 = S.A0; S.A2 = S.A0; S.Bt = (const char*)WO; S.KA = 1024;
            S.ntile = skipc ? 256 : 272; S.skip_ctx = skipc; S.G = T.G; S.c = (T.G % 8 == 0) ? (T.blk % 8) * (T.G / 8) + T.blk / 8 : T.blk;
            pg8::EpiWo E{P.x, P.ctx, (const float*)(P.ws + WS_XA), layer, modv, (float*)(P.ws + WS_X1)};
            pg8::gemm_phase<pg8::EpiWo, pg8::SchedTok<1>, true, true>(ldsl, 1024, S, E);
    }
    SEAM(layer == NLAYER - 1 && 9 == 14); STAMP(layer * 14 + 9);
    for (int rep_ = 0; rep_ <= ((REP_MASK >> 10) & 1); ++rep_) { KParams Pq = Pk; asm volatile("" : "+s"(Pq)); const Params& P = *(const Params*)Pq; const Tctx T = opaque_ctx(T0);
            p7_ln_router(P, T, lds, layer);
    }
    SEAM(layer == NLAYER - 1 && 10 == 14); STAMP(layer * 14 + 10);
    for (int rep_ = 0; rep_ <= ((REP_MASK >> 11) & 1); ++rep_) { KParams Pq = Pk; asm volatile("" : "+s"(Pq)); const Params& P = *(const Params*)Pq; const Tctx T = opaque_ctx(T0);
            p8_topk(P, T, lds, layer);
    }
    SEAM(layer == NLAYER - 1 && 11 == 14); STAMP(layer * 14 + 11);
    for (int rep_ = 0; rep_ <= ((REP_MASK >> 12) & 1); ++rep_) { KParams Pq = Pk; asm volatile("" : "+s"(Pq)); const Params& P = *(const Params*)Pq; const Tctx T = opaque_ctx(T0);
            pg8::SchedExp S; S.A = (const char*)(P.ws + WS_H); S.gather = true; S.Bt = (const char*)WGU; S.KA = 1024; S.NMT = skipc ? 8 : 9; S.NPN = 16; S.OCW = 128; S.G = T.G; S.c = (T.G % 8 == 0) ? (T.blk % 8) * (T.G / 8) + T.blk / 8 : T.blk;
            pg8::EpiGU E{(bf16_t*)(P.ws + WS_HID)};
            pg8::gemm_phase<pg8::EpiGU, pg8::SchedExp, true, true, true>(ldsl, 1024, S, E, (const int*)(P.ws + WS_IDX));
    }
    SEAM(layer == NLAYER - 1 && 12 == 14); STAMP(layer * 14 + 12);
    for (int rep_ = 0; rep_ <= ((REP_MASK >> 13) & 1); ++rep_) { KParams Pq = Pk; asm volatile("" : "+s"(Pq)); const Params& P = *(const Params*)Pq; const Tctx T = opaque_ctx(T0);
            pg8::EpiDown E{(bf16_t*)(P.ws + WS_XS), (const float*)(P.ws + WS_AFFSEL), (bf16_t*)(P.ws + WS_Q)};
            const int vc = (T.G % 8 == 0) ? (T.blk % 8) * (T.G / 8) + T.blk / 8 : T.blk;
            if constexpr (!skipc) { pg8::SchedDownSplit S; S.A = (const char*)(P.ws + WS_HID); S.Bt = (const char*)WD; S.G = T.G; S.c = vc;
                pg8::gemm_phase<pg8::EpiDown, pg8::SchedDownSplit, true, true>(ldsl, 2048, S, E); }
            else { pg8::SchedExp S; S.A = (const char*)(P.ws + WS_HID); S.gather = false; S.Bt = (const char*)WD; S.KA = 2048; S.NMT = 8; S.NPN = 4; S.OCW = 256; S.G = T.G; S.c = vc;
                pg8::gemm_phase<pg8::EpiDown, pg8::SchedExp, true, true>(ldsl, 2048, S, E); }
    }
    SEAM(layer == NLAYER - 1 && 13 == 14); STAMP(layer * 14 + 13);
    for (int rep_ = 0; rep_ <= ((REP_MASK >> 14) & 1); ++rep_) { KParams Pq = Pk; asm volatile("" : "+s"(Pq)); const Params& P = *(const Params*)Pq; const Tctx T = opaque_ctx(T0);
            p11_combine(P, T, lds, layer);
    }
    SEAM(layer == NLAYER - 1 && 14 == 14); STAMP(layer * 14 + 14);
}

__global__ void __launch_bounds__(512, 2) fwd_mega(Params P_unused_) {
    const __attribute__((address_space(4))) Params* Pk = (const __attribute__((address_space(4))) Params*)__builtin_amdgcn_kernarg_segment_ptr();
    const Params& P = *(const Params*)Pk;
    extern __shared__ __attribute__((aligned(16))) unsigned char lds[];
    cg::grid_group grid = cg::this_grid();
    Tctx T0; { Tctx& T = T0; T.tid = threadIdx.x; T.lane = T.tid & 63; T.wave = __builtin_amdgcn_readfirstlane(T.tid >> 6); T.G = gridDim.x; T.blk = blockIdx.x; T.gw = T.blk * 8 + T.wave; T.NGW = T.G * 8; }
    const Tctx& T = T0;
    PG8_LAS unsigned char* ldsl = (PG8_LAS unsigned char*)lds;
    volatile LAS unsigned* MISC = (volatile LAS unsigned*)(ldsl + (LDS_BYTES - 256));
    if (T.tid < 64) MISC[T.tid] = 0u;
    unsigned* barw = (unsigned*)(P.ws + WS_BAR);
    __syncthreads();
    const XcdBarrier bar0 = xcd_barrier_post(barw, MISC + 8);
    if (P.ph_lo == 0x7fffffff) grid.sync();
    if (T.blk < 192) p0_modv(P, T, lds, T.blk);
    if (T.blk == T.G - 1) p0_rope(P, T);
    p0_convert(P, T, lds);
#ifdef P0_TWICE
    __syncthreads(); p0_convert(P, T, lds);
#endif
    { XcdBarrier bar = bar0; asm volatile("" : "+s"(bar.bar)); xcd_barrier(bar); }
    STAMP(0);
    run_layer<0>(Pk, T0, lds, ldsl, bar0);
    run_layer<1>(Pk, T0, lds, ldsl, bar0);
#ifdef TIME_A
    if (T0.blk == 0 && T0.tid == 0) { volatile LAS unsigned long long* st = (volatile LAS unsigned long long*)(ldsl + 143616);
        const unsigned long long d = (st[TIME_B] - st[TIME_A]) * (unsigned long long)TIME_MULT; const unsigned long long t0 = __builtin_amdgcn_s_memrealtime();
        while (__builtin_amdgcn_s_memrealtime() - t0 < d) __builtin_amdgcn_s_sleep(8); }
#endif
}

constexpr int N_PHASES = 1 + NLAYER * 14;

extern "C" void kernel_launch(void* const* d_in, const int* in_sizes, int n_in, void* d_out, int out_size, void* d_ws, size_t ws_size, hipStream_t stream) {
    static int grid = 0;
    if (grid == 0) {
        if (n_in != 28 || ws_size < WS_END) { fprintf(stderr, "kernel_launch: unexpected n_in %d / ws %zu (need %zu)\n", n_in, ws_size, (size_t)WS_END); grid = -1; return; }
        int dev = 0, cus = 0, per_cu = 0;
        (void)hipGetDevice(&dev); (void)hipDeviceGetAttribute(&cus, hipDeviceAttributeMultiprocessorCount, dev);
        (void)hipFuncSetAttribute((const void*)fwd_mega, hipFuncAttributeMaxDynamicSharedMemorySize, LDS_BYTES);
        (void)hipOccupancyMaxActiveBlocksPerMultiprocessor(&per_cu, (const void*)fwd_mega, 512, LDS_BYTES);
        if (per_cu < 1) { fprintf(stderr, "kernel_launch: occupancy query says %d blocks/CU\n", per_cu); per_cu = 1; }
        grid = cus * per_cu;
    }
    if (grid < 0) return;
    (void)hipMemsetAsync((char*)d_ws + WS_BAR, 0, 16384, stream);
    Params p{};
    const float** f = (const float**)&p;
    for (int i = 0; i < 28; ++i) f[i] = (const float*)d_in[i];
    p.out = (float*)d_out; p.ws = (unsigned char*)d_ws;
    p.ph_lo = 0; p.ph_hi = 0;
    void* args[] = {&p};
    hipError_t e = hipLaunchCooperativeKernel((const void*)fwd_mega, dim3(grid), dim3(512), args, LDS_BYTES, stream);
    if (e != hipSuccess) fprintf(stderr, "cooperative launch failed: %s (grid %d)\n", hipGetErrorString(e), grid);
}
```

```cpp
#include <hip/hip_runtime.h>
#include <hip/hip_bf16.h>
#include <hip/hip_cooperative_groups.h>
#include <cstdio>
#include <cstdint>
namespace cg = cooperative_groups;

#define DI __device__ __forceinline__
#define LAS __attribute__((address_space(3)))
typedef unsigned short bf16_t;
typedef short bf16x8 __attribute__((ext_vector_type(8)));
typedef float f32x4 __attribute__((ext_vector_type(4)));
typedef float f32x2 __attribute__((ext_vector_type(2)));
typedef float f32x16 __attribute__((ext_vector_type(16)));
typedef unsigned u32x4 __attribute__((ext_vector_type(4)));
typedef unsigned u32x2 __attribute__((ext_vector_type(2)));

constexpr int DMODEL = 1024, NBATCH = 4, SEQL = 4096, CTXL = 256, TPB = SEQL + CTXL  , MR = NBATCH * TPB  ;
constexpr int NLAYER = 2, IN_COLS = 6672, NP = 6656;
constexpr int PK = 0, PV = 128, PXBC = 256, PQ = 1024, PZ = 1536, PSCB = 2048, PSCC = 2560, PSCX = 3072, PG = 3584;
constexpr int NEXP = 16, FF = 2048, ESTR = 2304  , NCH = 34  ;
constexpr float EPSF = 1e-6f;
constexpr float ALPHA_F = 1.4142135623730951f;
constexpr float QSCALE = 0.125f * 1.4426950408889634f;

constexpr size_t al256(size_t x) { return (x + 255) & ~(size_t)255; }
constexpr size_t WS_WIN = 0;
constexpr size_t WS_WBR = WS_WIN + al256((size_t)NLAYER * NP * 1024 * 2);
constexpr size_t WS_WO = WS_WBR + al256((size_t)NLAYER * 3 * 1024 * 512 * 2);
constexpr size_t WS_WGU = WS_WO + al256((size_t)NLAYER * 1024 * 1024 * 2);
constexpr size_t WS_WD = WS_WGU + al256((size_t)NLAYER * NEXP * 4096 * 1024 * 2);
constexpr size_t WS_XA = WS_WD + al256((size_t)NLAYER * NEXP * 1024 * 2048 * 2);
constexpr size_t WS_X1 = WS_XA + al256((size_t)MR * 1024 * 4);
constexpr size_t WS_H = WS_X1 + al256((size_t)MR * 1024 * 4);
constexpr size_t WS_PROJ = WS_H + al256((size_t)MR * 1024 * 2);
constexpr size_t WS_XS = WS_PROJ;
constexpr size_t WS_HID = WS_PROJ + al256((size_t)NEXP * ESTR * 1024 * 2);
constexpr size_t WS_Q = WS_PROJ + al256((size_t)MR * NP * 2);
constexpr size_t WS_K = WS_Q + al256((size_t)MR * 512 * 2);
constexpr size_t WS_V = WS_K + al256((size_t)MR * 128 * 2);
constexpr size_t WS_XBC = WS_V + al256((size_t)MR * 128 * 2);
constexpr size_t WS_YC = WS_XBC + al256((size_t)MR * 768 * 2);
constexpr size_t WS_YA = WS_YC + al256((size_t)MR * 512 * 2);
constexpr size_t WS_YS = WS_YA + al256((size_t)MR * 512 * 2);
constexpr size_t WS_YRAW = WS_YS + al256((size_t)MR * 512 * 2);
constexpr size_t WS_M = WS_YRAW + al256((size_t)MR * 512 * 2);
constexpr size_t WS_ST = WS_M + al256((size_t)MR * 1024 * 2);
constexpr size_t WS_DT = WS_ST + al256((size_t)2 * NBATCH * NCH * 8 * 4096 * 4);
constexpr size_t WS_ACS = WS_DT + al256((size_t)MR * 16 * 4);
constexpr size_t WS_AFF = WS_ACS + al256((size_t)MR * 16 * 4);
constexpr size_t WS_SLOT = WS_AFF + al256((size_t)MR * 16 * 4);
constexpr size_t WS_AFFSEL = WS_SLOT + al256((size_t)MR * 16 * 4);
constexpr size_t WS_MODV = WS_AFFSEL + al256((size_t)NEXP * ESTR * 4);
constexpr size_t WS_ROPE = WS_MODV + al256((size_t)NLAYER * 5 * 6144 * 4);
constexpr size_t WS_BAR = WS_ROPE + al256((size_t)64 * 16 * 2 * 4);
constexpr size_t WS_IDX = WS_BAR + 16384;
constexpr size_t WS_SSQ = WS_IDX + al256((size_t)NEXP * ESTR * 4);
constexpr size_t WS_END = WS_SSQ + al256((size_t)MR * 4);
static_assert(WS_HID + (size_t)NEXP * ESTR * 2048 * 2 <= WS_Q, "MoE overlays fit inside PROJ");
static_assert(WS_END <= (size_t)1073741824, "workspace fits 1 GiB");

constexpr int LDS_BYTES = 147456;
constexpr int RING_BYTES = 131072;

struct Params {
    const float *x, *c, *ctx, *c_ctx, *w_mod, *b_mod, *w_in, *q_norm, *k_norm, *ssd_conv_w, *ssd_conv_b, *ssd_a_log, *ssd_dt_bias, *ssd_d, *ssd_norm, *sc_conv_w,
        *w_br_attn, *w_br_ssd, *w_br_conv, *w_o, *ln1_g, *ln1_b, *w_router, *w_exp_gate, *w_exp_up, *w_exp_down, *ln2_g, *ln2_b;
    float* out; unsigned char* ws; int ph_lo, ph_hi;
};

template <int CTRL> DI float dppf(float v) { return __int_as_float(__builtin_amdgcn_update_dpp(0, __float_as_int(v), CTRL, 0xF, 0xF, true)); }
DI float swap16_add(float a, float b) { auto r = __builtin_amdgcn_permlane16_swap(__float_as_uint(a), __float_as_uint(b), false, false); return __uint_as_float(r[0]) + __uint_as_float(r[1]); }
DI float swap32_add(float a, float b) { auto r = __builtin_amdgcn_permlane32_swap(__float_as_uint(a), __float_as_uint(b), false, false); return __uint_as_float(r[0]) + __uint_as_float(r[1]); }
DI float wave_sum(float v) {
    v += dppf<0xB1>(v); v += dppf<0x4E>(v); v += dppf<0x141>(v); v += dppf<0x140>(v);
    v = swap16_add(v, v); v = swap32_add(v, v); return v;
}
DI float wave_max(float v) {
    v = fmaxf(v, dppf<0xB1>(v)); v = fmaxf(v, dppf<0x4E>(v)); v = fmaxf(v, dppf<0x141>(v)); v = fmaxf(v, dppf<0x140>(v));
    { auto r = __builtin_amdgcn_permlane16_swap(__float_as_uint(v), __float_as_uint(v), false, false); v = fmaxf(__uint_as_float(r[0]), __uint_as_float(r[1])); }
    { auto r = __builtin_amdgcn_permlane32_swap(__float_as_uint(v), __float_as_uint(v), false, false); v = fmaxf(__uint_as_float(r[0]), __uint_as_float(r[1])); }
    return v;
}
DI int wave_sum_i(int v) {
#pragma unroll
    for (int o = 1; o < 64; o <<= 1) v += __shfl_xor(v, o);
    return v;
}
DI float reduce16(const float (&s)[16], int lane) {
    float t[8], u[4], w[2];
#pragma unroll
    for (int q = 0; q < 8; ++q) t[q] = swap32_add(s[q], s[q + 8]);
#pragma unroll
    for (int q = 0; q < 4; ++q) u[q] = swap16_add(t[q], t[q + 4]);
    const bool b3 = (lane & 8) != 0, b2 = (lane & 4) != 0;
#pragma unroll
    for (int q = 0; q < 2; ++q) { const float send = b3 ? u[q] : u[q + 2], keep = b3 ? u[q + 2] : u[q]; w[q] = keep + dppf<0x128>(send); }
    float v; { const float send = b2 ? w[0] : w[1], keep = b2 ? w[1] : w[0]; v = keep + __shfl_xor(send, 4); }
    v += dppf<0xB1>(v); v += dppf<0x4E>(v); return v;
}
DI int lane_j16(int lane) { return ((lane >> 5) & 1) * 8 + ((lane >> 4) & 1) * 4 + ((lane >> 3) & 1) * 2 + ((lane >> 2) & 1); }
typedef __bf16 bf16x2_t __attribute__((ext_vector_type(2)));
DI unsigned pk2(float lo, float hi) { f32x2 v = {lo, hi}; bf16x2_t b = __builtin_convertvector(v, bf16x2_t); return __builtin_bit_cast(unsigned, b); }
DI float bflo(unsigned w) { return __uint_as_float(w << 16); }
DI float bfhi(unsigned w) { return __uint_as_float(w & 0xffff0000u); }
DI void unpack8(const u32x4 v, float (&f)[8]) { f[0] = bflo(v.x); f[1] = bfhi(v.x); f[2] = bflo(v.y); f[3] = bfhi(v.y); f[4] = bflo(v.z); f[5] = bfhi(v.z); f[6] = bflo(v.w); f[7] = bfhi(v.w); }
DI u32x4 pack8(const float (&f)[8]) { u32x4 o; o.x = pk2(f[0], f[1]); o.y = pk2(f[2], f[3]); o.z = pk2(f[4], f[5]); o.w = pk2(f[6], f[7]); return o; }
DI float sigmoidf_(float x) { return __builtin_amdgcn_rcpf(1.f + __expf(-x)); }
DI float siluf_(float x) { return x * __builtin_amdgcn_rcpf(1.f + __expf(-x)); }
DI int crow(int r, int hi) { return (r & 3) + 8 * (r >> 2) + 4 * hi; }
DI void row_bp(int r, int& b, int& p) { b = r / TPB; p = r - b * TPB; }
DI const float* xsrc_row(const Params& P, int layer, int r) {
    if (layer == 0) { int b, p; row_bp(r, b, p); return p < CTXL ? P.ctx + ((size_t)b * CTXL + p) * DMODEL : P.x + ((size_t)b * SEQL + (p - CTXL)) * DMODEL; }
    return (const float*)(P.ws + WS_XA) + (size_t)r * DMODEL;
}

namespace pg8 {
#define PG8_LAS __attribute__((address_space(3)))
constexpr int BM = 256, BK = 64, HALF = 128, HTB = HALF * BK * 2, STAGE_BYTES = 8 * HTB;
DI int lds_byte(int r, int c) { const int st = (r >> 4) * 2 + (c >> 5), rr = r & 15, cc = c & 31, ob = rr * 64 + cc * 2; return st * 1024 + (ob ^ (((ob >> 9) & 1) << 5)); }
DI void stage_rc(int b, int& R, int& C) { const int st = b / 1024, sb = b % 1024, swz = sb ^ (((sb >> 9) & 1) << 5); R = (st >> 1) * 16 + swz / 64; C = (st & 1) * 32 + (swz % 64) / 2; }
DI int perm32(int rho) { const int n = rho >> 4, i = rho & 15; return 8 * (i >> 2) + 4 * n + (i & 3); }
struct Unit { const char* a; const char* b; int orow, ocol, aux, keep, nt; };
DI unsigned cvt_pk_bf16(float lo, float hi) { return pk2(lo, hi); }
template <class Epi, class Sched, bool ALIGN_EPI = false, bool SP2 = false, bool GATHER = false>
__device__ __forceinline__ void gemm_phase(PG8_LAS unsigned char* lds, const int K_, const Sched& S, const Epi& E, const int* gidx = nullptr) {
    int tid = threadIdx.x; asm volatile("" : "+v"(tid)); const int wid = __builtin_amdgcn_readfirstlane(tid >> 6), lane = tid & 63, wr = wid >> 2, wc = wid & 3, fr = lane & 15, fq = lane >> 4;
    const int K = K_, nt = K / BK;
    unsigned voffA[2], voffB[2]; unsigned gA0[2] = {0u, 0u}, gA1[2] = {0u, 0u}, nA0[2] = {0u, 0u}, nA1[2] = {0u, 0u}; int gR[2], gC[2];
#pragma unroll
    for (int i = 0; i < 2; ++i) { int R, C; stage_rc(tid * 16 + i * 8192, R, C); gR[i] = R; gC[i] = C; const int Rb = Epi::PERM ? ((R & ~31) + perm32(R & 31)) : R;
        voffA[i] = (unsigned)(R * K + C) * 2u; voffB[i] = (unsigned)(Rb * K + C) * 2u; }
    const size_t kstep = (size_t)(BK * 2);
    const size_t hstep = (size_t)HALF * K * 2;
    const unsigned ldsw = (unsigned)wid * 1024u;
    const int aoff = lds_byte(wr * 64 + fr, fq * 8), boff = lds_byte(wc * 32 + fr, fq * 8);
#define PG8_SA(b, h) (((b) * 2 + (h)) * HTB)
#define PG8_SB(b, h) ((4 + (b) * 2 + (h)) * HTB)
#define PG8_STAGE(bufoff, gbase, voff) do { _Pragma("unroll") for (int _i = 0; _i < 2; ++_i) \
        __builtin_amdgcn_global_load_lds((const unsigned*)((const char*)(gbase) + (voff)[_i]), (PG8_LAS unsigned*)(lds + (bufoff) + ldsw + _i * 8192), 16, 0, 0); } while (0)
#define PG8_GLOAD(d0, d1, U) do { _Pragma("unroll") for (int _i = 0; _i < 2; ++_i) { d0[_i] = (unsigned)(gidx[(U).orow + gR[_i]] * K + gC[_i]) * 2u; d1[_i] = (unsigned)(gidx[(U).orow + 128 + gR[_i]] * K + gC[_i]) * 2u; } } while (0)
#define PG8_STAGEA(b, h, ptr, nx) do { if constexpr (GATHER) { _Pragma("unroll") for (int _i = 0; _i < 2; ++_i) { const unsigned _o = (nx) ? ((h) ? nA1[_i] : nA0[_i]) : ((h) ? gA1[_i] : gA0[_i]); \
        __builtin_amdgcn_global_load_lds((const unsigned*)((const char*)(ptr) + _o), (PG8_LAS unsigned*)(lds + PG8_SA(b, h) + ldsw + _i * 8192), 16, 0, 0); } } \
    else { PG8_STAGE(PG8_SA(b, h), (ptr) + ((h) ? hstep : 0), voffA); } } while (0)
#define PG8_LDA(dst, b, h) do { _Pragma("unroll") for (int m = 0; m < 4; ++m) _Pragma("unroll") for (int k = 0; k < 2; ++k) dst[m][k] = *(const PG8_LAS bf16x8*)(lds + PG8_SA(b, h) + aoff + m * 2048 + k * 1024); } while (0)
#define PG8_LDB(dst, b, h) do { _Pragma("unroll") for (int n = 0; n < 2; ++n) _Pragma("unroll") for (int k = 0; k < 2; ++k) dst[n][k] = *(const PG8_LAS bf16x8*)(lds + PG8_SB(b, h) + boff + n * 2048 + k * 1024); } while (0)
#define PG8_MMA(ai, bj, At, Bt) do { __builtin_amdgcn_s_setprio(1); _Pragma("unroll") for (int m = 0; m < 4; ++m) _Pragma("unroll") for (int n = 0; n < 2; ++n) _Pragma("unroll") for (int k = 0; k < 2; ++k) \
        acc[ai][bj][m][n] = __builtin_amdgcn_mfma_f32_16x16x32_bf16(Bt[n][k], At[m][k], acc[ai][bj][m][n], 0, 0, 0); __builtin_amdgcn_s_setprio(0); } while (0)
#define PG8_WAIT_V(n) asm volatile("s_waitcnt vmcnt(" #n ")" ::: "memory")
#define PG8_WAIT_L(n) asm volatile("s_waitcnt lgkmcnt(" #n ")" ::: "memory")
#define PG8_BAR __builtin_amdgcn_s_barrier()
#define PG8_SCHED __builtin_amdgcn_sched_barrier(0)
    Unit cur, nxt; int ui = 0;
    if (!S.next(0, cur)) return;
    f32x4 acc[2][2][4][2];
#pragma unroll
    for (int a = 0; a < 2; ++a)
#pragma unroll
        for (int b = 0; b < 2; ++b)
#pragma unroll
            for (int m = 0; m < 4; ++m)
#pragma unroll
                for (int n = 0; n < 2; ++n) acc[a][b][m][n] = (f32x4){0.f, 0.f, 0.f, 0.f};
    bf16x8 At[4][2], B0[2][2], B1[2][2];
    const char* cA = cur.a; const char* cB = cur.b;
    if constexpr (GATHER) { PG8_GLOAD(gA0, gA1, cur); }
    S.a_ready(cur);
    if constexpr (SP2) {
        PG8_STAGE(PG8_SB(0, 0), cB, voffB); PG8_STAGE(PG8_SB(0, 1), cB + hstep, voffB); PG8_STAGEA(0, 0, cA, false); PG8_STAGEA(0, 1, cA, false);
        if (wr == 1) PG8_BAR;
        PG8_WAIT_V(2); PG8_BAR;
        PG8_STAGE(PG8_SB(1, 0), cB + kstep, voffB); PG8_STAGEA(1, 0, cA + kstep, false); PG8_STAGE(PG8_SB(1, 1), cB + hstep + kstep, voffB);
        PG8_WAIT_V(6); PG8_BAR;
    } else {
        PG8_STAGE(PG8_SB(0, 0), cB, voffB); PG8_STAGEA(0, 0, cA, false); PG8_STAGE(PG8_SB(0, 1), cB + hstep, voffB); PG8_STAGEA(0, 1, cA, false);
        if (wr == 1) PG8_BAR;
        PG8_WAIT_V(4); PG8_BAR;
        PG8_STAGE(PG8_SB(1, 0), cB + kstep, voffB); PG8_STAGEA(1, 0, cA + kstep, false); PG8_STAGE(PG8_SB(1, 1), cB + hstep + kstep, voffB);
        PG8_WAIT_V(6); PG8_BAR;
    }
    for (;;) {
        const bool has_next = S.next(ui + 1, nxt);
        if constexpr (GATHER) { if (has_next) { PG8_GLOAD(nA0, nA1, nxt); } else { nA0[0] = gA0[0]; nA0[1] = gA0[1]; nA1[0] = gA1[0]; nA1[1] = gA1[1]; } }
        const char* nA = has_next ? nxt.a : cA; const char* nB = has_next ? nxt.b : cB;
        const int ntu = cur.nt ? cur.nt : nt;
        for (int t = 0; t < ntu; t += 2) {
            const bool last = (t == ntu - 2);
            const char* a1 = cA + (size_t)(t + 1) * kstep;
            const char* a2 = last ? nA : cA + (size_t)(t + 2) * kstep; const char* b2 = last ? nB : cB + (size_t)(t + 2) * kstep;
            const char* a3 = a2 + kstep; const char* b3 = b2 + kstep;
            if (last && has_next) S.a_ready(nxt);
            if constexpr (SP2) {
            PG8_LDB(B0, 0, 0); PG8_LDB(B1, 0, 1); PG8_SCHED; PG8_LDA(At, 0, 0); PG8_STAGEA(1, 1, a1, false);
            PG8_WAIT_V(8); PG8_WAIT_L(0); PG8_BAR; PG8_MMA(0, 0, At, B0); PG8_MMA(0, 1, At, B1); PG8_BAR; PG8_SCHED;
            PG8_LDA(At, 0, 1); PG8_STAGE(PG8_SB(0, 0), b2, voffB); PG8_STAGE(PG8_SB(0, 1), b2 + hstep, voffB); PG8_STAGEA(0, 0, a2, last);
            PG8_WAIT_V(8); PG8_WAIT_L(0); PG8_BAR; PG8_MMA(1, 0, At, B0); PG8_MMA(1, 1, At, B1); PG8_BAR; PG8_SCHED;
            PG8_LDB(B0, 1, 0); PG8_LDB(B1, 1, 1); PG8_SCHED; PG8_LDA(At, 1, 0); PG8_STAGEA(0, 1, a2, last);
            PG8_WAIT_V(8); PG8_WAIT_L(0); PG8_BAR; PG8_MMA(0, 0, At, B0); PG8_MMA(0, 1, At, B1); PG8_BAR; PG8_SCHED;
            PG8_LDA(At, 1, 1); PG8_STAGE(PG8_SB(1, 0), b3, voffB); PG8_STAGE(PG8_SB(1, 1), b3 + hstep, voffB); PG8_STAGEA(1, 0, a3, last);
            PG8_WAIT_V(8); PG8_WAIT_L(0); PG8_BAR; PG8_MMA(1, 0, At, B0); PG8_MMA(1, 1, At, B1); PG8_BAR; PG8_SCHED;
            } else {
            PG8_LDB(B0, 0, 0); PG8_SCHED; PG8_LDA(At, 0, 0); PG8_STAGEA(1, 1, a1, false);
            PG8_WAIT_L(8); PG8_BAR; PG8_WAIT_L(0); PG8_MMA(0, 0, At, B0); PG8_BAR; PG8_SCHED;
            PG8_LDB(B1, 0, 1); PG8_STAGE(PG8_SB(0, 0), b2, voffB);
            PG8_BAR; PG8_WAIT_L(0); PG8_MMA(0, 1, At, B1); PG8_BAR;
            PG8_LDA(At, 0, 1); PG8_STAGEA(0, 0, a2, last);
            PG8_BAR; PG8_WAIT_L(0); PG8_MMA(1, 0, At, B0); PG8_BAR; PG8_SCHED;
            PG8_STAGE(PG8_SB(0, 1), b2 + hstep, voffB);
            PG8_WAIT_V(6); PG8_BAR; PG8_MMA(1, 1, At, B1); PG8_BAR;
            PG8_LDB(B0, 1, 0); PG8_SCHED; PG8_LDA(At, 1, 0); PG8_STAGEA(0, 1, a2, last);
            PG8_WAIT_L(8); PG8_BAR; PG8_WAIT_L(0); PG8_MMA(0, 0, At, B0); PG8_BAR; PG8_SCHED;
            PG8_LDB(B1, 1, 1); PG8_STAGE(PG8_SB(1, 0), b3, voffB);
            PG8_BAR; PG8_WAIT_L(0); PG8_MMA(0, 1, At, B1); PG8_BAR;
            PG8_LDA(At, 1, 1); PG8_STAGEA(1, 0, a3, last);
            PG8_BAR; PG8_WAIT_L(0); PG8_MMA(1, 0, At, B0); PG8_BAR; PG8_SCHED;
            PG8_STAGE(PG8_SB(1, 1), b3 + hstep, voffB);
            PG8_WAIT_V(6); PG8_BAR; PG8_MMA(1, 1, At, B1); PG8_BAR;
            }
        }
        if constexpr (ALIGN_EPI) { if (wr == 0) PG8_BAR; }
        if constexpr (!Epi::AFTER_DRAIN) { E(acc, cur, wr, wc, fr, fq); S.done(cur); }
        if (!has_next) break;
        if (!cur.keep) {
#pragma unroll
        for (int a = 0; a < 2; ++a)
#pragma unroll
            for (int b = 0; b < 2; ++b)
#pragma unroll
                for (int m = 0; m < 4; ++m)
#pragma unroll
                    for (int n = 0; n < 2; ++n) acc[a][b][m][n] = (f32x4){0.f, 0.f, 0.f, 0.f};
        }
        cur = nxt; cA = nA; cB = nB; ++ui;
        if constexpr (GATHER) { gA0[0] = nA0[0]; gA0[1] = nA0[1]; gA1[0] = nA1[0]; gA1[1] = nA1[1]; }
        if constexpr (ALIGN_EPI) { if (wr == 1) PG8_BAR; }
    }
    PG8_WAIT_V(0);
    if constexpr (!ALIGN_EPI) { if (wr == 0) PG8_BAR; }
    PG8_BAR;
    if constexpr (Epi::AFTER_DRAIN) { E.fused(acc, cur, wr, wc, fr, fq, lds, wid, lane); S.done(cur); }
#undef PG8_SA
#undef PG8_SB
#undef PG8_STAGE
#undef PG8_LDA
#undef PG8_GLOAD
#undef PG8_STAGEA
#undef PG8_LDB
#undef PG8_MMA
#undef PG8_WAIT_V
#undef PG8_WAIT_L
#undef PG8_BAR
#undef PG8_SCHED
}


typedef f32x4 AccT[2][2][4][2];
struct EpiStoreBf16 {
    static constexpr bool PERM = true, AFTER_DRAIN = false;
    bf16_t* O; int ldc;
    DI void operator()(AccT& acc, const Unit& u, int wr, int wc, int fr, int fq) const {
        const int row0 = u.orow + wr * 64 + fr, col0 = u.ocol + wc * 32 + 8 * fq;
#pragma unroll
        for (int ai = 0; ai < 2; ++ai)
#pragma unroll
            for (int m = 0; m < 4; ++m) { bf16_t* rowp = O + (size_t)(row0 + ai * HALF + m * 16) * ldc + col0;
#pragma unroll
                for (int bj = 0; bj < 2; ++bj) { const f32x4 v0 = acc[ai][bj][m][0], v1 = acc[ai][bj][m][1];
                    u32x4 w; w.x = pk2(v0[0], v0[1]); w.y = pk2(v0[2], v0[3]); w.z = pk2(v1[0], v1[1]); w.w = pk2(v1[2], v1[3]);
                    *(u32x4*)(rowp + bj * HALF) = w; } }
    }
};
struct EpiMerge {
    static constexpr bool PERM = true, AFTER_DRAIN = false;
    const bf16_t* PROJ; bf16_t* Mo; const float* ssq; bf16_t* pb;
    DI void operator()(AccT& acc, const Unit& u, int wr, int wc, int fr, int fq) const {
        const int rl0 = wr * 64 + fr, cl0 = wc * 32 + 8 * fq; const int j = u.aux;
        bf16_t* pbl = pb + rl0 * 256 + cl0; asm volatile("" : "+v"(pbl));
        if (j < 2) {
#pragma unroll
            for (int ai = 0; ai < 2; ++ai)
#pragma unroll
                for (int m = 0; m < 4; ++m) { bf16_t* rowp = pbl + (size_t)j * 65536 + (ai * HALF + m * 16) * 256;
#pragma unroll
                    for (int bj = 0; bj < 2; ++bj) { const f32x4 v0 = acc[ai][bj][m][0], v1 = acc[ai][bj][m][1];
                        u32x4 w; w.x = pk2(v0[0], v0[1]); w.y = pk2(v0[2], v0[3]); w.z = pk2(v1[0], v1[1]); w.w = pk2(v1[2], v1[3]);
                        *(u32x4*)(rowp + bj * HALF) = w; } }
            return;
        }
#pragma unroll
        for (int ai = 0; ai < 2; ++ai)
#pragma unroll
            for (int m = 0; m < 4; ++m) { const int rl = rl0 + ai * HALF + m * 16; const size_t row = (size_t)(u.orow + rl);
                const float rs = rsqrtf(ssq[row] * (1.f / 512.f) + EPSF);
#pragma unroll
                for (int bj = 0; bj < 2; ++bj) { const bf16_t* gp = PROJ + row * NP + PG + u.ocol + cl0 + bj * HALF; const bf16_t* pp = pbl + (ai * HALF + m * 16) * 256 + bj * HALF;
                    const u32x4 g0 = *(const u32x4*)gp, g1 = *(const u32x4*)(gp + 1024), g2 = *(const u32x4*)(gp + 2048), p0 = *(const u32x4*)pp, p1 = *(const u32x4*)(pp + 65536);
                    const f32x4 v0 = acc[ai][bj][m][0], v1 = acc[ai][bj][m][1]; u32x4 w;
#define MRG2(gw0, gw1, gw2, pw0, pw1, xlo, xhi) pk2(sigmoidf_(bflo(gw0)) * bflo(pw0) + rs * sigmoidf_(bflo(gw1)) * bflo(pw1) + sigmoidf_(bflo(gw2)) * (xlo), \
                                                     sigmoidf_(bfhi(gw0)) * bfhi(pw0) + rs * sigmoidf_(bfhi(gw1)) * bfhi(pw1) + sigmoidf_(bfhi(gw2)) * (xhi))
                    w.x = MRG2(g0.x, g1.x, g2.x, p0.x, p1.x, v0[0], v0[1]); w.y = MRG2(g0.y, g1.y, g2.y, p0.y, p1.y, v0[2], v0[3]);
                    w.z = MRG2(g0.z, g1.z, g2.z, p0.z, p1.z, v1[0], v1[1]); w.w = MRG2(g0.w, g1.w, g2.w, p0.w, p1.w, v1[2], v1[3]);
#undef MRG2
                    *(u32x4*)(Mo + row * 1024 + u.ocol + cl0 + bj * HALF) = w;
                    if (bj == 1 && (m & 1)) asm volatile("" ::: "memory"); } }
    }
};
struct EpiWo {
    static constexpr bool PERM = false, AFTER_DRAIN = false;
    const float* x_in; const float* ctx_in; const float* XA; int layer; const float* modv  ; float* X1;
    DI void operator()(AccT& acc, const Unit& u, int wr, int wc, int fr, int fq) const {
        const int b = u.orow / TPB, p = u.orow - b * TPB;
        const float* xb; int mrow;
        if (p < CTXL) mrow = 4; else mrow = b;
        if (layer == 0) xb = (p < CTXL) ? ctx_in + (size_t)b * CTXL * DMODEL : x_in + ((size_t)b * SEQL + (p - CTXL)) * DMODEL;
        else xb = XA + (size_t)u.orow * DMODEL;
        const int rl0 = wr * 64 + fr, col0 = u.ocol + wc * 32 + 4 * fq;
        const float* m2 = modv + (size_t)mrow * 6144 + 2 * 1024;
        f32x4 mv[2][2];
#pragma unroll
        for (int bj = 0; bj < 2; ++bj)
#pragma unroll
            for (int n = 0; n < 2; ++n) mv[bj][n] = *(const f32x4*)(m2 + col0 + bj * HALF + n * 16);
#pragma unroll
        for (int ai = 0; ai < 2; ++ai) {
            f32x4 xv[4][2][2];
#pragma unroll
            for (int m = 0; m < 4; ++m) { const int rl = rl0 + ai * HALF + m * 16; const float* xr = xb + (size_t)rl * DMODEL + col0;
#pragma unroll
                for (int bj = 0; bj < 2; ++bj)
#pragma unroll
                    for (int n = 0; n < 2; ++n) xv[m][bj][n] = *(const f32x4*)(xr + bj * HALF + n * 16); }
#pragma unroll
            for (int m = 0; m < 4; ++m) { const int rl = rl0 + ai * HALF + m * 16; float* orow = X1 + (size_t)(u.orow + rl) * DMODEL + col0;
#pragma unroll
                for (int bj = 0; bj < 2; ++bj)
#pragma unroll
                    for (int n = 0; n < 2; ++n) *(f32x4*)(orow + bj * HALF + n * 16) = xv[m][bj][n] * ALPHA_F + mv[bj][n] * acc[ai][bj][m][n]; } }
    }
};
struct EpiGU {
    static constexpr bool PERM = true, AFTER_DRAIN = false;
    bf16_t* HID;
    DI void operator()(AccT& acc, const Unit& u, int wr, int wc, int fr, int fq) const {
        const int row0 = u.orow + wr * 64 + fr, col0 = u.ocol + wc * 32 + 8 * fq;
#pragma unroll
        for (int ai = 0; ai < 2; ++ai)
#pragma unroll
            for (int m = 0; m < 4; ++m) { bf16_t* rowp = HID + (size_t)(row0 + ai * HALF + m * 16) * FF + col0;
                const f32x4 g0 = acc[ai][0][m][0], g1 = acc[ai][0][m][1], u0 = acc[ai][1][m][0], u1 = acc[ai][1][m][1];
                u32x4 w; w.x = pk2(siluf_(g0[0]) * u0[0], siluf_(g0[1]) * u0[1]); w.y = pk2(siluf_(g0[2]) * u0[2], siluf_(g0[3]) * u0[3]);
                w.z = pk2(siluf_(g1[0]) * u1[0], siluf_(g1[1]) * u1[1]); w.w = pk2(siluf_(g1[2]) * u1[2], siluf_(g1[3]) * u1[3]);
                *(u32x4*)rowp = w; }
    }
};
struct EpiDown {
    static constexpr bool PERM = true, AFTER_DRAIN = false;
    bf16_t* Y; const float* affsel; bf16_t* YP;
    DI void operator()(AccT& acc, const Unit& u, int wr, int wc, int fr, int fq) const {
        const int row0 = u.orow + wr * 64 + fr, col0 = u.ocol + wc * 32 + 8 * fq; const int ks = u.aux >> 8, e = u.aux & 255;
        float sv[2][4];
#pragma unroll
        for (int ai = 0; ai < 2; ++ai)
#pragma unroll
            for (int m = 0; m < 4; ++m) sv[ai][m] = affsel[row0 + ai * HALF + m * 16];
#pragma unroll
        for (int ai = 0; ai < 2; ++ai)
#pragma unroll
            for (int m = 0; m < 4; ++m) { const int row = row0 + ai * HALF + m * 16; const float s = sv[ai][m];
                bf16_t* rowp = (ks == 0) ? Y + (size_t)row * 1024 + col0 : YP + ((size_t)(ks - 1) * 4096 + e * 256 + (row - u.orow)) * 1024 + col0;
#pragma unroll
                for (int bj = 0; bj < 2; ++bj) { const f32x4 v0 = acc[ai][bj][m][0] * s, v1 = acc[ai][bj][m][1] * s;
                    u32x4 w; w.x = pk2(v0[0], v0[1]); w.y = pk2(v0[2], v0[3]); w.z = pk2(v1[0], v1[1]); w.w = pk2(v1[2], v1[3]);
                    *(u32x4*)(rowp + bj * HALF) = w; } }
    }
};

struct NoHooks { DI void a_ready(const Unit&) const {} DI void done(const Unit&) const {} };
struct SchedInProj : NoHooks {
    const char* A; const char* Bt; int G, c;
    DI bool next(int i, Unit& u) const {
        constexpr int nM = MR / 256, nN = NP / 256, nwg = nM * nN, NXCD = 8, WGM = 8;
        const long L = (long)i * G + c; if (L >= nwg) return false;
        int wgid = (int)L; { const int q = nwg / NXCD, r = nwg % NXCD, xcd = wgid % NXCD, off = wgid / NXCD; wgid = (xcd < r ? xcd * (q + 1) : r * (q + 1) + (xcd - r) * q) + off; }
        const int nig = WGM * nN, gid = wgid / nig, fm = gid * WGM, gsz = (nM - fm) < WGM ? (nM - fm) : WGM;
        const int pm = fm + ((wgid % nig) % gsz), pn = (wgid % nig) / gsz;
        u.a = A + (size_t)pm * 256 * 1024 * 2; u.b = Bt + (size_t)pn * 256 * 1024 * 2; u.orow = pm * 256; u.ocol = pn * 256; u.aux = 0; u.keep = 0; u.nt = 0; return true;
    }
};
template <int NBR> struct SchedTok : NoHooks {
    const char* A0; const char* A1; const char* A2; const char* Bt; int KA  ; int ntile; bool skip_ctx; int G, c;
    DI bool next(int i, Unit& u) const {
        const int k = i / NBR, j = i - k * NBR; const int t = k * G + c; if (t >= ntile) return false;
        const int lt = t >> 2, pn = t & 3; const int pm = skip_ctx ? (lt / 16) * 17 + 1 + (lt % 16) : lt;
        const char* Ab = (j == 0) ? A0 : (j == 1 ? A1 : A2);
        u.a = Ab + (size_t)pm * 256 * KA * 2; u.b = Bt + ((size_t)j * 1024 + pn * 256) * KA * 2; u.orow = pm * 256; u.ocol = pn * 256; u.aux = j; u.keep = 0; u.nt = 0; return true;
    }
};
struct SchedExp : NoHooks {
    const char* A; const char* Bt; int KA; int NMT, NPN, OCW  ; int G, c; bool gather  ;
    DI bool next(int i, Unit& u) const {
        const int id = i * G + c; if (id >= NEXP * NMT * NPN) return false;
        const int mt = id % NMT, pn = (id / NMT) % NPN, e = id / (NMT * NPN);
        u.a = gather ? A : A + ((size_t)e * ESTR + mt * 256) * KA * 2; u.b = Bt + ((size_t)e * NPN + pn) * 256 * KA * 2; u.orow = e * ESTR + mt * 256; u.ocol = pn * OCW; u.aux = e; u.keep = 0; u.nt = 0; return true;
    }
};
struct SchedDownSplit : NoHooks {
    const char* A; const char* Bt; int G, c;
    DI bool next(int i, Unit& u) const {
        const int id = i * G + c; if (id >= 768) return false;
        if (id < 512) { const int mt = id & 7, pn = (id >> 3) & 3, e = id >> 5;
            u.a = A + ((size_t)e * ESTR + mt * 256) * 2048 * 2; u.b = Bt + ((size_t)e * 4 + pn) * 256 * 2048 * 2; u.orow = e * ESTR + mt * 256; u.ocol = pn * 256; u.aux = e; u.keep = 0; u.nt = 0; }
        else { const int j = id - 512, ks = j & 3, pn = (j >> 2) & 3, e = j >> 4;
            u.a = A + ((size_t)e * ESTR + 2048) * 2048 * 2 + ks * 512 * 2; u.b = Bt + ((size_t)e * 4 + pn) * 256 * 2048 * 2 + ks * 512 * 2; u.orow = e * ESTR + 2048; u.ocol = pn * 256; u.aux = e | (ks << 8); u.keep = 0; u.nt = 8; }
        return true;
    }
};
}

namespace attn_body {
using bf16=__hip_bfloat16;
using bf16x8=__attribute__((ext_vector_type(8)))short;
using s16x4=__attribute__((ext_vector_type(4)))short;
using f32x16=__attribute__((ext_vector_type(16)))float;
using u32x4=__attribute__((ext_vector_type(4)))unsigned;
constexpr int D=64,NW=8,QBLK=32,QB=QBLK*NW,KVBLK=64,QP=512,KP=128;
__device__ __forceinline__ int crow(int r,int hi){return (r&3)+8*(r>>2)+4*hi;}
#define SBAR() __builtin_amdgcn_sched_barrier(0)
__device__ __forceinline__ void cmask(f32x16&p0,f32x16&p1,int jb,int qrel,int hi){
  const float NEG=-INFINITY; int kb=64*jb+4*hi;
  #pragma unroll
  for(int r=0;r<16;++r){int kv=kb+(r&3)+8*(r>>2); if(kv>qrel)p0[r]=NEG; if(kv+32>qrel)p1[r]=NEG;}
}

constexpr int NSLOT=3, SLOTB=8192;
constexpr int LDS_K=0, LDS_V=NSLOT*SLOTB, LDS_WS=2*NSLOT*SLOTB, LDS_OST=LDS_WS+NW*64*4, LDS_BYTES=LDS_OST+NW*4096;
constexpr float C2=0.125f*1.4426950408889634f;
__device__ __forceinline__ void glds16(const void*gsrc,unsigned lds_dst){unsigned keep;
  asm volatile("s_mov_b32 %0, m0\n\ts_mov_b32 m0, %2\n\ts_nop 0\n\tglobal_load_lds_dwordx4 %1, off\n\ts_mov_b32 m0, %0":"=&s"(keep):"v"(gsrc),"s"(lds_dst):"memory");}
__device__ __forceinline__ float max3f(float a,float b,float c){float r;asm("v_max3_f32 %0, %1, %2, %3":"=v"(r):"v"(a),"v"(b),"v"(c));return r;}
__device__ __forceinline__ float max2f(float a,float b){float r;asm("v_max_f32_e32 %0, %1, %2":"=v"(r):"v"(a),"v"(b));return r;}
__device__ __forceinline__ float fadd_s(float a,float b){float r;asm("v_add_f32_e32 %0, %1, %2":"=v"(r):"v"(a),"v"(b));return r;}
__device__ __forceinline__ float fsub_s(float a,float b){float r;asm("v_sub_f32_e32 %0, %1, %2":"=v"(r):"v"(a),"v"(b));return r;}
typedef float f32x2_t __attribute__((ext_vector_type(2))); typedef __bf16 bf16x2_t __attribute__((ext_vector_type(2)));
__device__ __forceinline__ unsigned cvtpk_s(float lo,float hi){f32x2_t v={lo,hi};bf16x2_t b=__builtin_convertvector(v,bf16x2_t);return __builtin_bit_cast(unsigned,b);}
#define WAIT_BAR(N) asm volatile("s_waitcnt vmcnt(" #N ") lgkmcnt(0)\n\ts_barrier":::"memory")

__device__ __forceinline__ void qkt(f32x16&p0,f32x16&p1,const char*Kslot,const bf16x8*qr,const f32x16&negm,int r32,int hi){
  const char*kb=Kslot+hi*1024+r32*16;
  #pragma unroll
  for(int d0=0;d0<4;++d0){
    const bf16x8 b0=*reinterpret_cast<const bf16x8*>(kb+d0*2048);
    const bf16x8 b1=*reinterpret_cast<const bf16x8*>(kb+d0*2048+512);
    if(d0==0){p0=__builtin_amdgcn_mfma_f32_32x32x16_bf16(b0,qr[0],negm,0,0,0);p1=__builtin_amdgcn_mfma_f32_32x32x16_bf16(b1,qr[0],negm,0,0,0);}
    else{p0=__builtin_amdgcn_mfma_f32_32x32x16_bf16(b0,qr[d0],p0,0,0,0);p1=__builtin_amdgcn_mfma_f32_32x32x16_bf16(b1,qr[d0],p1,0,0,0);}}
}
typedef __attribute__((address_space(3))) const char* lds_cptr;
typedef short v4i16_t __attribute__((ext_vector_type(4)));
__device__ __forceinline__ void kload8(bf16x8*kf,lds_cptr kp){
  kf[0]=*(const __attribute__((address_space(3))) bf16x8*)(kp);      kf[1]=*(const __attribute__((address_space(3))) bf16x8*)(kp+512);
  kf[2]=*(const __attribute__((address_space(3))) bf16x8*)(kp+2048); kf[3]=*(const __attribute__((address_space(3))) bf16x8*)(kp+2560);
  kf[4]=*(const __attribute__((address_space(3))) bf16x8*)(kp+4096); kf[5]=*(const __attribute__((address_space(3))) bf16x8*)(kp+4608);
  kf[6]=*(const __attribute__((address_space(3))) bf16x8*)(kp+6144); kf[7]=*(const __attribute__((address_space(3))) bf16x8*)(kp+6656);
}
__device__ __forceinline__ void kload2(bf16x8*kf,lds_cptr kp,int j){ kf[2*j]=*(const __attribute__((address_space(3))) bf16x8*)(kp+j*2048); kf[2*j+1]=*(const __attribute__((address_space(3))) bf16x8*)(kp+j*2048+512); }
__device__ __forceinline__ s16x4 vtr(lds_cptr p){ return __builtin_bit_cast(s16x4,__builtin_amdgcn_ds_read_tr16_b64_v4i16((__attribute__((address_space(3))) v4i16_t*)p)); }
__device__ __forceinline__ float rowmax(const f32x16&p0,const f32x16&p1){
  float a=max3f(p0[0],p0[1],p1[0]),b=max3f(p0[2],p0[3],p1[1]);a=max3f(a,p1[2],p1[3]);
  #pragma unroll
  for(int r=4;r<16;r+=4){a=max3f(a,p0[r],p0[r+1]);b=max3f(b,p0[r+2],p0[r+3]);a=max3f(a,p1[r],p1[r+1]);b=max3f(b,p1[r+2],p1[r+3]);}
  const float m=max2f(a,b);
  auto rr=__builtin_amdgcn_permlane32_swap(__float_as_uint(m),__float_as_uint(m),false,false);
  return max2f(__uint_as_float(rr[0]),__uint_as_float(rr[1]));
}
__device__ __forceinline__ void pv(f32x16*o,int vb,bf16x8 pa0,bf16x8 pa1,bf16x8 pa2,bf16x8 pa3){
  #pragma unroll
  for(int d0=0;d0<2;++d0){s16x4 lo[4],hi[4];
    #pragma unroll
    for(int ks=0;ks<4;++ks){
      asm volatile("ds_read_b64_tr_b16 %0,%1 offset:%c2":"=&v"(lo[ks]):"v"(vb),"i"(d0*4096+ks*1024):"memory");
      asm volatile("ds_read_b64_tr_b16 %0,%1 offset:%c2":"=&v"(hi[ks]):"v"(vb),"i"(d0*4096+ks*1024+512):"memory");}
    asm volatile("s_waitcnt lgkmcnt(0)":::"memory");SBAR();
    #define PK(k) (bf16x8){lo[k][0],lo[k][1],lo[k][2],lo[k][3],hi[k][0],hi[k][1],hi[k][2],hi[k][3]}
    o[d0]=__builtin_amdgcn_mfma_f32_32x32x16_bf16(pa0,PK(0),o[d0],0,0,0);
    o[d0]=__builtin_amdgcn_mfma_f32_32x32x16_bf16(pa1,PK(1),o[d0],0,0,0);
    o[d0]=__builtin_amdgcn_mfma_f32_32x32x16_bf16(pa2,PK(2),o[d0],0,0,0);
    o[d0]=__builtin_amdgcn_mfma_f32_32x32x16_bf16(pa3,PK(3),o[d0],0,0,0);
    #undef PK
  }
}

#ifndef ATTN_STORE16
#define ATTN_STORE16(p,v) (*(u32x4*)(p)=(v))
#endif
template<int THRL> __device__ __forceinline__ void attn_unit(long qrow0,long krow0,int NT_,int h,int g,const bf16*Q,const bf16*__restrict__ K,const bf16*__restrict__ V,bf16*O,char*shm){
  int tid=threadIdx.x; asm volatile("":"+v"(tid)); const int lane=tid&63,r32=lane&31,hi=lane>>5; const int wid=__builtin_amdgcn_readfirstlane(tid>>6);
  const bf16*Qw=Q+(qrow0+wid*QBLK)*QP+h*D;
  const bf16*Kh=K+krow0*KP+g*D,*Vh=V+krow0*KP+g*D;
  const unsigned lds0=(unsigned)(uintptr_t)shm;
  float*wsf=(float*)(shm+LDS_WS)+wid*64;
  const bf16*ksrc=Kh+(long)lane*KP+wid*8;
  const bf16*vsrc=Vh+(long)(16*(wid&3)+(lane>>2))*KP+(wid>>2)*32+(lane&3)*8;
  const unsigned kdst=lds0+LDS_K+wid*1024, vdst=lds0+LDS_V+wid*1024;
  #define DMA_K(t,slot) glds16(ksrc+(long)(t)*KVBLK*KP,(unsigned)__builtin_amdgcn_readfirstlane(kdst+(slot)))
  #define DMA_V(t,slot) glds16(vsrc+(long)(t)*KVBLK*KP,(unsigned)__builtin_amdgcn_readfirstlane(vdst+(slot)))
  const int vb0=(int)(lds0+LDS_V)+((lane>>4)&1)*32+(lane&3)*8+(4*hi+((lane&15)>>2))*64;
  const char*Kbase=shm+LDS_K; bf16x8 kf[8];
  const lds_cptr shm3=(lds_cptr)shm; const lds_cptr kp0=shm3+LDS_K+hi*1024+r32*16; const lds_cptr vp0=shm3+LDS_V+((lane>>4)&1)*32+(lane&3)*8+(4*hi+((lane&15)>>2))*64;
  const int NT=NT_;
  DMA_K(0,0);DMA_V(0,0);DMA_K(1,SLOTB);
  bf16x8 qr[4];
  #pragma unroll
  for(int d0=0;d0<4;++d0)qr[d0]=*reinterpret_cast<const bf16x8*>(&Qw[(long)r32*QP+d0*16+hi*8]);
  float mhat=0.f,l_reg=0.f;f32x16 o[2];o[0]=f32x16{};o[1]=f32x16{};f32x16 negm=f32x16{};asm volatile("":"+v"(negm));
  const int qrel=wid*QBLK+r32;
  #define CMASK(P0,P1,t) do{}while(0)
  bool resc=false;
  #define START(P0,P1) do{ const float rm=rowmax(P0,P1); resc=false; \
    { const float dl=rm; mhat=fadd_s(mhat,dl); \
      _Pragma("unroll") for(int r=0;r<16;++r){P0[r]=fsub_s(P0[r],dl);P1[r]=fsub_s(P1[r],dl);} \
      _Pragma("unroll") for(int r=0;r<16;++r)negm[r]=-mhat; asm volatile("":"+v"(negm)); } \
    _Pragma("unroll") for(int r=0;r<16;++r)P0[r]=__builtin_amdgcn_exp2f(P0[r]); }while(0)
  #define RESC() do{ if(resc){ asm volatile("s_waitcnt lgkmcnt(0)":::"memory"); \
      _Pragma("unroll") for(int d_=0;d_<2;++d_) _Pragma("unroll") for(int r=0;r<16;++r)o[d_][r]*=wsf[crow(r,hi)]; } }while(0)
  f32x16 pA0,pA1,pB0,pB1;
  int sl_prev=0,sl_cur=0,sl_next=SLOTB;
  #define ROT() do{sl_prev=sl_cur;sl_cur=sl_next;sl_next=(sl_next==(NSLOT-1)*SLOTB)?0:sl_next+SLOTB;}while(0)
  DMA_K(2,2*SLOTB);
  WAIT_BAR(3);
  qkt(pA0,pA1,Kbase,qr,negm,r32,hi);asm volatile("s_nop 15\n\ts_nop 7":"+v"(pA0),"+v"(pA1));CMASK(pA0,pA1,0);
  START(pA0,pA1);
  _Pragma("unroll") for(int r=0;r<16;++r)pA1[r]=__builtin_amdgcn_exp2f(pA1[r]);
  WAIT_BAR(0);
  DMA_K(3,0);DMA_V(1,SLOTB);
  ROT();
  kload8(kf,kp0+sl_cur);
  WAIT_BAR(2);
  s16x4 vlo[8],vhi[8]; u32x4 pw0,pw1,pw2,pw3;
  #define PKW(P,B) cvtpk_s(P[B],P[B+1])
  #define PAF(k) __builtin_bit_cast(bf16x8,pw##k)
  #define VFR(i) (bf16x8){vlo[i][0],vlo[i][1],vlo[i][2],vlo[i][3],vhi[i][0],vhi[i][1],vhi[i][2],vhi[i][3]}
  #define PIN(x) asm volatile("":"+v"(x))
  #define MX3(a,b,c) __builtin_fmaxf(__builtin_fmaxf((a),(b)),(c))
  #define GAPA(MF,A0,A1,A2,A3,W0,W1,PW) do{ MF; sacc+=A0; sacc+=A1; sacc+=A2; sacc+=A3; PIN(sacc); W0; W1; PIN(PW); SBAR(); }while(0)
  #define EX(v) __builtin_amdgcn_exp2f(v)
  #define GAPB(MF,X,B) do{ MF; X[B]=EX(X[B]); X[B+1]=EX(X[B+1]); X[B+2]=EX(X[B+2]); X[B+3]=EX(X[B+3]); PIN(X); SBAR(); }while(0)
  #define VRD(i) do{ vlo[i]=vtr(vp_+(((i)>>2)*4096+((i)&3)*1024)); vhi[i]=vtr(vp_+(((i)>>2)*4096+((i)&3)*1024+512)); }while(0)
  #define KRD(G,j) do{ if(G){ kload2(kf,kp0+sl_next,j); SBAR(); } }while(0)
  #define STEP(C0,C1,P0,P1,t,GK,GV,GL) do{ SBAR(); \
    const lds_cptr vp_=vp0+sl_prev; \
    VRD(0); SBAR(); float sacc=(P0[0]+P0[1]); \
    GAPA(C0=__builtin_amdgcn_mfma_f32_32x32x16_bf16(kf[0],qr[0],negm,0,0,0), P0[2],P0[3],P0[4],P0[5],     pw0[0]=PKW(P0,0), pw0[1]=PKW(P0,2), pw0); \
    VRD(4); SBAR(); GAPA(C1=__builtin_amdgcn_mfma_f32_32x32x16_bf16(kf[1],qr[0],negm,0,0,0), P0[6],P0[7],P0[8],P0[9],     pw0[2]=PKW(P0,4), pw0[3]=PKW(P0,6), pw0); \
    VRD(1); SBAR(); GAPA(C0=__builtin_amdgcn_mfma_f32_32x32x16_bf16(kf[2],qr[1],C0,0,0,0),   P0[10],P0[11],P0[12],P0[13], pw1[0]=PKW(P0,8), pw1[1]=PKW(P0,10), pw1); \
    VRD(5); SBAR(); GAPA(C1=__builtin_amdgcn_mfma_f32_32x32x16_bf16(kf[3],qr[1],C1,0,0,0),   P0[14],P0[15],P1[0],P1[1],   pw1[2]=PKW(P0,12),pw1[3]=PKW(P0,14), pw1); \
    VRD(2); SBAR(); GAPA(C0=__builtin_amdgcn_mfma_f32_32x32x16_bf16(kf[4],qr[2],C0,0,0,0),   P1[2],P1[3],P1[4],P1[5],     pw2[0]=PKW(P1,0), pw2[1]=PKW(P1,2), pw2); \
    VRD(6); SBAR(); GAPA(C1=__builtin_amdgcn_mfma_f32_32x32x16_bf16(kf[5],qr[2],C1,0,0,0),   P1[6],P1[7],P1[8],P1[9],     pw2[2]=PKW(P1,4), pw2[3]=PKW(P1,6), pw2); \
    VRD(3); SBAR(); GAPA(C0=__builtin_amdgcn_mfma_f32_32x32x16_bf16(kf[6],qr[3],C0,0,0,0),   P1[10],P1[11],P1[12],P1[13], pw3[0]=PKW(P1,8), pw3[1]=PKW(P1,10), pw3); \
    VRD(7); SBAR(); GAPA(C1=__builtin_amdgcn_mfma_f32_32x32x16_bf16(kf[7],qr[3],C1,0,0,0),   P1[14],P1[15],0.f,0.f,       pw3[2]=PKW(P1,12),pw3[3]=PKW(P1,14), pw3); \
    l_reg+=sacc; \
    if(GK){DMA_K((t)+3,sl_cur);} if(GV){DMA_V((t)+1,sl_next);} \
    CMASK(C0,C1,t); \
    { float a=MX3(C0[0],C0[1],C1[0]),b=MX3(C0[2],C0[3],C1[1]); a=MX3(a,C1[2],C1[3]); \
      _Pragma("unroll") for(int r=4;r<16;r+=4){a=MX3(a,C0[r],C0[r+1]);b=MX3(b,C0[r+2],C0[r+3]);a=MX3(a,C1[r],C1[r+1]);b=MX3(b,C1[r+2],C1[r+3]);} \
      float rm=__builtin_fmaxf(a,b); { auto rr=__builtin_amdgcn_permlane32_swap(__float_as_uint(rm),__float_as_uint(rm),false,false); rm=__builtin_fmaxf(__uint_as_float(rr[0]),__uint_as_float(rr[1])); } \
      resc=false; \
      if(__builtin_expect(__any(rm>(float)THRL),0)){ const float dl=__builtin_fmaxf(rm,0.f); mhat+=dl; \
        _Pragma("unroll") for(int r=0;r<16;++r){C0[r]-=dl;C1[r]-=dl;} \
        _Pragma("unroll") for(int r=0;r<16;++r)negm[r]=-mhat; asm volatile("":"+v"(negm)); \
        const float f=__builtin_amdgcn_exp2f(-dl); l_reg*=f; if(hi==0)wsf[r32]=f; resc=true; } } \
    SBAR(); \
    GAPB(o[0]=__builtin_amdgcn_mfma_f32_32x32x16_bf16(PAF(0),VFR(0),o[0],0,0,0), C0,0); \
    GAPB(o[1]=__builtin_amdgcn_mfma_f32_32x32x16_bf16(PAF(0),VFR(4),o[1],0,0,0), C0,4); \
    KRD(GL,0); GAPB(o[0]=__builtin_amdgcn_mfma_f32_32x32x16_bf16(PAF(1),VFR(1),o[0],0,0,0), C0,8); \
    KRD(GL,1); GAPB(o[1]=__builtin_amdgcn_mfma_f32_32x32x16_bf16(PAF(1),VFR(5),o[1],0,0,0), C0,12); \
    KRD(GL,2); GAPB(o[0]=__builtin_amdgcn_mfma_f32_32x32x16_bf16(PAF(2),VFR(2),o[0],0,0,0), C1,0); \
    KRD(GL,3); GAPB(o[1]=__builtin_amdgcn_mfma_f32_32x32x16_bf16(PAF(2),VFR(6),o[1],0,0,0), C1,4); \
    GAPB(o[0]=__builtin_amdgcn_mfma_f32_32x32x16_bf16(PAF(3),VFR(3),o[0],0,0,0), C1,8); \
    GAPB(o[1]=__builtin_amdgcn_mfma_f32_32x32x16_bf16(PAF(3),VFR(7),o[1],0,0,0), C1,12); \
    }while(0)
  int t=1;
  #undef CMASK
  #define CMASK(P0,P1,t) do{}while(0)
  for(;t+5<NT;t+=2){
    STEP(pB0,pB1,pA0,pA1,t,true,true,true);     WAIT_BAR(2); RESC(); ROT();
    STEP(pA0,pA1,pB0,pB1,t+1,true,true,true);   WAIT_BAR(2); RESC(); ROT();
  }
  #undef CMASK
  #define CMASK(P0,P1,t) do{}while(0)
  #define ENDW(tt) do{ if((tt)+3<NT){WAIT_BAR(2);} else if((tt)+2<NT){WAIT_BAR(1);} else {WAIT_BAR(0);} }while(0)
  for(;t+1<NT;t+=2){
    STEP(pB0,pB1,pA0,pA1,t,(t+3<NT),(t+1<NT),(t+1<NT));       ENDW(t);   RESC(); ROT();
    STEP(pA0,pA1,pB0,pB1,t+1,(t+4<NT),(t+2<NT),(t+2<NT));     ENDW(t+1); RESC(); ROT();
  }
  STEP(pB0,pB1,pA0,pA1,NT-1,false,false,false); RESC();
  { float sacc=pB0[0]+pB0[1]; _Pragma("unroll") for(int r=2;r<16;++r)sacc+=pB0[r]; _Pragma("unroll") for(int r=0;r<16;++r)sacc+=pB1[r]; l_reg+=sacc;
    pw0=(u32x4){PKW(pB0,0),PKW(pB0,2),PKW(pB0,4),PKW(pB0,6)};pw1=(u32x4){PKW(pB0,8),PKW(pB0,10),PKW(pB0,12),PKW(pB0,14)};pw2=(u32x4){PKW(pB1,0),PKW(pB1,2),PKW(pB1,4),PKW(pB1,6)};pw3=(u32x4){PKW(pB1,8),PKW(pB1,10),PKW(pB1,12),PKW(pB1,14)};
    SBAR(); pv(o,vb0+sl_cur,PAF(0),PAF(1),PAF(2),PAF(3)); }
  #undef PKW
  #undef PAF
  #undef VFR
  #undef PIN
  #undef MX3
  #undef GAPA
  #undef GAPB
  #undef EX
  #undef VRD
  #undef KRD
  #undef STEP
  #undef ENDW
  {auto rr=__builtin_amdgcn_permlane32_swap(__float_as_uint(l_reg),__float_as_uint(l_reg),false,false);l_reg=__uint_as_float(rr[0])+__uint_as_float(rr[1]);}
  if(hi==0)wsf[32+r32]=l_reg;asm volatile("s_waitcnt lgkmcnt(0)":::"memory");
  float rli[16];
  #pragma unroll
  for(int r=0;r<16;++r)rli[r]=__builtin_amdgcn_rcpf(wsf[32+crow(r,hi)]);
  bf16*Ow=O+(qrow0+wid*QBLK)*QP+h*D;
  { bf16*stg=(bf16*)(shm+LDS_OST)+wid*2048;
    #pragma unroll
    for(int r=0;r<16;++r){const int orow=crow(r,hi);
      #pragma unroll
      for(int d0=0;d0<2;++d0)stg[orow*64+d0*32+r32]=__float2bfloat16(o[d0][r]*rli[r]);}
    asm volatile("s_waitcnt lgkmcnt(0)":::"memory");
    #pragma unroll
    for(int i=0;i<4;++i){const int row=i*8+(lane>>3),ch=lane&7; const u32x4 v=*(const u32x4*)(stg+row*64+ch*8); ATTN_STORE16(Ow+(long)row*QP+ch*8,v);} }
  asm volatile("s_waitcnt lgkmcnt(0)\n\ts_barrier":::"memory");
  #undef DMA_K
  #undef DMA_V
  #undef CMASK
  #undef START
  #undef RESC
  #undef ROT
}

#undef SBAR
#undef WAIT_BAR
}

#define LDSW() asm volatile("s_waitcnt lgkmcnt(0)" ::: "memory")
#define MFMA32(a, b, c) __builtin_amdgcn_mfma_f32_32x32x16_bf16((a), (b), (c), 0, 0, 0)
struct Tctx { int tid, lane, wave, G, blk, gw, NGW; };
DI Tctx opaque_ctx(const Tctx& T0) { Tctx t = T0; asm volatile("" : "+v"(t.tid)); asm volatile("" : "+s"(t.blk)); asm volatile("" : "+s"(t.G));
    t.NGW = t.G * 8; t.lane = t.tid & 63; t.wave = __builtin_amdgcn_readfirstlane(t.tid >> 6); t.gw = t.blk * 8 + t.wave; return t; }

DI int row_skip(int r, int NGW, bool skipc) { if (skipc && r < MR) { const int p = r % TPB; if (p < CTXL) r += ((CTXL - p + NGW - 1) / NGW) * NGW; } return r; }
struct CvItem { const float* src; bf16_t* dst; int ld, ldd; };
DI void cv_load(const CvItem& it, int lane, f32x4 (&v)[16]) {
#pragma unroll
    for (int j = 0; j < 16; ++j) v[j] = __builtin_nontemporal_load((const f32x4*)(it.src + (size_t)(4 * j + (lane >> 4)) * it.ld + 4 * (lane & 15)));
}
DI void cv_store(const CvItem& it, int lane, const f32x4 (&v)[16], LAS float* scr) {
#pragma unroll
    for (int j = 0; j < 16; ++j) { LAS float* s = scr + (4 * j + (lane >> 4)) * 65 + 4 * (lane & 15); s[0] = v[j].x; s[1] = v[j].y; s[2] = v[j].z; s[3] = v[j].w; }
    LDSW();
    const int c = lane & 7;
#pragma unroll
    for (int j = 0; j < 8; ++j) { const int n = (lane >> 3) + 8 * j; const LAS float* s = scr + (8 * c) * 65 + n;
        u32x4 o; o.x = pk2(s[0], s[65]); o.y = pk2(s[130], s[195]); o.z = pk2(s[260], s[325]); o.w = pk2(s[390], s[455]);
        *(u32x4*)(it.dst + (size_t)n * it.ldd + 8 * c) = o; }
    LDSW();
}
DI CvItem cv_decode(const Params& P, int it0) {
    bf16_t* WIN = (bf16_t*)(P.ws + WS_WIN); bf16_t* WBR = (bf16_t*)(P.ws + WS_WBR); bf16_t* WO = (bf16_t*)(P.ws + WS_WO); bf16_t* WGU = (bf16_t*)(P.ws + WS_WGU); bf16_t* WD = (bf16_t*)(P.ws + WS_WD);
    constexpr int I_IN = 16 * 104, I_BR = 8 * 16, I_O = 16 * 16, I_G = 16 * 32, I_D = 32 * 16;
    constexpr int PER_LAYER = I_IN + 3 * I_BR + I_O + NEXP * (2 * I_G + I_D);
    CvItem r;
    const int l = it0 / PER_LAYER; int it = it0 - l * PER_LAYER;
    if (it < I_IN) { const int kb = it / 104, nb = it % 104; const int scol = nb * 64 + (nb >= 16 ? 16 : 0);
        r.src = P.w_in + ((size_t)l * 1024 + kb * 64) * IN_COLS + scol; r.ld = IN_COLS; r.dst = WIN + ((size_t)l * NP + nb * 64) * 1024 + kb * 64; r.ldd = 1024; return r; }
    it -= I_IN;
    if (it < 3 * I_BR) { const int j = it / I_BR; it -= j * I_BR; const int kb = it / 16, nb = it % 16; const float* w = (j == 0) ? P.w_br_attn : (j == 1 ? P.w_br_ssd : P.w_br_conv);
        r.src = w + ((size_t)l * 512 + kb * 64) * 1024 + nb * 64; r.ld = 1024; r.dst = WBR + (((size_t)l * 3 + j) * 1024 + nb * 64) * 512 + kb * 64; r.ldd = 512; return r; }
    it -= 3 * I_BR;
    if (it < I_O) { const int kb = it / 16, nb = it % 16;
        r.src = P.w_o + ((size_t)l * 1024 + kb * 64) * 1024 + nb * 64; r.ld = 1024; r.dst = WO + ((size_t)l * 1024 + nb * 64) * 1024 + kb * 64; r.ldd = 1024; return r; }
    it -= I_O;
    const int e = it / (2 * I_G + I_D); it -= e * (2 * I_G + I_D);
    if (it < 2 * I_G) { const int up = it / I_G; it -= up * I_G; const int kb = it / 32, nb = it % 32; const float* w = up ? P.w_exp_up : P.w_exp_gate;
        const int f0 = nb * 64, pn = f0 >> 7, within = f0 & 127; const size_t drow = ((size_t)(l * NEXP + e) * 16 + pn) * 256 + up * 128 + within;
        r.src = w + (((size_t)l * NEXP + e) * 1024 + kb * 64) * 2048 + nb * 64; r.ld = 2048; r.dst = WGU + drow * 1024 + kb * 64; r.ldd = 1024; return r; }
    it -= 2 * I_G;
    { const int kb = it / 16, nb = it % 16;
        r.src = P.w_exp_down + (((size_t)l * NEXP + e) * 2048 + kb * 64) * 1024 + nb * 64; r.ld = 1024; r.dst = WD + (((size_t)l * NEXP + e) * 1024 + nb * 64) * 2048 + kb * 64; r.ldd = 2048; return r; }
}
DI void p0_convert(const Params& P, const Tctx& T0, unsigned char* lds) { const Tctx T = opaque_ctx(T0);
    LAS float* scr = (LAS float*)lds + T.wave * (64 * 65);
    constexpr int NITEM = NLAYER * (16 * 104 + 3 * 8 * 16 + 16 * 16 + NEXP * (2 * 16 * 32 + 32 * 16));
    int it = T.gw; if (it >= NITEM) return;
    CvItem cur = cv_decode(P, it); f32x4 va[16], vb[16]; cv_load(cur, T.lane, va);
    for (;;) {
        int nit = it + T.NGW; CvItem nxt = cur; const bool hn = nit < NITEM; if (hn) { nxt = cv_decode(P, nit); cv_load(nxt, T.lane, vb); }
        cv_store(cur, T.lane, va, scr);
        if (!hn) break;
        it = nit + T.NGW; cur = nxt; const bool hn2 = it < NITEM; if (hn2) { cur = cv_decode(P, it); cv_load(cur, T.lane, va); }
        cv_store(nxt, T.lane, vb, scr);
        if (!hn2) break;
    }
}
DI void p0_modv(const Params& P, const Tctx& T0, unsigned char* lds_, int item) { const Tctx T = opaque_ctx(T0);
    LAS float* lds = (LAS float*)lds_;
    const int layer = item / 96, jb = item % 96;
    for (int i = T.tid; i < 5120; i += 512) { const int row = i >> 10, k = i & 1023; const float cv = row < 4 ? P.c[row * 1024 + k] : P.c_ctx[k]; lds[i] = siluf_(cv); }
    __syncthreads();
    const int col = T.tid & 63, ks = T.tid >> 6;
    const float* w = P.w_mod + ((size_t)layer * 1024 + ks * 128) * 6144 + jb * 64 + col;
    float a0 = 0.f, a1 = 0.f, a2 = 0.f, a3 = 0.f, a4 = 0.f;
#pragma unroll 1
    for (int k0 = 0; k0 < 128; k0 += 32) { float wv[32];
#pragma unroll
        for (int q = 0; q < 32; ++q) wv[q] = w[(size_t)(k0 + q) * 6144];
#pragma unroll
        for (int q = 0; q < 32; ++q) { const int kk = ks * 128 + k0 + q;
            a0 += lds[kk] * wv[q]; a1 += lds[1024 + kk] * wv[q]; a2 += lds[2048 + kk] * wv[q]; a3 += lds[3072 + kk] * wv[q]; a4 += lds[4096 + kk] * wv[q]; } }
    LAS float* red = lds + 5120;
    red[(ks * 5 + 0) * 64 + col] = a0; red[(ks * 5 + 1) * 64 + col] = a1; red[(ks * 5 + 2) * 64 + col] = a2; red[(ks * 5 + 3) * 64 + col] = a3; red[(ks * 5 + 4) * 64 + col] = a4;
    __syncthreads();
    if (T.tid < 320) { const int row = T.tid >> 6, cc = T.tid & 63; float s = 0.f;
#pragma unroll
        for (int q = 0; q < 8; ++q) s += red[(q * 5 + row) * 64 + cc];
        ((float*)(P.ws + WS_MODV))[((size_t)layer * 5 + row) * 6144 + jb * 64 + cc] = s + P.b_mod[(size_t)layer * 6144 + jb * 64 + cc]; }
    __syncthreads();
}
DI void p0_rope(const Params& P, const Tctx& T0) { const Tctx T = opaque_ctx(T0);
    float* tab = (float*)(P.ws + WS_ROPE);
    for (int i = T.tid; i < 1024; i += 512) { const int pos = i >> 4, j = i & 15;
        const float inv = exp2f(-(float)j * (13.287712379549449f / 16.f));
        const float ang = (float)pos * inv; float rev = ang * 0.15915494309189535f; rev -= floorf(rev);
        tab[2 * i] = __builtin_amdgcn_cosf(rev); tab[2 * i + 1] = __builtin_amdgcn_sinf(rev); }
}

DI void ln_norm(f32x4 (&v)[4]) {
    float s = 0.f;
#pragma unroll
    for (int j = 0; j < 4; ++j) s += (v[j].x + v[j].y) + (v[j].z + v[j].w);
    const float mean = wave_sum(s) * (1.f / DMODEL); float s2 = 0.f;
#pragma unroll
    for (int j = 0; j < 4; ++j) { v[j] = v[j] - mean; s2 += (v[j].x * v[j].x + v[j].y * v[j].y) + (v[j].z * v[j].z + v[j].w * v[j].w); }
    const float rstd = rsqrtf(wave_sum(s2) * (1.f / DMODEL) + EPSF);
#pragma unroll
    for (int j = 0; j < 4; ++j) v[j] = v[j] * rstd;
}
DI void load_row(const float* p, int lane, f32x4 (&v)[4]) {
#pragma unroll
    for (int j = 0; j < 4; ++j) v[j] = *((const f32x4*)p + lane + 64 * j);
}
DI void store_row(float* p, int lane, const f32x4 (&v)[4]) {
#pragma unroll
    for (int j = 0; j < 4; ++j) *((f32x4*)p + lane + 64 * j) = v[j];
}
DI void store_row_bf16(bf16_t* p, int lane, const f32x4 (&v)[4]) {
#pragma unroll
    for (int j = 0; j < 4; ++j) { u32x2 o; o.x = pk2(v[j].x, v[j].y); o.y = pk2(v[j].z, v[j].w); *((u32x2*)p + lane + 64 * j) = o; }
}
DI void stage_w16(LAS float* Wl, const float* src, int ld, int tid) {
    for (int idx = tid; idx < 16384; idx += 512) { const int k = idx >> 4, jj = idx & 15; const int j = k >> 8, l = (k & 255) >> 2, e = k & 3;
        Wl[((j * 4 + e) * 64 + l) * 16 + jj] = src[(size_t)k * ld + jj]; }
}
DI void row_dot16(const f32x4 (&h)[4], const LAS float* Wl, int lane, float (&s)[16]) {
#pragma unroll
    for (int q = 0; q < 16; ++q) s[q] = 0.f;
#pragma unroll
    for (int j = 0; j < 4; ++j)
#pragma unroll
        for (int e = 0; e < 4; ++e) { const float x = h[j][e]; const LAS f32x4* wp = (const LAS f32x4*)(Wl + ((j * 4 + e) * 64 + lane) * 16);
#pragma unroll
            for (int q = 0; q < 4; ++q) { const f32x4 w = wp[q]; s[4 * q] += x * w.x; s[4 * q + 1] += x * w.y; s[4 * q + 2] += x * w.z; s[4 * q + 3] += x * w.w; }
            if (e & 1) asm volatile("" ::: "memory"); }
}

DI void row_dot16x2(const f32x4 (&ha)[4], const f32x4 (&hb)[4], const LAS float* Wl, int lane, float (&sa)[16], float (&sb)[16]) {
#pragma unroll
    for (int o = 0; o < 16; ++o) { sa[o] = 0.f; sb[o] = 0.f; }
#pragma unroll
    for (int j = 0; j < 4; ++j)
#pragma unroll
        for (int e = 0; e < 4; ++e) { const LAS f32x4* wp = (const LAS f32x4*)(Wl + ((j * 4 + e) * 64 + lane) * 16); const float xa = ha[j][e], xb = hb[j][e];
#pragma unroll
            for (int o4 = 0; o4 < 4; ++o4) { const f32x4 w = wp[o4];
                sa[4 * o4] += xa * w.x; sa[4 * o4 + 1] += xa * w.y; sa[4 * o4 + 2] += xa * w.z; sa[4 * o4 + 3] += xa * w.w;
                sb[4 * o4] += xb * w.x; sb[4 * o4 + 1] += xb * w.y; sb[4 * o4 + 2] += xb * w.z; sb[4 * o4 + 3] += xb * w.w; }
            if (e & 1) asm volatile("" ::: "memory"); }
}
DI void p1_row(const Params& P, int layer, const float* modv, bf16_t* H, int r, bool ok, int lane, f32x4 (&v)[4]) {
    int b, p; row_bp(r, b, p); const int mrow = p < CTXL ? 4 : b; ln_norm(v); const float* mv = modv + (size_t)mrow * 6144;
#pragma unroll
    for (int j = 0; j < 4; ++j) { const f32x4 sh = *((const f32x4*)mv + lane + 64 * j), sc = *((const f32x4*)(mv + 1024) + lane + 64 * j); v[j] = v[j] * (sc + 1.f) + sh; }
    if (ok) store_row_bf16(H + (size_t)r * DMODEL, lane, v);
}
DI void p1_modulate(const Params& P, const Tctx& T0, unsigned char* lds, int layer) { const Tctx T = opaque_ctx(T0);
    LAS float* Wl = (LAS float*)lds;
    stage_w16(Wl, P.w_in + (size_t)layer * 1024 * IN_COLS + 1024, IN_COLS, T.tid);
    __syncthreads();
    const float* modv = (const float*)(P.ws + WS_MODV) + (size_t)layer * 5 * 6144;
    bf16_t* H = (bf16_t*)(P.ws + WS_H); float* DT = (float*)(P.ws + WS_DT);
    const int jl = lane_j16(T.lane); const float dtb = P.ssd_dt_bias[layer * 16 + jl];
#pragma unroll 1
    for (int r = T.gw; r < MR; r += 2 * T.NGW) {
        const int r2 = r + T.NGW; const bool ok2 = r2 < MR; const int rb = ok2 ? r2 : r;
        f32x4 va[4], vb[4]; load_row(xsrc_row(P, layer, r), T.lane, va); load_row(xsrc_row(P, layer, rb), T.lane, vb);
        p1_row(P, layer, modv, H, r, true, T.lane, va); p1_row(P, layer, modv, H, rb, ok2, T.lane, vb);
        float sa[16], sb[16]; row_dot16x2(va, vb, Wl, T.lane, sa, sb);
        const float xa = reduce16(sa, T.lane) + dtb, xb = reduce16(sb, T.lane) + dtb;
        if ((T.lane & 3) == 0) { DT[(size_t)r * 16 + jl] = xa > 20.f ? xa : __logf(1.f + __expf(xa)); if (ok2) DT[(size_t)r2 * 16 + jl] = xb > 20.f ? xb : __logf(1.f + __expf(xb)); }
    }
    __syncthreads();
}

DI void norm_rope8(float (&y)[8], const float (&nw)[8], int lq, bool do_rope, const float* tab_row, const float* tab_col, float outscale) {
    float ss = 0.f;
#pragma unroll
    for (int e = 0; e < 8; ++e) ss += y[e] * y[e];
    ss += dppf<0xB1>(ss); ss += dppf<0x4E>(ss); ss += dppf<0x141>(ss);
    const float rstd = rsqrtf(ss * (1.f / 64.f) + EPSF);
#pragma unroll
    for (int e = 0; e < 8; ++e) y[e] = y[e] * rstd * nw[e];
    if (do_rope) { const int axis = lq >> 2, half = (lq >> 1) & 1, j0 = 8 * (lq & 1); const float* tab = (axis ? tab_col : tab_row) + 2 * j0;
#pragma unroll
        for (int e = 0; e < 8; ++e) { const float pr = dppf<0x4E>(y[e]); const float cs = tab[2 * e], sn = tab[2 * e + 1]; y[e] = half ? y[e] * cs + pr * sn : y[e] * cs - pr * sn; } }
#pragma unroll
    for (int e = 0; e < 8; ++e) y[e] *= outscale;
}
struct P3In { u32x4 qv, kv, xc0, xp0, xn0, xc1, xp1, xn1, sb, sc1, sx1, sc0, sx0, sc2, sx2; };
DI void p3_load(const bf16_t* PROJ, int r, int lane, P3In& I) {
    const int p = r % TPB; const bf16_t* pr = PROJ + (size_t)r * NP;
    const bool hasprev = !(p == 0 || p == CTXL), hasnext = !(p == CTXL - 1 || p == TPB - 1);
    const bf16_t* pp = hasprev ? pr - NP : pr; const bf16_t* pq = hasnext ? pr + NP : pr; const int l16 = lane & 15, ch1 = 512 + 8 * (lane & 31);
    I.qv = *(const u32x4*)(pr + PQ + 8 * lane); I.kv = *(const u32x4*)(pr + (lane < 16 ? PK : PV) + 8 * l16);
    I.xc0 = *(const u32x4*)(pr + PXBC + 8 * lane); I.xp0 = *(const u32x4*)(pp + PXBC + 8 * lane); I.xn0 = *(const u32x4*)(pq + PXBC + 8 * lane);
    I.xc1 = *(const u32x4*)(pr + PXBC + ch1); I.xp1 = *(const u32x4*)(pp + PXBC + ch1); I.xn1 = *(const u32x4*)(pq + PXBC + ch1);
    I.sb = *(const u32x4*)(pr + PSCB + 8 * lane); I.sc1 = *(const u32x4*)(pr + PSCC + 8 * lane); I.sx1 = *(const u32x4*)(pr + PSCX + 8 * lane);
    I.sc0 = *(const u32x4*)(pp + PSCC + 8 * lane); I.sx0 = *(const u32x4*)(pp + PSCX + 8 * lane); I.sc2 = *(const u32x4*)(pq + PSCC + 8 * lane); I.sx2 = *(const u32x4*)(pq + PSCX + 8 * lane);
}
DI void p3_post(const Params& P, const Tctx& T0, int layer) { const Tctx T = opaque_ctx(T0);
    const bf16_t* PROJ = (const bf16_t*)(P.ws + WS_PROJ); const float* rope = (const float*)(P.ws + WS_ROPE);
    bf16_t* Qf = (bf16_t*)(P.ws + WS_Q); bf16_t* Kf = (bf16_t*)(P.ws + WS_K); bf16_t* Vf = (bf16_t*)(P.ws + WS_V); bf16_t* XBC = (bf16_t*)(P.ws + WS_XBC); bf16_t* YC = (bf16_t*)(P.ws + WS_YC);
    const int lane = T.lane, lq = lane & 7;
    const u32x4 z4 = {0u, 0u, 0u, 0u};
    float qn[8], kn[8], cw0[3][8], cb0[8], sw[3][8];
    {
#pragma unroll
      for (int e = 0; e < 8; ++e) { qn[e] = P.q_norm[layer * 64 + 8 * lq + e]; kn[e] = P.k_norm[layer * 64 + 8 * lq + e];
          cb0[e] = P.ssd_conv_b[(size_t)layer * 768 + 8 * lane + e];
#pragma unroll
          for (int t = 0; t < 3; ++t) { cw0[t][e] = P.ssd_conv_w[((size_t)layer * 3 + t) * 768 + 8 * lane + e]; sw[t][e] = P.sc_conv_w[((size_t)layer * 3 + t) * 512 + 8 * lane + e]; } } }
    P3In In; if (T.gw < MR) p3_load(PROJ, T.gw, lane, In);
    for (int r = T.gw; r < MR; r += T.NGW) {
        const P3In I = In; if (r + T.NGW < MR) p3_load(PROJ, r + T.NGW, lane, In);
        if (lane == 0) ((float*)(P.ws + WS_SSQ))[r] = 0.f;
        int b, p; row_bp(r, b, p); const bool isctx = p < CTXL; const int pos = isctx ? 0 : p - CTXL;
        const float* trow = rope + (size_t)(pos >> 6) * 32; const float* tcol = rope + (size_t)(pos & 63) * 32;
        const bool hasprev = !(p == 0 || p == CTXL), hasnext = !(p == CTXL - 1 || p == TPB - 1);
        const int ch1 = 512 + 8 * (lane & 31);
        { float y[8]; unpack8(I.qv, y); norm_rope8(y, qn, lq, !isctx, trow, tcol, QSCALE); *(u32x4*)(Qf + (size_t)r * 512 + 8 * lane) = pack8(y); }
        { float y[8]; unpack8(I.kv, y); norm_rope8(y, kn, lq, !isctx, trow, tcol, 1.f);
          if (lane < 16) *(u32x4*)(Kf + (size_t)r * 128 + 8 * lane) = pack8(y);
          else if (lane < 32) *(u32x4*)(Vf + (size_t)r * 128 + 8 * (lane - 16)) = I.kv; }
#pragma unroll
        for (int pass = 0; pass < 2; ++pass) { const int ch0 = pass ? ch1 : 8 * lane;
            if (pass == 0 || lane < 32) { float cu[8], pv[8], nx[8]; unpack8(pass ? I.xc1 : I.xc0, cu); unpack8(hasprev ? (pass ? I.xp1 : I.xp0) : z4, pv); unpack8(hasnext ? (pass ? I.xn1 : I.xn0) : z4, nx);
                float o[8];
#pragma unroll
                for (int e = 0; e < 8; ++e) { const float* cwp = P.ssd_conv_w + (size_t)layer * 3 * 768 + ch1; const float t = pass ? cwp[e] * pv[e] + cwp[768 + e] * cu[e] + cwp[1536 + e] * nx[e] + P.ssd_conv_b[(size_t)layer * 768 + ch1 + e] : cw0[0][e] * pv[e] + cw0[1][e] * cu[e] + cw0[2][e] * nx[e] + cb0[e]; o[e] = siluf_(t); }
                *(u32x4*)(XBC + (size_t)r * 768 + ch0) = pack8(o); } }
        { const int ch0 = 8 * lane; float bq[8], c0[8], x0[8], c1[8], x1[8], c2[8], x2[8];
            unpack8(I.sb, bq); unpack8(I.sc1, c1); unpack8(I.sx1, x1); unpack8(hasprev ? I.sc0 : z4, c0); unpack8(hasprev ? I.sx0 : z4, x0); unpack8(hasnext ? I.sc2 : z4, c2); unpack8(hasnext ? I.sx2 : z4, x2);
            float o[8];
#pragma unroll
            for (int e = 0; e < 8; ++e) o[e] = bq[e] * (sw[0][e] * (c0[e] * x0[e]) + sw[1][e] * (c1[e] * x1[e]) + sw[2][e] * (c2[e] * x2[e]));
            *(u32x4*)(YC + (size_t)r * 512 + ch0) = pack8(o); }
    }
}

constexpr int XS_LD = 272;
constexpr int BS_LD = 80;
typedef short v4i16_t __attribute__((ext_vector_type(4)));
typedef short s16x4 __attribute__((ext_vector_type(4)));
DI s16x4 tr_read(const LAS bf16_t* p) { return __builtin_bit_cast(s16x4, __builtin_amdgcn_ds_read_tr16_b64_v4i16((LAS v4i16_t*)p)); }
DI bf16x8 cat8(s16x4 lo, s16x4 hi) { return __builtin_shufflevector(lo, hi, 0, 1, 2, 3, 4, 5, 6, 7); }
DI bf16x8 scale8(const bf16x8 vv, const float (&w)[8]) { float f[8]; unpack8(__builtin_bit_cast(u32x4, vv), f);
#pragma unroll
    for (int e = 0; e < 8; ++e) f[e] *= w[e];
    return __builtin_bit_cast(bf16x8, pack8(f)); }
DI bf16x8 scale8s(const u32x4 v, float w) { float f[8]; unpack8(v, f);
#pragma unroll
    for (int e = 0; e < 8; ++e) f[e] *= w;
    return __builtin_bit_cast(bf16x8, pack8(f)); }
DI void ssd_stage_rows(const bf16_t* src, int ld, int nch8, LAS bf16_t* dst, int dld, int tid, int nload) {
    for (int i = 0; i < nload; ++i) { const int q = tid + 512 * i; const int s = q / nch8, ch0 = (q % nch8) * 8;
        *(LAS u32x4*)(dst + s * dld + ch0) = *(const u32x4*)(src + (size_t)s * ld + ch0); }
}

DI void ssd_a(const Params& P, const Tctx& T0, unsigned char* lds_, int layer) { const Tctx T = opaque_ctx(T0);
    const bf16_t* XBC = (const bf16_t*)(P.ws + WS_XBC); const float* DT = (const float*)(P.ws + WS_DT); float* ACS = (float*)(P.ws + WS_ACS); float* ST = (float*)(P.ws + WS_ST);
    LAS bf16_t* XR = (LAS bf16_t*)lds_; LAS bf16_t* BR = (LAS bf16_t*)(lds_ + 69632); LAS float* lw = (LAS float*)(lds_ + 69632 + 20480);
    const int lane = T.lane, w = T.wave, r = lane & 31, hb = lane >> 5, qq = (lane & 15) >> 2, pp = lane & 3, blk = (lane >> 4) & 1;
    for (int u = T.blk; u < NBATCH * NCH * 4; u += T.G) {
        const int dir = u & 1, g = (u >> 1) & 1, c = (u >> 2) % NCH, b = u / (4 * NCH); const int r0 = b * TPB + c * 128;
        const int hh = w & 3, ph = w >> 2, h = 4 * g + hh, dh = dir * 8 + h;
        if (w < 4) { const float a = -__expf(P.ssd_a_log[layer * 16 + dh]); const int l0 = 2 * lane;
          const float d0 = DT[(size_t)(r0 + l0) * 16 + dh], d1 = DT[(size_t)(r0 + l0 + 1) * 16 + dh]; const float v0 = d0 * a, v1 = d1 * a; const float sm = v0 + v1; float Pf = sm;
#pragma unroll
          for (int o = 1; o < 64; o <<= 1) { const float t = __shfl_up(Pf, o); if (lane >= o) Pf += t; }
          const float tot = __shfl(Pf, 63); float a0, a1;
          if (dir == 0) { a0 = Pf - v1; a1 = Pf; } else { const float S = tot - Pf + sm; a0 = S; a1 = S - v0; }
          ACS[(size_t)(r0 + l0) * 16 + dh] = a0; ACS[(size_t)(r0 + l0 + 1) * 16 + dh] = a1;
          lw[hh * 128 + l0] = __expf(tot - a0) * d0; lw[hh * 128 + l0 + 1] = __expf(tot - a1) * d1; }
        ssd_stage_rows(XBC + (size_t)r0 * 768 + 256 * g, 768, 32, XR, XS_LD, T.tid, 8);
        ssd_stage_rows(XBC + (size_t)r0 * 768 + 512 + 64 * g, 768, 8, BR, BS_LD, T.tid, 2);
        __syncthreads();
        f32x16 acc[2];
#pragma unroll
        for (int j = 0; j < 2; ++j)
#pragma unroll
            for (int q = 0; q < 16; ++q) acc[j][q] = 0.f;
#pragma unroll 2
        for (int kk = 0; kk < 8; ++kk) { float wv[8]; { const f32x4 w0 = *(const LAS f32x4*)(lw + hh * 128 + 16 * kk + 8 * hb), w1 = *(const LAS f32x4*)(lw + hh * 128 + 16 * kk + 8 * hb + 4);
                wv[0] = w0.x; wv[1] = w0.y; wv[2] = w0.z; wv[3] = w0.w; wv[4] = w1.x; wv[5] = w1.y; wv[6] = w1.z; wv[7] = w1.w; }
            const int rb = 16 * kk + 8 * hb + qq;
            const LAS bf16_t* xa = XR + rb * XS_LD + 64 * hh + 32 * ph + 16 * blk + 4 * pp;
            const bf16x8 af = scale8(cat8(tr_read(xa), tr_read(xa + 4 * XS_LD)), wv);
#pragma unroll
            for (int nt = 0; nt < 2; ++nt) { const LAS bf16_t* ba = BR + rb * BS_LD + 32 * nt + 16 * blk + 4 * pp;
                const bf16x8 bfr = cat8(tr_read(ba), tr_read(ba + 4 * BS_LD)); acc[nt] = MFMA32(af, bfr, acc[nt]); } }
        float* st = ST + ((((size_t)dir * NBATCH + b) * NCH + c) * 8 + h) * 4096;
#pragma unroll
        for (int nt = 0; nt < 2; ++nt)
#pragma unroll
            for (int i = 0; i < 16; ++i) st[(32 * ph + crow(i, hb)) * 64 + 32 * nt + r] = acc[nt][i];
        __syncthreads();
    }
}
DI void ssd_b(const Params& P, const Tctx& T0) { const Tctx T = opaque_ctx(T0);
    float* ST = (float*)(P.ws + WS_ST); const float* ACS = (const float*)(P.ws + WS_ACS);
    for (int e = T.blk * 512 + T.tid; e < 2 * NBATCH * 8 * 4096; e += T.G * 512) {
        const int pn = e & 4095, h = (e >> 12) & 7, b = (e >> 15) & 3, dir = e >> 17;
        float* base = ST + (((size_t)dir * NBATCH + b) * NCH * 8 + h) * 4096 + pn;
        const float* ab = ACS + (size_t)(b * TPB + (dir == 0 ? 127 : 0)) * 16 + dir * 8 + h;
        float st[NCH], dec[NCH];
#pragma unroll
        for (int c = 0; c < NCH; ++c) { st[c] = base[(size_t)c * 8 * 4096]; dec[c] = ab[(size_t)c * 128 * 16]; }
        float hs = 0.f;
        if (dir == 0) {
#pragma unroll
            for (int c = 0; c < NCH; ++c) { base[(size_t)c * 8 * 4096] = hs; hs = __expf(dec[c]) * hs + st[c]; }
        } else {
            base[(size_t)1 * 8 * 4096] = hs; hs = __expf(dec[1]) * hs + st[1];
            base[0] = hs; hs = __expf(dec[0]) * hs + st[0];
#pragma unroll
            for (int c = NCH - 1; c >= 2; --c) { base[(size_t)c * 8 * 4096] = hs; hs = __expf(dec[c]) * hs + st[c]; }
        }
    }
}
DI void ssd_c(const Params& P, const Tctx& T0, unsigned char* lds_, int layer) { const Tctx T = opaque_ctx(T0);
    const bf16_t* XBC = (const bf16_t*)(P.ws + WS_XBC); const float* DT = (const float*)(P.ws + WS_DT); const float* ACS = (const float*)(P.ws + WS_ACS); const float* ST = (const float*)(P.ws + WS_ST);
    bf16_t* YRAW = (bf16_t*)(P.ws + WS_YRAW);
    LAS bf16_t* XR = (LAS bf16_t*)lds_; LAS float* bfw = (LAS float*)(lds_ + 69632); LAS float* lacs = (LAS float*)(lds_ + 69632 + 4096);
    const int lane = T.lane, w = T.wave, r = lane & 31, hb = lane >> 5, qq = (lane & 15) >> 2, pp = lane & 3, blk = (lane >> 4) & 1;
    const int c0 = (layer == NLAYER - 1) ? 2 : 0, ncu = NCH - c0;
    for (int u = T.blk; u < NBATCH * ncu * 4; u += T.G) {
        const int half = u & 1, g = (u >> 1) & 1, c = c0 + (u >> 2) % ncu, b = u / (4 * ncu); const int r0 = b * TPB + c * 128;
        const int hh = w & 3, h = 4 * g + hh, l0 = 64 * half + 32 * (w >> 2), l = l0 + r;
        for (int i = T.tid; i < 1024; i += 512) { const int ll = i & 127, dd = (i >> 7) & 1, h4 = i >> 8; const size_t o = (size_t)(r0 + ll) * 16 + dd * 8 + 4 * g + h4;
            const float a = ACS[o]; lacs[i] = a; bfw[i] = a - __logf(DT[o]); }
        ssd_stage_rows(XBC + (size_t)r0 * 768 + 256 * g, 768, 32, XR, XS_LD, T.tid, 8);
        __syncthreads();
        const float af_l = lacs[(hh * 2) * 128 + l], ab_l = lacs[(hh * 2 + 1) * 128 + l]; const float Dh = P.ssd_d[layer * 8 + h];
        const bf16_t* Cg = XBC + (size_t)r0 * 768 + 640 + 64 * g; const bf16_t* Bg = XBC + (size_t)r0 * 768 + 512 + 64 * g;
        f32x16 gt[4];
#pragma unroll
        for (int j = 0; j < 4; ++j)
#pragma unroll
            for (int q = 0; q < 16; ++q) gt[j][q] = 0.f;
#pragma unroll
        for (int kk = 0; kk < 4; ++kk) { const bf16x8 cfr = *(const bf16x8*)(Cg + (size_t)l * 768 + 16 * kk + 8 * hb);
#pragma unroll
            for (int js = 0; js < 4; ++js) { const bf16x8 bfr = *(const bf16x8*)(Bg + (size_t)(32 * js + r) * 768 + 16 * kk + 8 * hb); gt[js] = MFMA32(bfr, cfr, gt[js]); } }
        f32x16 y[2];
#pragma unroll
        for (int pt = 0; pt < 2; ++pt)
#pragma unroll
            for (int q = 0; q < 16; ++q) y[pt][q] = 0.f;
#pragma unroll
        for (int js = 0; js < 4; ++js) {
#pragma unroll
            for (int q = 0; q < 4; ++q) { const int s0 = 32 * js + 8 * q + 4 * hb;
                const f32x4 f4 = *(const LAS f32x4*)(bfw + (hh * 2) * 128 + s0), b4 = *(const LAS f32x4*)(bfw + (hh * 2 + 1) * 128 + s0);
#pragma unroll
                for (int e = 0; e < 4; ++e) { const int sx = s0 + e; const float argf = (sx <= l) ? af_l - f4[e] : -INFINITY, argb = (sx >= l) ? ab_l - b4[e] : -INFINITY;
                    gt[js][4 * q + e] = gt[js][4 * q + e] * (__expf(argf) + __expf(argb)) + (sx == l ? Dh : 0.f); } }
#pragma unroll
            for (int ks = 0; ks < 2; ++ks) { u32x4 pk; pk.x = pk2(gt[js][8 * ks], gt[js][8 * ks + 1]); pk.y = pk2(gt[js][8 * ks + 2], gt[js][8 * ks + 3]); pk.z = pk2(gt[js][8 * ks + 4], gt[js][8 * ks + 5]); pk.w = pk2(gt[js][8 * ks + 6], gt[js][8 * ks + 7]);
                const bf16x8 wfr = __builtin_bit_cast(bf16x8, pk); const int rb = 32 * js + 16 * ks + 4 * hb + qq;
#pragma unroll
                for (int pt = 0; pt < 2; ++pt) { const LAS bf16_t* xa = XR + rb * XS_LD + 64 * hh + 32 * pt + 16 * blk + 4 * pp;
                    y[pt] = MFMA32(cat8(tr_read(xa), tr_read(xa + 8 * XS_LD)), wfr, y[pt]); } } }
#pragma unroll 1
        for (int dd = 0; dd < 2; ++dd) { const float el = __expf(dd ? ab_l : af_l);
            const float* hs = ST + ((((size_t)dd * NBATCH + b) * NCH + c) * 8 + h) * 4096;
#pragma unroll
            for (int kk = 0; kk < 4; ++kk) { const bf16x8 cfr = scale8s(*(const u32x4*)(Cg + (size_t)l * 768 + 16 * kk + 8 * hb), el);
#pragma unroll
                for (int pt = 0; pt < 2; ++pt) { const float* hp = hs + (32 * pt + r) * 64 + 16 * kk + 8 * hb; const f32x4 h0 = *(const f32x4*)hp, h1 = *(const f32x4*)(hp + 4);
                    u32x4 pkd; pkd.x = pk2(h0.x, h0.y); pkd.y = pk2(h0.z, h0.w); pkd.z = pk2(h1.x, h1.y); pkd.w = pk2(h1.z, h1.w);
                    y[pt] = MFMA32(__builtin_bit_cast(bf16x8, pkd), cfr, y[pt]); } } }
        { const bf16_t* zr = (const bf16_t*)(P.ws + WS_PROJ) + (size_t)(r0 + l) * NP + PZ + h * 64; const float* nw = P.ssd_norm + layer * 512 + h * 64;
          bf16_t* yo = (bf16_t*)(P.ws + WS_YS) + (size_t)(r0 + l) * 512 + h * 64; float ss = 0.f;
#pragma unroll
          for (int pt = 0; pt < 2; ++pt)
#pragma unroll
            for (int q = 0; q < 4; ++q) { const int po = 32 * pt + 8 * q + 4 * hb; const u32x2 zz = *(const u32x2*)(zr + po); const f32x4 wv = *(const f32x4*)(nw + po);
                const float t0 = y[pt][4 * q] * siluf_(bflo(zz.x)), t1 = y[pt][4 * q + 1] * siluf_(bfhi(zz.x)), t2 = y[pt][4 * q + 2] * siluf_(bflo(zz.y)), t3 = y[pt][4 * q + 3] * siluf_(bfhi(zz.y));
                ss += (t0 * t0 + t1 * t1) + (t2 * t2 + t3 * t3);
                u32x2 o; o.x = pk2(t0 * wv.x, t1 * wv.y); o.y = pk2(t2 * wv.z, t3 * wv.w); *(u32x2*)(yo + po) = o; }
          ss = swap32_add(ss, ss);
          if (hb == 0) atomicAdd((float*)(P.ws + WS_SSQ) + (r0 + l), ss); }
        __syncthreads();
    }
}
DI void ys_finalize(const Params& P, const Tctx& T0, int layer) { const Tctx T = opaque_ctx(T0);
    const bf16_t* YRAW = (const bf16_t*)(P.ws + WS_YRAW); const bf16_t* PROJ = (const bf16_t*)(P.ws + WS_PROJ); bf16_t* YS = (bf16_t*)(P.ws + WS_YS);
    for (int r = T.gw; r < MR; r += T.NGW) {
        if (layer == 1 && (r % TPB) < CTXL) continue;
        float y[8], z[8]; unpack8(*(const u32x4*)(YRAW + (size_t)r * 512 + 8 * T.lane), y); unpack8(*(const u32x4*)(PROJ + (size_t)r * NP + PZ + 8 * T.lane), z);
        float ss = 0.f;
#pragma unroll
        for (int e = 0; e < 8; ++e) { y[e] *= siluf_(z[e]); ss += y[e] * y[e]; }
        const float rstd = rsqrtf(wave_sum(ss) * (1.f / 512.f) + EPSF); const float* nw = P.ssd_norm + layer * 512 + 8 * T.lane;
#pragma unroll
        for (int e = 0; e < 8; ++e) y[e] = y[e] * rstd * nw[e];
        *(u32x4*)(YS + (size_t)r * 512 + 8 * T.lane) = pack8(y);
    }
}

DI float softmax16(float lg) { const float mx = wave_max(lg); const float ex = expf(lg - mx); return ex / (wave_sum(ex) * 0.25f); }
DI void p7_ln_router(const Params& P, const Tctx& T0, unsigned char* lds, int layer) { const Tctx T = opaque_ctx(T0);
    LAS float* Wl = (LAS float*)lds;
    stage_w16(Wl, P.w_router + (size_t)layer * 1024 * 16, 16, T.tid);
    __syncthreads();
    const float* modv = (const float*)(P.ws + WS_MODV) + (size_t)layer * 5 * 6144;
    float* X1 = (float*)(P.ws + WS_X1); bf16_t* H = (bf16_t*)(P.ws + WS_H); float* AFF = (float*)(P.ws + WS_AFF);
    f32x4 g1v[4], b1v[4];
#pragma unroll
    for (int j = 0; j < 4; ++j) { g1v[j] = *((const f32x4*)(P.ln1_g + layer * 1024) + T.lane + 64 * j); b1v[j] = *((const f32x4*)(P.ln1_b + layer * 1024) + T.lane + 64 * j); }
    const int jl = lane_j16(T.lane);
    int r0 = T.gw; if (layer == 1 && (r0 % TPB) < CTXL) r0 += ((CTXL - (r0 % TPB) + T.NGW - 1) / T.NGW) * T.NGW;
    f32x4 pend[4]; int pr = -1;
#pragma unroll
    for (int j = 0; j < 4; ++j) pend[j] = (f32x4){0.f, 0.f, 0.f, 0.f};
    f32x4 nv[4]; int nr = r0; if (r0 < MR) load_row(X1 + (size_t)r0 * DMODEL, T.lane, nv);
    for (int r = r0; r < MR; r = nr) {
        int b, p; row_bp(r, b, p); const int mrow = p < CTXL ? 4 : b;
        f32x4 v[4];
#pragma unroll
        for (int j = 0; j < 4; ++j) v[j] = nv[j];
        { int rn = r + T.NGW; if (layer == 1 && rn < MR && (rn % TPB) < CTXL) rn += ((CTXL - (rn % TPB) + T.NGW - 1) / T.NGW) * T.NGW; if (rn < MR) load_row(X1 + (size_t)rn * DMODEL, T.lane, nv); nr = rn; }
        ln_norm(v);
#pragma unroll
        for (int j = 0; j < 4; ++j) v[j] = v[j] * g1v[j] + b1v[j];
        store_row(X1 + (size_t)r * DMODEL, T.lane, v);
        ln_norm(v); const float* mv = modv + (size_t)mrow * 6144;
#pragma unroll
        for (int j = 0; j < 4; ++j) { const f32x4 sh = *((const f32x4*)(mv + 3072) + T.lane + 64 * j), sc = *((const f32x4*)(mv + 4096) + T.lane + 64 * j); v[j] = v[j] * (sc + 1.f) + sh; }
        store_row_bf16(H + (size_t)r * DMODEL, T.lane, v);
        if (pr < 0) { pr = r;
#pragma unroll
            for (int j = 0; j < 4; ++j) pend[j] = v[j]; }
        else { float sa[16], sb[16]; row_dot16x2(pend, v, Wl, T.lane, sa, sb);
            const float pa = softmax16(reduce16(sa, T.lane)), pb = softmax16(reduce16(sb, T.lane));
            if ((T.lane & 3) == 0) { AFF[(size_t)pr * 16 + jl] = pa; AFF[(size_t)r * 16 + jl] = pb; }
            pr = -1; }
    }
    if (pr >= 0) { float s[16]; row_dot16(pend, Wl, T.lane, s); const float pa = softmax16(reduce16(s, T.lane));
        if ((T.lane & 3) == 0) AFF[(size_t)pr * 16 + jl] = pa; }
    __syncthreads();
}

DI unsigned block_scan_excl(unsigned v, LAS unsigned* wt, int lane, int wave, unsigned& total) {
    unsigned inc = v;
#pragma unroll
    for (int o = 1; o < 64; o <<= 1) { const unsigned t = __shfl_up(inc, o); if (lane >= o) inc += t; }
    if (lane == 63) wt[wave] = inc;
    __syncthreads();
    unsigned off = 0, tot = 0;
#pragma unroll
    for (int q = 0; q < 8; ++q) { const unsigned t = wt[q]; if (q < wave) off += t; tot += t; }
    __syncthreads();
    total = tot; return off + inc - v;
}
DI void p8_topk(const Params& P, const Tctx& T0, unsigned char* lds_, int layer) { const Tctx T = opaque_ctx(T0);
    const float* AFF = (const float*)(P.ws + WS_AFF); int* SLOT = (int*)(P.ws + WS_SLOT); float* AFFSEL = (float*)(P.ws + WS_AFFSEL);
    const bf16_t* H = (const bf16_t*)(P.ws + WS_H); bf16_t* XS = (bf16_t*)(P.ws + WS_XS);
    LAS unsigned* cnt = (LAS unsigned*)lds_; LAS unsigned* wt = cnt + 16; LAS int* rows = (LAS int*)(cnt + 32);
    const int ntask = layer == 0 ? 128 : 64;
    for (int task = T.blk; task < ntask; task += T.G) {
        const int set = task >> 6, tt = task & 63, b = tt >> 4, e = tt & 15; const int n = set ? CTXL : SEQL, k = set ? 32 : 512;
        const int rowbase = b * TPB + (set ? 0 : CTXL), slotbase = set ? 2048 + b * 32 : b * 512;
        unsigned key[8];
#pragma unroll
        for (int j = 0; j < 8; ++j) { const int idx = T.tid * 8 + j; key[j] = idx < n ? __float_as_uint(AFF[(size_t)(rowbase + idx) * 16 + e]) : 0u; }
        unsigned prefix = 0;
        for (int bit = 29; bit >= 0; --bit) { const unsigned cand = prefix | (1u << bit); int c = 0;
#pragma unroll
            for (int j = 0; j < 8; ++j) c += __popcll(__ballot(key[j] >= cand));
            if (T.lane == 0) cnt[(bit & 1) * 8 + T.wave] = (unsigned)c;
            __syncthreads();
            unsigned tot = 0;
#pragma unroll
            for (int q = 0; q < 8; ++q) tot += cnt[(bit & 1) * 8 + q];
            if ((int)tot >= k) prefix = cand; }
        unsigned cg_ = 0, ce_ = 0;
#pragma unroll
        for (int j = 0; j < 8; ++j) { cg_ += key[j] > prefix ? 1u : 0u; ce_ += key[j] == prefix ? 1u : 0u; }
        unsigned total; const unsigned ex1 = block_scan_excl((ce_ << 16) | cg_, wt, T.lane, T.wave, total);
        const int need_eq = k - (int)(total & 0xffffu); int eq_rank = (int)(ex1 >> 16);
        unsigned selm = 0, nsel = 0;
#pragma unroll
        for (int j = 0; j < 8; ++j) { bool s = key[j] > prefix; if (key[j] == prefix) { s = eq_rank < need_eq; ++eq_rank; } if (s) { selm |= 1u << j; ++nsel; } }
        unsigned tot2; unsigned pos = block_scan_excl(nsel, wt, T.lane, T.wave, tot2);
#pragma unroll
        for (int j = 0; j < 8; ++j) { const int idx = T.tid * 8 + j; if (idx < n) { const int r = rowbase + idx;
                if (selm & (1u << j)) { const int slot = slotbase + (int)pos; SLOT[(size_t)r * 16 + e] = slot; AFFSEL[e * ESTR + slot] = __uint_as_float(key[j]); rows[pos] = r; ++pos; }
                else SLOT[(size_t)r * 16 + e] = -1; } }
        __syncthreads();
        { int* IDX = (int*)(P.ws + WS_IDX) + e * ESTR;
          for (int s = T.tid; s < k; s += 512) IDX[slotbase + s] = rows[s];
          if (set == 1 && b == 0 && T.tid < 128) IDX[2176 + T.tid] = 0; }
        __syncthreads();
    }
}

DI void p11_combine(const Params& P, const Tctx& T0, unsigned char* lds, int layer) { const Tctx T = opaque_ctx(T0);
    const bool fuse = layer + 1 < NLAYER;
    LAS float* Wl = (LAS float*)lds;
    if (fuse) { stage_w16(Wl, P.w_in + (size_t)(layer + 1) * 1024 * IN_COLS + 1024, IN_COLS, T.tid); __syncthreads(); }
    const float* modn = (const float*)(P.ws + WS_MODV) + (size_t)(layer + 1) * 5 * 6144; bf16_t* H = (bf16_t*)(P.ws + WS_H); float* DT = (float*)(P.ws + WS_DT);
    const int jl = lane_j16(T.lane); const float dtb = fuse ? P.ssd_dt_bias[(layer + 1) * 16 + jl] : 0.f;
    const float* X1 = (const float*)(P.ws + WS_X1); const int* SLOT = (const int*)(P.ws + WS_SLOT); const bf16_t* Y = (const bf16_t*)(P.ws + WS_XS);
    const float* modv = (const float*)(P.ws + WS_MODV) + (size_t)layer * 5 * 6144; float* XA = (float*)(P.ws + WS_XA);
    f32x4 g2v[4], b2v[4];
#pragma unroll
    for (int j = 0; j < 4; ++j) { g2v[j] = *((const f32x4*)(P.ln2_g + layer * 1024) + T.lane + 64 * j); b2v[j] = *((const f32x4*)(P.ln2_b + layer * 1024) + T.lane + 64 * j); }
    const bool skipc = layer == 1;
    int r = row_skip(T.gw, T.NGW, skipc);
    f32x4 pend[4]; int pr = -1;
#pragma unroll
    for (int j = 0; j < 4; ++j) pend[j] = (f32x4){0.f, 0.f, 0.f, 0.f};
    f32x4 nv[4]; int nsl = -1;
    if (r < MR) { load_row(X1 + (size_t)r * DMODEL, T.lane, nv); nsl = SLOT[(size_t)r * 16 + (T.lane & 15)]; }
    while (r < MR) {
        int b, p; row_bp(r, b, p); const int mrow = p < CTXL ? 4 : b;
        f32x4 v[4], acc[4]; const int sl = nsl;
#pragma unroll
        for (int j = 0; j < 4; ++j) { v[j] = nv[j]; acc[j] = (f32x4){0.f, 0.f, 0.f, 0.f}; }
        const int rn = row_skip(r + T.NGW, T.NGW, skipc);
        if (rn < MR) { load_row(X1 + (size_t)rn * DMODEL, T.lane, nv); nsl = SLOT[(size_t)rn * 16 + (T.lane & 15)]; }
        unsigned mask = (unsigned)__ballot(T.lane < 16 && sl >= 0) & 0xffffu;
        while (mask) {
            const int e0 = __builtin_ctz(mask); mask &= mask - 1; const bool two = mask != 0; const int e1 = two ? __builtin_ctz(mask) : e0; if (two) mask &= mask - 1;
            const int s0 = __builtin_amdgcn_readlane(sl, e0), s1 = __builtin_amdgcn_readlane(sl, e1);
            const bf16_t* y0 = Y + ((size_t)e0 * ESTR + s0) * DMODEL; const bf16_t* y1 = Y + ((size_t)e1 * ESTR + s1) * DMODEL;
            u32x2 w0[4], w1[4];
#pragma unroll
            for (int j = 0; j < 4; ++j) { w0[j] = *((const u32x2*)y0 + T.lane + 64 * j); w1[j] = *((const u32x2*)y1 + T.lane + 64 * j); }
            const float f1 = two ? 1.f : 0.f;
#pragma unroll
            for (int j = 0; j < 4; ++j) { acc[j].x += bflo(w0[j].x) + f1 * bflo(w1[j].x); acc[j].y += bfhi(w0[j].x) + f1 * bfhi(w1[j].x); acc[j].z += bflo(w0[j].y) + f1 * bflo(w1[j].y); acc[j].w += bfhi(w0[j].y) + f1 * bfhi(w1[j].y); }
            if (layer == 0 && p < CTXL) {
                const bf16_t* YP = (const bf16_t*)(P.ws + WS_Q);
#pragma unroll 1
                for (int ks = 0; ks < 3; ++ks) { const bf16_t* q0 = YP + ((size_t)ks * 4096 + e0 * 256 + (s0 - 2048)) * DMODEL; const bf16_t* q1 = YP + ((size_t)ks * 4096 + e1 * 256 + (s1 - 2048)) * DMODEL;
#pragma unroll
                    for (int j = 0; j < 4; ++j) { const u32x2 a0 = *((const u32x2*)q0 + T.lane + 64 * j), a1 = *((const u32x2*)q1 + T.lane + 64 * j);
                        acc[j].x += bflo(a0.x) + f1 * bflo(a1.x); acc[j].y += bfhi(a0.x) + f1 * bfhi(a1.x); acc[j].z += bflo(a0.y) + f1 * bflo(a1.y); acc[j].w += bfhi(a0.y) + f1 * bfhi(a1.y); } } }
        }
        const float* m5 = modv + (size_t)mrow * 6144 + 5 * 1024;
#pragma unroll
        for (int j = 0; j < 4; ++j) v[j] = v[j] * ALPHA_F + *((const f32x4*)m5 + T.lane + 64 * j) * acc[j];
        ln_norm(v);
#pragma unroll
        for (int j = 0; j < 4; ++j) v[j] = v[j] * g2v[j] + b2v[j];
        float* dst = (layer == 0) ? XA + (size_t)r * DMODEL : P.out + ((size_t)b * SEQL + (p - CTXL)) * DMODEL;
        store_row(dst, T.lane, v);
        if (fuse) { ln_norm(v); const float* mv = modn + (size_t)mrow * 6144;
#pragma unroll
            for (int j = 0; j < 4; ++j) { const f32x4 sh = *((const f32x4*)mv + T.lane + 64 * j), sc = *((const f32x4*)(mv + 1024) + T.lane + 64 * j); v[j] = v[j] * (sc + 1.f) + sh; }
            store_row_bf16(H + (size_t)r * DMODEL, T.lane, v);
            if (pr < 0) { pr = r;
#pragma unroll
                for (int j = 0; j < 4; ++j) pend[j] = v[j]; }
            else { float sa[16], sb[16]; row_dot16x2(pend, v, Wl, T.lane, sa, sb);
                const float xa = reduce16(sa, T.lane) + dtb, xb = reduce16(sb, T.lane) + dtb;
                if ((T.lane & 3) == 0) { DT[(size_t)pr * 16 + jl] = xa > 20.f ? xa : __logf(1.f + __expf(xa)); DT[(size_t)r * 16 + jl] = xb > 20.f ? xb : __logf(1.f + __expf(xb)); }
                pr = -1; } }
        r = rn;
    }
    if (fuse && pr >= 0) { float sd[16]; row_dot16(pend, Wl, T.lane, sd); const float xx = reduce16(sd, T.lane) + dtb;
        if ((T.lane & 3) == 0) DT[(size_t)pr * 16 + jl] = xx > 20.f ? xx : __logf(1.f + __expf(xx)); }
    if (fuse) __syncthreads();
}

#define RLX_AGENT __ATOMIC_RELAXED, __HIP_MEMORY_SCOPE_AGENT
#define XB_TMO      128
#define XB_XCNT(j)  (256  + 64 * (j))
#define XB_XSUB(j)  (1280 + 64 * (j))
#define XB_XGEN(j)  (2304 + 64 * (j))
#define XB_TOP      3328
#define XB_TOPGEN   3392
#define XCD_BAR_WORDS 3456
#define XB_SPIN_CAP (1u << 18)

__device__ __forceinline__ unsigned xb_ld(unsigned* p)              { return __hip_atomic_load(p, __ATOMIC_RELAXED, __HIP_MEMORY_SCOPE_AGENT); }
__device__ __forceinline__ unsigned xb_add(unsigned* p, unsigned v) { return __hip_atomic_fetch_add(p, v, __ATOMIC_RELAXED, __HIP_MEMORY_SCOPE_AGENT); }
__device__ __forceinline__ unsigned xb_xcc_id() { return (unsigned)__builtin_amdgcn_s_getreg((3 << 11) | 20) & 0xFu; }
#define XB_SPIN(cond, bar) do { unsigned _sp = 0; while (cond) { __builtin_amdgcn_s_sleep(1); \
    if ((++_sp & 255u) == 0u) { if (xb_ld(&(bar)[XB_TMO])) break; if (_sp > XB_SPIN_CAP) { atomicAdd(&(bar)[XB_TMO], 1u); break; } } } } while (0)

struct XcdBarrier {
    unsigned* bar; unsigned x;
    volatile LAS unsigned* st;
};

__device__ __forceinline__ XcdBarrier xcd_barrier_post(unsigned* bar, volatile LAS unsigned* st) {
    XcdBarrier b; b.bar = bar; b.x = xb_xcc_id(); b.st = st;
    if (threadIdx.x == 0) (void)xb_add(&bar[XB_XCNT(b.x)], 1u);
    return b;
}
__device__ __forceinline__ void xcd_barrier_complete(unsigned* bar, unsigned x, unsigned& nloc, unsigned& nx) {
    const unsigned G = gridDim.x * gridDim.y * gridDim.z;
    unsigned sum, cnt, mine, sp = 0u;
    for (;;) {
        sum = 0u; cnt = 0u; mine = 0u;
#pragma unroll
        for (unsigned j = 0; j < 16; ++j) { const unsigned c = xb_ld(&bar[XB_XCNT(j)]); sum += c; cnt += (c > 0u) ? 1u : 0u; mine = (j == x) ? c : mine; }
        if (sum == G) break;
        __builtin_amdgcn_s_sleep(1);
        if ((++sp & 255u) == 0u) { if (xb_ld(&bar[XB_TMO])) break; if (sp > XB_SPIN_CAP) { atomicAdd(&bar[XB_TMO], 1u); break; } }
    }
    nloc = mine > 0u ? mine : 1u; nx = cnt > 0u ? cnt : 1u;
}

__device__ __forceinline__ void xcd_barrier(const XcdBarrier& b) {
    asm volatile("s_waitcnt vmcnt(0)" ::: "memory");
    __syncthreads();
    if (threadIdx.x == 0) {
        unsigned* bar = b.bar;
        __builtin_amdgcn_s_waitcnt(0);
        unsigned nloc = b.st[0], nx = b.st[1];
        if (nloc == 0u) { xcd_barrier_complete(bar, b.x, nloc, nx); b.st[0] = nloc; b.st[1] = nx; }
        const unsigned old = xb_add(&bar[XB_XSUB(b.x)], 1u);
        const unsigned gen = old / nloc;
        if (old + 1u == (gen + 1u) * nloc) {
            __builtin_amdgcn_fence(__ATOMIC_RELEASE, "agent");
            asm volatile("s_waitcnt vmcnt(0)" ::: "memory");
            const unsigned og = xb_add(&bar[XB_TOP], 1u);
            const unsigned tg = og / nx;
            if (og + 1u == (tg + 1u) * nx) xb_add(&bar[XB_TOPGEN], 1u);
            else XB_SPIN(xb_ld(&bar[XB_TOPGEN]) == tg, bar);
            __builtin_amdgcn_fence(__ATOMIC_ACQUIRE, "agent");
            xb_add(&bar[XB_XGEN(b.x)], 1u);
            asm volatile("s_waitcnt vmcnt(0)" ::: "memory");
        } else {
            XB_SPIN(xb_ld(&bar[XB_XGEN(b.x)]) == gen, bar);
            __builtin_amdgcn_fence(__ATOMIC_ACQUIRE, "agent");
            asm volatile("s_waitcnt vmcnt(0)" ::: "memory");
        }
    }
    __syncthreads();
}


#ifndef REP_MASK
#define REP_MASK 0
#endif
#ifndef EXTRA_SYNC
#define EXTRA_SYNC 0
#endif
#define WIN ((const bf16_t*)(P.ws + WS_WIN) + (size_t)layer * NP * 1024)
#define WBR ((const bf16_t*)(P.ws + WS_WBR) + (size_t)layer * 3 * 1024 * 512)
#define WO ((const bf16_t*)(P.ws + WS_WO) + (size_t)layer * 1024 * 1024)
#define WGU ((const bf16_t*)(P.ws + WS_WGU) + (size_t)layer * NEXP * 4096 * 1024)
#define WD ((const bf16_t*)(P.ws + WS_WD) + (size_t)layer * NEXP * 1024 * 2048)
#define modv ((const float*)(P.ws + WS_MODV) + (size_t)layer * 5 * 6144)
typedef const __attribute__((address_space(4))) Params* KParams;
#ifdef TIME_A
#define STAMP(idx_) do { if (T0.blk == 0 && T0.tid == 0) ((volatile LAS unsigned long long*)(ldsl + 143616))[(idx_)] = __builtin_amdgcn_s_memrealtime(); } while (0)
#else
#define STAMP(idx_) do { } while (0)
#endif
#define SEAM(last_) do { if (!(last_)) { XcdBarrier bar = bar0; asm volatile("" : "+s"(bar.bar)); xcd_barrier(bar); for (int xs_ = 0; xs_ < EXTRA_SYNC; ++xs_) xcd_barrier(bar); } } while (0)
template <int layer> DI void run_layer(KParams Pk, const Tctx& T0, unsigned char* lds, PG8_LAS unsigned char* ldsl, const XcdBarrier& bar0) {
    constexpr bool skipc = layer == NLAYER - 1;
    if constexpr (layer == 0)
    for (int rep_ = 0; rep_ <= ((REP_MASK >> 1) & 1); ++rep_) { KParams Pq = Pk; asm volatile("" : "+s"(Pq)); const Params& P = *(const Params*)Pq; const Tctx T = opaque_ctx(T0);
            p1_modulate(P, T, lds, layer);
    }
    if constexpr (layer == 0) { SEAM(false); } STAMP(layer * 14 + 1);
    for (int rep_ = 0; rep_ <= ((REP_MASK >> 2) & 1); ++rep_) { KParams Pq = Pk; asm volatile("" : "+s"(Pq)); const Params& P = *(const Params*)Pq; const Tctx T = opaque_ctx(T0);
            pg8::SchedInProj S; S.A = (const char*)(P.ws + WS_H); S.Bt = (const char*)WIN; S.G = T.G; S.c = T.blk;
            pg8::EpiStoreBf16 E{(bf16_t*)(P.ws + WS_PROJ), NP};
            pg8::gemm_phase<pg8::EpiStoreBf16, pg8::SchedInProj, true, true>(ldsl, 1024, S, E);
    }
    SEAM(layer == NLAYER - 1 && 2 == 14); STAMP(layer * 14 + 2);
    for (int rep_ = 0; rep_ <= ((REP_MASK >> 3) & 1); ++rep_) { KParams Pq = Pk; asm volatile("" : "+s"(Pq)); const Params& P = *(const Params*)Pq; const Tctx T = opaque_ctx(T0);
            p3_post(P, T, layer);
    }
    SEAM(layer == NLAYER - 1 && 3 == 14); STAMP(layer * 14 + 3);
    for (int rep_ = 0; rep_ <= ((REP_MASK >> 4) & 1); ++rep_) { KParams Pq = Pk; asm volatile("" : "+s"(Pq)); const Params& P = *(const Params*)Pq; const Tctx T = opaque_ctx(T0);
            ssd_a(P, T, lds, layer);
    }
    SEAM(layer == NLAYER - 1 && 4 == 14); STAMP(layer * 14 + 4);
    for (int rep_ = 0; rep_ <= ((REP_MASK >> 5) & 1); ++rep_) { KParams Pq = Pk; asm volatile("" : "+s"(Pq)); const Params& P = *(const Params*)Pq; const Tctx T = opaque_ctx(T0);
            ssd_b(P, T);
    }
    SEAM(layer == NLAYER - 1 && 5 == 14); STAMP(layer * 14 + 5);
    STAMP(layer * 14 + 6);
    for (int rep_ = 0; rep_ <= ((REP_MASK >> 7) & 1); ++rep_) { KParams Pq = Pk; asm volatile("" : "+s"(Pq)); const Params& P = *(const Params*)Pq; const Tctx T = opaque_ctx(T0);
            ssd_c(P, T, lds, layer);
            const attn_body::bf16* Qf = (const attn_body::bf16*)(P.ws + WS_Q); const attn_body::bf16* Kf = (const attn_body::bf16*)(P.ws + WS_K); const attn_body::bf16* Vf = (const attn_body::bf16*)(P.ws + WS_V);
            attn_body::bf16* YA = (attn_body::bf16*)(P.ws + WS_YA);
            __syncthreads();
            const int nu = skipc ? 512 : 544;
            const int nlat = (512 - T.blk + T.G - 1) / T.G;
            for (int it = 0; ; ++it) {
                int u = it * T.G + T.blk;
                if (it >= nlat) { const int v = ((T.blk - 32 % T.G + T.G) % T.G) + (it - nlat) * T.G; if (skipc || v >= 32) break; u = 512 + v; }
                long q0, k0; int nt, h;
                if (u < 512) { const int b = u >> 7, qb = u & 15; h = (u >> 4) & 7; q0 = (long)b * TPB + CTXL + qb * 256; k0 = (long)b * TPB; nt = TPB / 64; }
                else { const int v = u - 512, b = v >> 3; h = v & 7; q0 = (long)b * TPB; k0 = q0; nt = CTXL / 64; }
                attn_body::attn_unit<8>(q0, k0, nt, h, h >> 2, Qf, Kf, Vf, YA, (char*)lds); }
    }
    SEAM(layer == NLAYER - 1 && 7 == 14); STAMP(layer * 14 + 7);
    for (int rep_ = 0; rep_ <= ((REP_MASK >> 8) & 1); ++rep_) { KParams Pq = Pk; asm volatile("" : "+s"(Pq)); const Params& P = *(const Params*)Pq; const Tctx T = opaque_ctx(T0);
            pg8::SchedTok<3> S; S.A0 = (const char*)(P.ws + WS_YA); S.A1 = (const char*)(P.ws + WS_YS); S.A2 = (const char*)(P.ws + WS_YC); S.Bt = (const char*)WBR; S.KA = 512;
            S.ntile = skipc ? 256 : 272; S.skip_ctx = skipc; S.G = T.G; S.c = (T.G % 8 == 0) ? (T.blk % 8) * (T.G / 8) + T.blk / 8 : T.blk;
            pg8::EpiMerge E{(const bf16_t*)(P.ws + WS_PROJ), (bf16_t*)(P.ws + WS_M), (const float*)(P.ws + WS_SSQ), (bf16_t*)(P.ws + WS_X1) + (size_t)T.blk * 131072};
            pg8::gemm_phase<pg8::EpiMerge, pg8::SchedTok<3>, true, true>(ldsl, 512, S, E);
    }
    SEAM(layer == NLAYER - 1 && 8 == 14); STAMP(layer * 14 + 8);
    for (int rep_ = 0; rep_ <= ((REP_MASK >> 9) & 1); ++rep_) { KParams Pq = Pk; asm volatile("" : "+s"(Pq)); const Params& P = *(const Params*)Pq; const Tctx T = opaque_ctx(T0);
            pg8::SchedTok<1> S; S.A0 = (const char*)(P.ws + WS_M); S.A1 = S.A0; S.A2 = S.A0; S.Bt = (const char*)WO; S.KA = 1024;
            S.ntile = skipc ? 256 : 272; S.skip_ctx = skipc; S.G = T.G; S.c = (T.G % 8 == 0) ? (T.blk % 8) * (T.G / 8) + T.blk / 8 : T.blk;
            pg8::EpiWo E{P.x, P.ctx, (const float*)(P.ws + WS_XA), layer, modv, (float*)(P.ws + WS_X1)};
            pg8::gemm_phase<pg8::EpiWo, pg8::SchedTok<1>, true, true>(ldsl, 1024, S, E);
    }
    SEAM(layer == NLAYER - 1 && 9 == 14); STAMP(layer * 14 + 9);
    for (int rep_ = 0; rep_ <= ((REP_MASK >> 10) & 1); ++rep_) { KParams Pq = Pk; asm volatile("" : "+s"(Pq)); const Params& P = *(const Params*)Pq; const Tctx T = opaque_ctx(T0);
            p7_ln_router(P, T, lds, layer);
    }
    SEAM(layer == NLAYER - 1 && 10 == 14); STAMP(layer * 14 + 10);
    for (int rep_ = 0; rep_ <= ((REP_MASK >> 11) & 1); ++rep_) { KParams Pq = Pk; asm volatile("" : "+s"(Pq)); const Params& P = *(const Params*)Pq; const Tctx T = opaque_ctx(T0);
            p8_topk(P, T, lds, layer);
    }
    SEAM(layer == NLAYER - 1 && 11 == 14); STAMP(layer * 14 + 11);
    for (int rep_ = 0; rep_ <= ((REP_MASK >> 12) & 1); ++rep_) { KParams Pq = Pk; asm volatile("" : "+s"(Pq)); const Params& P = *(const Params*)Pq; const Tctx T = opaque_ctx(T0);
            pg8::SchedExp S; S.A = (const char*)(P.ws + WS_H); S.gather = true; S.Bt = (const char*)WGU; S.KA = 1024; S.NMT = skipc ? 8 : 9; S.NPN = 16; S.OCW = 128; S.G = T.G; S.c = (T.G % 8 == 0) ? (T.blk % 8) * (T.G / 8) + T.blk / 8 : T.blk;
            pg8::EpiGU E{(bf16_t*)(P.ws + WS_HID)};
            pg8::gemm_phase<pg8::EpiGU, pg8::SchedExp, true, true, true>(ldsl, 1024, S, E, (const int*)(P.ws + WS_IDX));
    }
    SEAM(layer == NLAYER - 1 && 12 == 14); STAMP(layer * 14 + 12);
    for (int rep_ = 0; rep_ <= ((REP_MASK >> 13) & 1); ++rep_) { KParams Pq = Pk; asm volatile("" : "+s"(Pq)); const Params& P = *(const Params*)Pq; const Tctx T = opaque_ctx(T0);
            pg8::EpiDown E{(bf16_t*)(P.ws + WS_XS), (const float*)(P.ws + WS_AFFSEL), (bf16_t*)(P.ws + WS_Q)};
            const int vc = (T.G % 8 == 0) ? (T.blk % 8) * (T.G / 8) + T.blk / 8 : T.blk;
            if constexpr (!skipc) { pg8::SchedDownSplit S; S.A = (const char*)(P.ws + WS_HID); S.Bt = (const char*)WD; S.G = T.G; S.c = vc;
                pg8::gemm_phase<pg8::EpiDown, pg8::SchedDownSplit, true, true>(ldsl, 2048, S, E); }
            else { pg8::SchedExp S; S.A = (const char*)(P.ws + WS_HID); S.gather = false; S.Bt = (const char*)WD; S.KA = 2048; S.NMT = 8; S.NPN = 4; S.OCW = 256; S.G = T.G; S.c = vc;
                pg8::gemm_phase<pg8::EpiDown, pg8::SchedExp, true, true>(ldsl, 2048, S, E); }
    }
    SEAM(layer == NLAYER - 1 && 13 == 14); STAMP(layer * 14 + 13);
    for (int rep_ = 0; rep_ <= ((REP_MASK >> 14) & 1); ++rep_) { KParams Pq = Pk; asm volatile("" : "+s"(Pq)); const Params& P = *(const Params*)Pq; const Tctx T = opaque_ctx(T0);
            p11_combine(P, T, lds, layer);
    }
    SEAM(layer == NLAYER - 1 && 14 == 14); STAMP(layer * 14 + 14);
}

__global__ void __launch_bounds__(512, 2) fwd_mega(Params P_unused_) {
    const __attribute__((address_space(4))) Params* Pk = (const __attribute__((address_space(4))) Params*)__builtin_amdgcn_kernarg_segment_ptr();
    const Params& P = *(const Params*)Pk;
    extern __shared__ __attribute__((aligned(16))) unsigned char lds[];
    cg::grid_group grid = cg::this_grid();
    Tctx T0; { Tctx& T = T0; T.tid = threadIdx.x; T.lane = T.tid & 63; T.wave = __builtin_amdgcn_readfirstlane(T.tid >> 6); T.G = gridDim.x; T.blk = blockIdx.x; T.gw = T.blk * 8 + T.wave; T.NGW = T.G * 8; }
    const Tctx& T = T0;
    PG8_LAS unsigned char* ldsl = (PG8_LAS unsigned char*)lds;
    volatile LAS unsigned* MISC = (volatile LAS unsigned*)(ldsl + (LDS_BYTES - 256));
    if (T.tid < 64) MISC[T.tid] = 0u;
    unsigned* barw = (unsigned*)(P.ws + WS_BAR);
    __syncthreads();
    const XcdBarrier bar0 = xcd_barrier_post(barw, MISC + 8);
    if (P.ph_lo == 0x7fffffff) grid.sync();
    if (T.blk < 192) p0_modv(P, T, lds, T.blk);
    if (T.blk == T.G - 1) p0_rope(P, T);
    p0_convert(P, T, lds);
#ifdef P0_TWICE
    __syncthreads(); p0_convert(P, T, lds);
#endif
    { XcdBarrier bar = bar0; asm volatile("" : "+s"(bar.bar)); xcd_barrier(bar); }
    STAMP(0);
    run_layer<0>(Pk, T0, lds, ldsl, bar0);
    run_layer<1>(Pk, T0, lds, ldsl, bar0);
#ifdef TIME_A
    if (T0.blk == 0 && T0.tid == 0) { volatile LAS unsigned long long* st = (volatile LAS unsigned long long*)(ldsl + 143616);
        const unsigned long long d = (st[TIME_B] - st[TIME_A]) * (unsigned long long)TIME_MULT; const unsigned long long t0 = __builtin_amdgcn_s_memrealtime();
        while (__builtin_amdgcn_s_memrealtime() - t0 < d) __builtin_amdgcn_s_sleep(8); }
#endif
}

constexpr int N_PHASES = 1 + NLAYER * 14;

extern "C" void kernel_launch(void* const* d_in, const int* in_sizes, int n_in, void* d_out, int out_size, void* d_ws, size_t ws_size, hipStream_t stream) {
    static int grid = 0;
    if (grid == 0) {
        if (n_in != 28 || ws_size < WS_END) { fprintf(stderr, "kernel_launch: unexpected n_in %d / ws %zu (need %zu)\n", n_in, ws_size, (size_t)WS_END); grid = -1; return; }
        int dev = 0, cus = 0, per_cu = 0;
        (void)hipGetDevice(&dev); (void)hipDeviceGetAttribute(&cus, hipDeviceAttributeMultiprocessorCount, dev);
        (void)hipFuncSetAttribute((const void*)fwd_mega, hipFuncAttributeMaxDynamicSharedMemorySize, LDS_BYTES);
        (void)hipOccupancyMaxActiveBlocksPerMultiprocessor(&per_cu, (const void*)fwd_mega, 512, LDS_BYTES);
        if (per_cu < 1) { fprintf(stderr, "kernel_launch: occupancy query says %d blocks/CU\n", per_cu); per_cu = 1; }
        grid = cus * per_cu;
    }
    if (grid < 0) return;
    (void)hipMemsetAsync((char*)d_ws + WS_BAR, 0, 16384, stream);
    Params p{};
    const float** f = (const float**)&p;
    for (int i = 0; i < 28; ++i) f[i] = (const float*)d_in[i];
    p.out = (float*)d_out; p.ws = (unsigned char*)d_ws;
    p.ph_lo = 0; p.ph_hi = 0;
    void* args[] = {&p};
    hipError_t e = hipLaunchCooperativeKernel((const void*)fwd_mega, dim3(grid), dim3(512), args, LDS_BYTES, stream);
    if (e != hipSuccess) fprintf(stderr, "cooperative launch failed: %s (grid %d)\n", hipGetErrorString(e), grid);
}
```
